# Optimizing an MI355X kernel written in HIP

```python
import math
import jax, jax.numpy as jnp
from jax import lax
import numpy as np

D_MODEL = 4096
BATCH = 8
SEQ = 2048
DEPTH = 2

HEAD_DIM = 128
CONV_WIDTH = D_MODEL // 2
CONV_K = 3
MOBA_HEADS = (D_MODEL // 2) // HEAD_DIM
MOBA_WIDTH = MOBA_HEADS * HEAD_DIM
MOBA_BLOCK = 256
MOBA_TOPK = 3
MOBA_Q_CHUNK = 32
SB_HEADS = D_MODEL // HEAD_DIM
SB_WIDTH = SB_HEADS * HEAD_DIM
SB_Q_BLOCK = 128
N_MEM = 256
XATTN_HEADS = 4
XATTN_HEAD_DIM = D_MODEL // 16
XATTN_WIDTH = XATTN_HEADS * XATTN_HEAD_DIM
REL_BUCKETS = 32
REL_MAX_DIST = 128
LN_EPS = 1e-5
NEG_INF = -1e30
DEEPNORM_ALPHA = (2 * DEPTH) ** 0.25
DEEPNORM_BETA = (8 * DEPTH) ** -0.25

kernel_name = "hybrid_conv_moba_stickbreak_deepnorm"


def layer_norm(x, g, b):
    xf = x.astype(jnp.float32)
    mu = jnp.mean(xf, axis=-1, keepdims=True)
    var = jnp.mean(jnp.square(xf - mu), axis=-1, keepdims=True)
    return ((xf - mu) * lax.rsqrt(var + LN_EPS)).astype(x.dtype) * g + b


def t5_causal_bucket(dist):
    n = jnp.maximum(dist, 0)
    max_exact = REL_BUCKETS // 2
    nf = jnp.maximum(n, 1).astype(jnp.float32)
    large = max_exact + (jnp.log(nf / max_exact) / math.log(REL_MAX_DIST / max_exact)
                         * (REL_BUCKETS - max_exact)).astype(jnp.int32)
    large = jnp.minimum(large, REL_BUCKETS - 1)
    return jnp.where(n < max_exact, n, large)


def short_conv(h, w):
    c = h.shape[-1]
    return lax.conv_general_dilated(h, w[:, None, :], window_strides=(1,),
                                    padding=[(CONV_K - 1, 0)],
                                    dimension_numbers=('NWC', 'WIO', 'NWC'),
                                    feature_group_count=c)


def moba_attention(q, k, v, rel_bias):
    b, s, h, dh = q.shape
    nb = -(-s // MOBA_BLOCK)
    pad = nb * MOBA_BLOCK - s
    scale = dh ** -0.5
    qh = q.transpose(0, 2, 1, 3)

    def to_blocks(t):
        t = jnp.pad(t, ((0, 0), (0, pad), (0, 0), (0, 0)))
        return t.reshape(b, nb, MOBA_BLOCK, h, dh).transpose(0, 3, 1, 2, 4)

    kbh = to_blocks(k)
    vbh = to_blocks(v)
    rb = rel_bias.T
    qpos = jnp.arange(s, dtype=jnp.int32)
    qblk = qpos // MOBA_BLOCK
    n_sel = min(MOBA_TOPK, nb - 1)
    if n_sel > 0:
        kbar = jnp.mean(kbh.astype(jnp.float32), axis=3)
        gate = jnp.einsum('bhsd,bhnd->bhsn', qh.astype(jnp.float32), kbar)
        past = jnp.arange(nb, dtype=jnp.int32)[None, :] < qblk[:, None]
        gate = jnp.where(past, gate, NEG_INF)
        _, sel = lax.top_k(gate, n_sel)
        sel_valid = sel < qblk[:, None]
    bi = jnp.arange(b)[:, None, None, None]
    hi = jnp.arange(h)[None, :, None, None]
    blk_off = jnp.arange(MOBA_BLOCK, dtype=jnp.int32)
    n_keys_sel = n_sel * MOBA_BLOCK

    def chunk(c):
        q0 = c * MOBA_Q_CHUNK
        qc = lax.dynamic_slice_in_dim(qh, q0, MOBA_Q_CHUNK, axis=2)
        qp = q0 + jnp.arange(MOBA_Q_CHUNK, dtype=jnp.int32)
        ob = q0 // MOBA_BLOCK
        k_own = lax.dynamic_index_in_dim(kbh, ob, axis=2, keepdims=False)
        v_own = lax.dynamic_index_in_dim(vbh, ob, axis=2, keepdims=False)
        kp_own = ob * MOBA_BLOCK + blk_off
        bkt_own = t5_causal_bucket(qp[:, None] - kp_own[None, :])
        lg_own = jnp.einsum('bhqd,bhkd->bhqk', qc, k_own).astype(jnp.float32) * scale + rb[:, bkt_own]
        lg_own = jnp.where(kp_own[None, :] <= qp[:, None], lg_own, NEG_INF)
        if n_sel == 0:
            p = jax.nn.softmax(lg_own, axis=-1).astype(v.dtype)
            return jnp.einsum('bhqk,bhkd->bhqd', p, v_own)
        sc = lax.dynamic_slice_in_dim(sel, q0, MOBA_Q_CHUNK, axis=2)
        vc = lax.dynamic_slice_in_dim(sel_valid, q0, MOBA_Q_CHUNK, axis=2)
        k_sel = kbh[bi, hi, sc]
        v_sel = vbh[bi, hi, sc]
        kp_sel = sc[..., None] * MOBA_BLOCK + blk_off
        bkt_sel = t5_causal_bucket(qp[None, None, :, None, None] - kp_sel)
        lg_sel = (jnp.einsum('bhqd,bhqnkd->bhqnk', qc, k_sel).astype(jnp.float32) * scale
                  + rb[hi[..., None], bkt_sel])
        lg_sel = jnp.where(vc[..., None], lg_sel, NEG_INF).reshape(b, h, MOBA_Q_CHUNK, n_keys_sel)
        p = jax.nn.softmax(jnp.concatenate([lg_sel, lg_own], axis=-1), axis=-1).astype(v.dtype)
        v_sel = v_sel.reshape(b, h, MOBA_Q_CHUNK, n_keys_sel, dh)
        return (jnp.einsum('bhqm,bhqmd->bhqd', p[..., :n_keys_sel], v_sel)
                + jnp.einsum('bhqk,bhkd->bhqd', p[..., n_keys_sel:], v_own))

    out = lax.map(chunk, jnp.arange(s // MOBA_Q_CHUNK, dtype=jnp.int32))
    return out.transpose(1, 0, 3, 2, 4).reshape(b, s, h, dh)


def stick_breaking_attention(q, k, v):
    b, s, h, dh = q.shape
    scale = dh ** -0.5
    outs = []
    for i in range(s // SB_Q_BLOCK):
        q0 = i * SB_Q_BLOCK
        q1 = q0 + SB_Q_BLOCK
        z = jnp.einsum('bqhd,bkhd->bhqk', q[:, q0:q1], k[:, :q1]).astype(jnp.float32) * scale
        qp = jnp.arange(q0, q1, dtype=jnp.int32)
        kp = jnp.arange(q1, dtype=jnp.int32)
        strict = kp[None, :] < qp[:, None]
        log_1m_beta = jnp.where(strict, jax.nn.log_sigmoid(-z), 0.0)
        rem = lax.cumsum(log_1m_beta, axis=3, reverse=True) - log_1m_beta
        w = jnp.where(strict, jnp.exp(jax.nn.log_sigmoid(z) + rem), 0.0).astype(v.dtype)
        outs.append(jnp.einsum('bhqk,bkhd->bqhd', w, v[:, :q1]))
    return jnp.concatenate(outs, axis=1)


def conv_moba_mixer(x, w_in, conv_w, w_out, rel_bias):
    b, s, _ = x.shape
    widths = [CONV_WIDTH] * 4 + [MOBA_WIDTH] * 4
    splits = np.cumsum(widths)[:-1].tolist()
    h, b_gate, c_gate, g_a, q, k, v, g_b = jnp.split(x @ w_in, splits, axis=-1)
    y_a = b_gate * short_conv(c_gate * h, conv_w) * jax.nn.silu(g_a)
    hd = (b, s, MOBA_HEADS, HEAD_DIM)
    y_b = moba_attention(q.reshape(hd), k.reshape(hd), v.reshape(hd), rel_bias).reshape(b, s, MOBA_WIDTH)
    y_b = y_b * jax.nn.silu(g_b)
    return jnp.concatenate([y_a, y_b], axis=-1) @ w_out


def stick_breaking_mixer(x, w_in, w_out):
    b, s, _ = x.shape
    q, k, v, g = jnp.split(x @ w_in, 4, axis=-1)
    hd = (b, s, SB_HEADS, HEAD_DIM)
    y = stick_breaking_attention(q.reshape(hd), k.reshape(hd), v.reshape(hd)).reshape(b, s, SB_WIDTH)
    return (y * jax.nn.silu(g)) @ w_out


def memory_cross_attention(x, mem, w_xq, w_xkv, w_xo):
    b, s, _ = x.shape
    m = mem.shape[1]
    q, g = jnp.split(x @ w_xq, 2, axis=-1)
    k, v = jnp.split(mem @ w_xkv, 2, axis=-1)
    q = q.reshape(b, s, XATTN_HEADS, XATTN_HEAD_DIM)
    k = k.reshape(b, m, XATTN_HEADS, XATTN_HEAD_DIM)
    v = v.reshape(b, m, XATTN_HEADS, XATTN_HEAD_DIM)
    lg = jnp.einsum('bshd,bmhd->bhsm', q, k).astype(jnp.float32) * (XATTN_HEAD_DIM ** -0.5)
    p = jax.nn.softmax(lg, axis=-1).astype(v.dtype)
    o = jnp.einsum('bhsm,bmhd->bshd', p, v).reshape(b, s, XATTN_WIDTH)
    return (o * jax.nn.silu(g)) @ w_xo


def setup_inputs(seed: int = 0) -> dict:
    key = jax.random.key(seed)
    ks = jax.random.split(key, 32)

    def dense(k, fan_in, fan_out, scale=1.0):
        return jax.random.normal(k, (fan_in, fan_out), jnp.float32) * (scale * fan_in ** -0.5)

    def gain(k):
        return 1.0 + 0.02 * jax.random.normal(k, (D_MODEL,), jnp.float32)

    def bias(k):
        return 0.02 * jax.random.normal(k, (D_MODEL,), jnp.float32)

    even_in = 4 * CONV_WIDTH + 4 * MOBA_WIDTH
    return {
        'x': jax.random.normal(ks[0], (BATCH, SEQ, D_MODEL), jnp.float32),
        'mem': jax.random.normal(ks[1], (BATCH, N_MEM, D_MODEL), jnp.float32),
        'rel_bias': 0.5 * jax.random.normal(ks[2], (REL_BUCKETS, MOBA_HEADS), jnp.float32),
        'w_in_0': dense(ks[3], D_MODEL, even_in),
        'conv_w_0': jax.random.normal(ks[4], (CONV_K, CONV_WIDTH), jnp.float32) * CONV_K ** -0.5,
        'w_out_0': dense(ks[5], CONV_WIDTH + MOBA_WIDTH, D_MODEL, DEEPNORM_BETA),
        'ln1_g_0': gain(ks[6]),
        'ln1_b_0': bias(ks[7]),
        'w_xq_0': dense(ks[8], D_MODEL, 2 * XATTN_WIDTH),
        'w_xkv_0': dense(ks[9], D_MODEL, 2 * XATTN_WIDTH),
        'w_xo_0': dense(ks[10], XATTN_WIDTH, D_MODEL, DEEPNORM_BETA),
        'ln2_g_0': gain(ks[11]),
        'ln2_b_0': bias(ks[12]),
        'w_in_1': dense(ks[13], D_MODEL, 4 * SB_WIDTH),
        'w_out_1': dense(ks[14], SB_WIDTH, D_MODEL, DEEPNORM_BETA),
        'ln1_g_1': gain(ks[15]),
        'ln1_b_1': bias(ks[16]),
        'w_xq_1': dense(ks[17], D_MODEL, 2 * XATTN_WIDTH),
        'w_xkv_1': dense(ks[18], D_MODEL, 2 * XATTN_WIDTH),
        'w_xo_1': dense(ks[19], XATTN_WIDTH, D_MODEL, DEEPNORM_BETA),
        'ln2_g_1': gain(ks[20]),
        'ln2_b_1': bias(ks[21]),
    }


def reference(x, mem, rel_bias,
              w_in_0, conv_w_0, w_out_0, ln1_g_0, ln1_b_0, w_xq_0, w_xkv_0, w_xo_0, ln2_g_0, ln2_b_0,
              w_in_1, w_out_1, ln1_g_1, ln1_b_1, w_xq_1, w_xkv_1, w_xo_1, ln2_g_1, ln2_b_1):
    mixer_params = [(w_in_0, conv_w_0, w_out_0), (w_in_1, w_out_1)]
    ln_mix = [(ln1_g_0, ln1_b_0), (ln1_g_1, ln1_b_1)]
    xattn = [(w_xq_0, w_xkv_0, w_xo_0), (w_xq_1, w_xkv_1, w_xo_1)]
    ln_mem = [(ln2_g_0, ln2_b_0), (ln2_g_1, ln2_b_1)]
    for layer in range(DEPTH):
        if layer % 2 == 0:
            w_in, conv_w, w_out = mixer_params[layer]
            y = conv_moba_mixer(x, w_in, conv_w, w_out, rel_bias)
        else:
            w_in, w_out = mixer_params[layer]
            y = stick_breaking_mixer(x, w_in, w_out)
        g1, b1 = ln_mix[layer]
        x = layer_norm(DEEPNORM_ALPHA * x + y, g1, b1)
        w_xq, w_xkv, w_xo = xattn[layer]
        g2, b2 = ln_mem[layer]
        x = layer_norm(DEEPNORM_ALPHA * x + memory_cross_attention(x, mem, w_xq, w_xkv, w_xo), g2, b2)
    return x
```

```cpp
#include <hip/hip_runtime.h>
#include <cstdio>
#include <cstdint>
namespace pg8 {
#define PG8_LAS __attribute__((address_space(3)))
typedef unsigned short bf16_t;
typedef short bf16x8 __attribute__((ext_vector_type(8)));
typedef float f32x4 __attribute__((ext_vector_type(4)));
typedef unsigned u32x4 __attribute__((ext_vector_type(4)));
constexpr int BM = 256, BK = 64, HALF = 128, HTB = HALF * BK * 2  , STAGE_BYTES = 8 * HTB, NXCD = 8, WGM = 8;

__host__ __device__ __forceinline__ int lds_byte(int r, int c) { const int st = (r >> 4) * 2 + (c >> 5), rr = r & 15, cc = c & 31, ob = rr * 64 + cc * 2; return st * 1024 + (ob ^ (((ob >> 9) & 1) << 5)); }
__host__ __device__ __forceinline__ void stage_rc(int b, int& R, int& C) { const int st = b / 1024, sb = b % 1024, swz = sb ^ (((sb >> 9) & 1) << 5); R = (st >> 1) * 16 + swz / 64; C = (st & 1) * 32 + (swz % 64) / 2; }
__host__ __device__ __forceinline__ int perm32(int rho) { const int n = rho >> 4, i = rho & 15; return 8 * (i >> 2) + 4 * n + (i & 3); }

struct Unit { int pm, pn; };
struct Gemm { const bf16_t* A; const bf16_t* Bt; int M, N, K; };

struct StaticOrder {
    int nM, nN, nwg, G, c;
    __host__ __device__ void init(int M, int N, int G_, int c_) { nM = M / BM; nN = N / BM; nwg = nM * nN; G = G_; c = c_; }
    __host__ __device__ bool next(int i, Unit& u) const {
        const long L = (long)i * G + c; if (L >= nwg) return false;
        int wgid = (int)L; { const int q = nwg / NXCD, r = nwg % NXCD, xcd = wgid % NXCD, off = wgid / NXCD; wgid = (xcd < r ? xcd * (q + 1) : r * (q + 1) + (xcd - r) * q) + off; }
        const int nig = WGM * nN, gid = wgid / nig, fm = gid * WGM, gsz = (nM - fm) < WGM ? (nM - fm) : WGM;
        u.pm = fm + ((wgid % nig) % gsz); u.pn = (wgid % nig) / gsz; return true;
    }
    __device__ __forceinline__ void a_ready(const Unit&) const {}
    __device__ __forceinline__ void done(const Unit&) const {}
};

__device__ __forceinline__ unsigned cvt_pk_bf16(float lo, float hi) { unsigned r; asm volatile("v_cvt_pk_bf16_f32 %0, %1, %2" : "=v"(r) : "v"(lo), "v"(hi)); return r; }
typedef float f32x2 __attribute__((ext_vector_type(2)));
struct EpiBf16 {
    static constexpr bool PERM = true, AFTER_DRAIN = false;
    bf16_t* O; int ldc;
    __device__ __forceinline__ void operator()(const f32x4 (&acc)[2][2][4][2], const Unit& u, int wr, int wc, int fr, int fq) const {
        const int row0 = u.pm * BM + wr * 64 + fr; const int col0 = u.pn * BM + wc * 32 + 8 * fq;
#pragma unroll
        for (int ai = 0; ai < 2; ++ai)
#pragma unroll
            for (int m = 0; m < 4; ++m) { bf16_t* rowp = O + (size_t)(row0 + ai * HALF + m * 16) * ldc + col0;
#pragma unroll
                for (int bj = 0; bj < 2; ++bj) { const f32x4 v0 = acc[ai][bj][m][0], v1 = acc[ai][bj][m][1];
                    u32x4 w; w.x = cvt_pk_bf16(v0[0], v0[1]); w.y = cvt_pk_bf16(v0[2], v0[3]); w.z = cvt_pk_bf16(v1[0], v1[1]); w.w = cvt_pk_bf16(v1[2], v1[3]);
                    *(u32x4*)(rowp + bj * HALF) = w; } }
    }
};
struct EpiResF32 {
    static constexpr bool PERM = false, AFTER_DRAIN = false;
    const float* res; float* out; int ldc; float alpha;
    __device__ __forceinline__ void operator()(const f32x4 (&acc)[2][2][4][2], const Unit& u, int wr, int wc, int fr, int fq) const {
        const int row0 = u.pm * BM + wr * 64 + fr, col0 = u.pn * BM + wc * 32 + 4 * fq;
#pragma unroll
        for (int ai = 0; ai < 2; ++ai)
#pragma unroll
            for (int m = 0; m < 4; ++m) { const size_t off = (size_t)(row0 + ai * HALF + m * 16) * ldc + col0;
                f32x4 r[2][2];
#pragma unroll
                for (int bj = 0; bj < 2; ++bj)
#pragma unroll
                    for (int n = 0; n < 2; ++n) r[bj][n] = *(const f32x4*)(res + off + bj * HALF + n * 16);
#pragma unroll
                for (int bj = 0; bj < 2; ++bj)
#pragma unroll
                    for (int n = 0; n < 2; ++n) *(f32x4*)(out + off + bj * HALF + n * 16) = r[bj][n] * alpha + acc[ai][bj][m][n];
                asm volatile("" ::: "memory"); }
    }
};
template <class Epi, class Sched, bool ALIGN_EPI = false, bool SP2 = false>
__device__ __forceinline__ void gemm_phase(PG8_LAS unsigned char* lds, const Gemm g, const Sched& S, const Epi& E) {
    const int tid = threadIdx.x, wid = __builtin_amdgcn_readfirstlane(tid >> 6), lane = tid & 63, wr = wid >> 2, wc = wid & 3, fr = lane & 15, fq = lane >> 4;
    const int K = g.K, nt = K / BK;
    unsigned voffA[2], voffB[2];
#pragma unroll
    for (int i = 0; i < 2; ++i) { int R, C; stage_rc(tid * 16 + i * 8192, R, C); const int Rb = Epi::PERM ? ((R & ~31) + perm32(R & 31)) : R;
        voffA[i] = (unsigned)(R * K + C) * 2u; voffB[i] = (unsigned)(Rb * K + C) * 2u; }
    const size_t kstep = (size_t)(BK * 2);
    const size_t hstep = (size_t)HALF * K * 2;
    const size_t tstep = 2 * hstep;
    const unsigned ldsw = (unsigned)wid * 1024u;
    const int aoff = lds_byte(wr * 64 + fr, fq * 8), boff = lds_byte(wc * 32 + fr, fq * 8);
#define PG8_SA(b, h) (((b) * 2 + (h)) * HTB)
#define PG8_SB(b, h) ((4 + (b) * 2 + (h)) * HTB)
#define PG8_STAGE(bufoff, gbase, voff) do { _Pragma("unroll") for (int _i = 0; _i < 2; ++_i) \
        __builtin_amdgcn_global_load_lds((const unsigned*)((const char*)(gbase) + (voff)[_i]), (PG8_LAS unsigned*)(lds + (bufoff) + ldsw + _i * 8192), 16, 0, 0); } while (0)
#define PG8_LDA(dst, b, h) do { _Pragma("unroll") for (int m = 0; m < 4; ++m) _Pragma("unroll") for (int k = 0; k < 2; ++k) dst[m][k] = *(const PG8_LAS bf16x8*)(lds + PG8_SA(b, h) + aoff + m * 2048 + k * 1024); } while (0)
#define PG8_LDB(dst, b, h) do { _Pragma("unroll") for (int n = 0; n < 2; ++n) _Pragma("unroll") for (int k = 0; k < 2; ++k) dst[n][k] = *(const PG8_LAS bf16x8*)(lds + PG8_SB(b, h) + boff + n * 2048 + k * 1024); } while (0)
#define PG8_MMA(ai, bj, At, Bt) do { __builtin_amdgcn_s_setprio(1); _Pragma("unroll") for (int m = 0; m < 4; ++m) _Pragma("unroll") for (int n = 0; n < 2; ++n) _Pragma("unroll") for (int k = 0; k < 2; ++k) \
        acc[ai][bj][m][n] = __builtin_amdgcn_mfma_f32_16x16x32_bf16(Bt[n][k], At[m][k], acc[ai][bj][m][n], 0, 0, 0); __builtin_amdgcn_s_setprio(0); } while (0)
#define PG8_WAIT_V(n) asm volatile("s_waitcnt vmcnt(" #n ")" ::: "memory")
#define PG8_WAIT_L(n) asm volatile("s_waitcnt lgkmcnt(" #n ")" ::: "memory")
#define PG8_BAR __builtin_amdgcn_s_barrier()
#define PG8_SCHED __builtin_amdgcn_sched_barrier(0)
    Unit cur, nxt; int ui = 0;
    if (!S.next(0, cur)) return;
    f32x4 acc[2][2][4][2];
#pragma unroll
    for (int a = 0; a < 2; ++a)
#pragma unroll
        for (int b = 0; b < 2; ++b)
#pragma unroll
            for (int m = 0; m < 4; ++m)
#pragma unroll
                for (int n = 0; n < 2; ++n) acc[a][b][m][n] = (f32x4){0.f, 0.f, 0.f, 0.f};
    bf16x8 At[4][2], B0[2][2], B1[2][2];
    const char* cA = (const char*)g.A + (size_t)cur.pm * tstep; const char* cB = (const char*)g.Bt + (size_t)cur.pn * tstep;
    S.a_ready(cur);
    if constexpr (SP2) {
        PG8_STAGE(PG8_SB(0, 0), cB, voffB); PG8_STAGE(PG8_SB(0, 1), cB + hstep, voffB); PG8_STAGE(PG8_SA(0, 0), cA, voffA); PG8_STAGE(PG8_SA(0, 1), cA + hstep, voffA);
        if (wr == 1) PG8_BAR;
        PG8_WAIT_V(2); PG8_BAR;
        PG8_STAGE(PG8_SB(1, 0), cB + kstep, voffB); PG8_STAGE(PG8_SA(1, 0), cA + kstep, voffA); PG8_STAGE(PG8_SB(1, 1), cB + hstep + kstep, voffB);
        PG8_WAIT_V(6); PG8_BAR;
    } else {
        PG8_STAGE(PG8_SB(0, 0), cB, voffB); PG8_STAGE(PG8_SA(0, 0), cA, voffA); PG8_STAGE(PG8_SB(0, 1), cB + hstep, voffB); PG8_STAGE(PG8_SA(0, 1), cA + hstep, voffA);
        if (wr == 1) PG8_BAR;
        PG8_WAIT_V(4); PG8_BAR;
        PG8_STAGE(PG8_SB(1, 0), cB + kstep, voffB); PG8_STAGE(PG8_SA(1, 0), cA + kstep, voffA); PG8_STAGE(PG8_SB(1, 1), cB + hstep + kstep, voffB);
        PG8_WAIT_V(6); PG8_BAR;
    }
    for (;;) {
        const bool has_next = S.next(ui + 1, nxt);
        const char* nA = has_next ? (const char*)g.A + (size_t)nxt.pm * tstep : cA; const char* nB = has_next ? (const char*)g.Bt + (size_t)nxt.pn * tstep : cB;
        for (int t = 0; t < nt; t += 2) {
            const bool last = (t == nt - 2);
            const char* a1 = cA + (size_t)(t + 1) * kstep;
            const char* a2 = last ? nA : cA + (size_t)(t + 2) * kstep; const char* b2 = last ? nB : cB + (size_t)(t + 2) * kstep;
            const char* a3 = a2 + kstep; const char* b3 = b2 + kstep;
            if (last && has_next) S.a_ready(nxt);
            if constexpr (SP2) {
            PG8_LDB(B0, 0, 0); PG8_LDB(B1, 0, 1); PG8_SCHED; PG8_LDA(At, 0, 0); PG8_STAGE(PG8_SA(1, 1), a1 + hstep, voffA);
            PG8_WAIT_V(8); PG8_WAIT_L(0); PG8_BAR; PG8_MMA(0, 0, At, B0); PG8_MMA(0, 1, At, B1); PG8_BAR; PG8_SCHED;
            PG8_LDA(At, 0, 1); PG8_STAGE(PG8_SB(0, 0), b2, voffB); PG8_STAGE(PG8_SB(0, 1), b2 + hstep, voffB); PG8_STAGE(PG8_SA(0, 0), a2, voffA);
            PG8_WAIT_V(8); PG8_WAIT_L(0); PG8_BAR; PG8_MMA(1, 0, At, B0); PG8_MMA(1, 1, At, B1); PG8_BAR; PG8_SCHED;
            PG8_LDB(B0, 1, 0); PG8_LDB(B1, 1, 1); PG8_SCHED; PG8_LDA(At, 1, 0); PG8_STAGE(PG8_SA(0, 1), a2 + hstep, voffA);
            PG8_WAIT_V(8); PG8_WAIT_L(0); PG8_BAR; PG8_MMA(0, 0, At, B0); PG8_MMA(0, 1, At, B1); PG8_BAR; PG8_SCHED;
            PG8_LDA(At, 1, 1); PG8_STAGE(PG8_SB(1, 0), b3, voffB); PG8_STAGE(PG8_SB(1, 1), b3 + hstep, voffB); PG8_STAGE(PG8_SA(1, 0), a3, voffA);
            PG8_WAIT_V(8); PG8_WAIT_L(0); PG8_BAR; PG8_MMA(1, 0, At, B0); PG8_MMA(1, 1, At, B1); PG8_BAR; PG8_SCHED;
            } else {
            PG8_LDB(B0, 0, 0); PG8_SCHED; PG8_LDA(At, 0, 0); PG8_STAGE(PG8_SA(1, 1), a1 + hstep, voffA);
            PG8_WAIT_L(8); PG8_BAR; PG8_WAIT_L(0); PG8_MMA(0, 0, At, B0); PG8_BAR; PG8_SCHED;
            PG8_LDB(B1, 0, 1); PG8_STAGE(PG8_SB(0, 0), b2, voffB);
            PG8_BAR; PG8_WAIT_L(0); PG8_MMA(0, 1, At, B1); PG8_BAR;
            PG8_LDA(At, 0, 1); PG8_STAGE(PG8_SA(0, 0), a2, voffA);
            PG8_BAR; PG8_WAIT_L(0); PG8_MMA(1, 0, At, B0); PG8_BAR; PG8_SCHED;
            PG8_STAGE(PG8_SB(0, 1), b2 + hstep, voffB);
            PG8_WAIT_V(6); PG8_BAR; PG8_MMA(1, 1, At, B1); PG8_BAR;
            PG8_LDB(B0, 1, 0); PG8_SCHED; PG8_LDA(At, 1, 0); PG8_STAGE(PG8_SA(0, 1), a2 + hstep, voffA);
            PG8_WAIT_L(8); PG8_BAR; PG8_WAIT_L(0); PG8_MMA(0, 0, At, B0); PG8_BAR; PG8_SCHED;
            PG8_LDB(B1, 1, 1); PG8_STAGE(PG8_SB(1, 0), b3, voffB);
            PG8_BAR; PG8_WAIT_L(0); PG8_MMA(0, 1, At, B1); PG8_BAR;
            PG8_LDA(At, 1, 1); PG8_STAGE(PG8_SA(1, 0), a3, voffA);
            PG8_BAR; PG8_WAIT_L(0); PG8_MMA(1, 0, At, B0); PG8_BAR; PG8_SCHED;
            PG8_STAGE(PG8_SB(1, 1), b3 + hstep, voffB);
            PG8_WAIT_V(6); PG8_BAR; PG8_MMA(1, 1, At, B1); PG8_BAR;
            }
        }
        if constexpr (ALIGN_EPI) { if (wr == 0) PG8_BAR; }
        if constexpr (!Epi::AFTER_DRAIN) { E(acc, cur, wr, wc, fr, fq); S.done(cur); }
        if (!has_next) break;
#pragma unroll
        for (int a = 0; a < 2; ++a)
#pragma unroll
            for (int b = 0; b < 2; ++b)
#pragma unroll
                for (int m = 0; m < 4; ++m)
#pragma unroll
                    for (int n = 0; n < 2; ++n) acc[a][b][m][n] = (f32x4){0.f, 0.f, 0.f, 0.f};
        cur = nxt; cA = nA; cB = nB; ++ui;
        if constexpr (ALIGN_EPI) { if (wr == 1) PG8_BAR; }
    }
    PG8_WAIT_V(0);
    if constexpr (!ALIGN_EPI) { if (wr == 0) PG8_BAR; }
    PG8_BAR;
    if constexpr (Epi::AFTER_DRAIN) { E.fused(acc, cur, wr, wc, fr, fq, lds, wid, lane); S.done(cur); }
#undef PG8_SA
#undef PG8_SB
#undef PG8_STAGE
#undef PG8_LDA
#undef PG8_LDB
#undef PG8_MMA
#undef PG8_WAIT_V
#undef PG8_WAIT_L
#undef PG8_BAR
#undef PG8_SCHED
}
}
#define GAS __attribute__((address_space(1)))
#define LAS __attribute__((address_space(3)))
typedef unsigned short bf16;
typedef unsigned v4u __attribute__((ext_vector_type(4)));
typedef float f32x4 __attribute__((ext_vector_type(4)));
typedef short bf16x8 __attribute__((ext_vector_type(8)));
typedef GAS unsigned gu32;
typedef GAS unsigned long long gu64;
#define RLX_AGENT __ATOMIC_RELAXED, __HIP_MEMORY_SCOPE_AGENT
#define LDS_WAIT() asm volatile("s_waitcnt lgkmcnt(0)" ::: "memory")
#define VM_WAIT() asm volatile("s_waitcnt vmcnt(0)" ::: "memory")
__device__ __forceinline__ unsigned long long rt() { return __builtin_amdgcn_s_memrealtime(); }
__device__ __forceinline__ unsigned f2bf(float f) { unsigned u = __builtin_bit_cast(unsigned, f); return (u + 0x7fffu + ((u >> 16) & 1u)) >> 16; }
__device__ __forceinline__ unsigned pk2(float lo, float hi) { return f2bf(lo) | (f2bf(hi) << 16); }

#define XB_TMO      128
#define XB_XCNT(j)  (256  + 64 * (j))
#define XB_XSUB(j)  (1280 + 64 * (j))
#define XB_XGEN(j)  (2304 + 64 * (j))
#define XB_TOP      3328
#define XB_TOPGEN   3392
#define XCD_BAR_WORDS 3456
#define XB_SPIN_CAP (1u << 22)

__device__ __forceinline__ unsigned xb_ld(unsigned* p)              { return __hip_atomic_load(p, __ATOMIC_RELAXED, __HIP_MEMORY_SCOPE_AGENT); }
__device__ __forceinline__ unsigned xb_add(unsigned* p, unsigned v) { return __hip_atomic_fetch_add(p, v, __ATOMIC_RELAXED, __HIP_MEMORY_SCOPE_AGENT); }
__device__ __forceinline__ unsigned xb_xcc_id() { return (unsigned)__builtin_amdgcn_s_getreg((3 << 11) | 20) & 0xFu; }
#define XB_SPIN(cond, bar) do { unsigned _sp = 0; while (cond) { __builtin_amdgcn_s_sleep(1); \
    if ((++_sp & 255u) == 0u) { if (xb_ld(&(bar)[XB_TMO])) break; if (_sp > XB_SPIN_CAP) { atomicAdd(&(bar)[XB_TMO], 1u); break; } } } } while (0)

struct XcdBarrier {
    unsigned* bar; unsigned x;
    volatile LAS unsigned* st;
};

__device__ __forceinline__ XcdBarrier xcd_barrier_post(unsigned* bar, volatile LAS unsigned* st) {
    XcdBarrier b; b.bar = bar; b.x = xb_xcc_id(); b.st = st;
    if (threadIdx.x == 0) (void)xb_add(&bar[XB_XCNT(b.x)], 1u);
    return b;
}
__device__ __forceinline__ void xcd_barrier_complete(unsigned* bar, unsigned x, unsigned& nloc, unsigned& nx) {
    const unsigned G = gridDim.x * gridDim.y * gridDim.z;
    unsigned sum, cnt, mine, sp = 0u;
    for (;;) {
        sum = 0u; cnt = 0u; mine = 0u;
#pragma unroll
        for (unsigned j = 0; j < 16; ++j) { const unsigned c = xb_ld(&bar[XB_XCNT(j)]); sum += c; cnt += (c > 0u) ? 1u : 0u; mine = (j == x) ? c : mine; }
        if (sum == G) break;
        __builtin_amdgcn_s_sleep(1);
        if ((++sp & 255u) == 0u) { if (xb_ld(&bar[XB_TMO])) break; if (sp > XB_SPIN_CAP) { atomicAdd(&bar[XB_TMO], 1u); break; } }
    }
    nloc = mine > 0u ? mine : 1u; nx = cnt > 0u ? cnt : 1u;
}

__device__ __forceinline__ void xcd_barrier(const XcdBarrier& b) {
    asm volatile("s_waitcnt vmcnt(0)" ::: "memory");
    __syncthreads();
    if (threadIdx.x == 0) {
        unsigned* bar = b.bar;
        __builtin_amdgcn_s_waitcnt(0);
        unsigned nloc = b.st[0], nx = b.st[1];
        if (nloc == 0u) { xcd_barrier_complete(bar, b.x, nloc, nx); b.st[0] = nloc; b.st[1] = nx; }
        const unsigned old = xb_add(&bar[XB_XSUB(b.x)], 1u);
        const unsigned gen = old / nloc;
        if (old + 1u == (gen + 1u) * nloc) {
            __builtin_amdgcn_fence(__ATOMIC_RELEASE, "agent");
            asm volatile("s_waitcnt vmcnt(0)" ::: "memory");
            const unsigned og = xb_add(&bar[XB_TOP], 1u);
            const unsigned tg = og / nx;
            if (og + 1u == (tg + 1u) * nx) xb_add(&bar[XB_TOPGEN], 1u);
            else XB_SPIN(xb_ld(&bar[XB_TOPGEN]) == tg, bar);
            __builtin_amdgcn_fence(__ATOMIC_ACQUIRE, "agent");
            xb_add(&bar[XB_XGEN(b.x)], 1u);
            asm volatile("s_waitcnt vmcnt(0)" ::: "memory");
        } else {
            XB_SPIN(xb_ld(&bar[XB_XGEN(b.x)]) == gen, bar);
            __builtin_amdgcn_fence(__ATOMIC_ACQUIRE, "agent");
            asm volatile("s_waitcnt vmcnt(0)" ::: "memory");
        }
    }
    __syncthreads();
}

constexpr int NWAVES = 8;
constexpr int BATCH = 8, SEQ = 2048, DM = 4096, MROWS = BATCH * SEQ;
constexpr int NPROJ = 16384;
constexpr int HD = 128;
constexpr int L0_H = 0, L0_B = 2048, L0_C = 4096, L0_GA = 6144, L0_Q = 8192, L0_K = 10240, L0_V = 12288, L0_GB = 14336;
constexpr int L1_Q = 0, L1_K = 4096, L1_V = 8192, L1_G = 12288;
constexpr int CONVW = 2048, MOBA_H = 16, MOBA_BLK = 256, MOBA_NB = 8, SB_H = 32;
constexpr int NMEM = 256, XH = 4, XHD = 256, XW = 1024, XQW = 2048;
constexpr float LN_EPS = 1e-5f;
constexpr float DN_ALPHA = 1.41421356237309515f;
constexpr float LOG2E = 1.4426950408889634f;
constexpr int N_IN = 22;
typedef float f32x2v __attribute__((ext_vector_type(2)));
enum { I_X = 0, I_MEM, I_RELB, I_WIN0, I_CONVW, I_WOUT0, I_LN1G0, I_LN1B0, I_WXQ0, I_WXKV0, I_WXO0, I_LN2G0, I_LN2B0, I_WIN1, I_WOUT1, I_LN1G1, I_LN1B1, I_WXQ1, I_WXKV1, I_WXO1, I_LN2G1, I_LN2B1 };

constexpr size_t MiB = 1u << 20;
constexpr size_t WS_CTL = 0, CTL_ZERO_BYTES = 1 * MiB;
constexpr size_t WS_KBAR = 1 * MiB;
constexpr size_t WS_W = 2 * MiB, W_LAYER = 200 * MiB;
constexpr size_t W_IN = 0, W_OUT = 128 * MiB, W_XQ = 160 * MiB, W_XKV = 176 * MiB, W_XO = 192 * MiB;
constexpr size_t WS_MEMB = 402 * MiB;
constexpr size_t WS_KVX = 418 * MiB, KVX_LAYER = 8 * MiB;
constexpr size_t WS_XM = 434 * MiB;
constexpr size_t WS_PROJ = 562 * MiB;
constexpr size_t WS_QG = WS_PROJ, WS_XOIN = WS_PROJ + 64 * MiB;
constexpr size_t WS_END = 1074 * MiB;
constexpr int CW_TMO = 0, CW_CODE = 1;
constexpr int CW_BAR = 4096;
constexpr int RING_OFF = 0, RING_BYTES = 131072;
constexpr int LDSCTL_OFF = RING_BYTES, MISC_OFF = LDSCTL_OFF + 320;
constexpr int LDS_BYTES = 147456;

#define PH_IDS() int tid_ = threadIdx.x; asm volatile("" : "+v"(tid_)); const int tid = tid_, lane = tid & 63, wave = __builtin_amdgcn_readfirstlane(tid >> 6); (void)lane; (void)wave; \
    int vcu_ = F.vcu_, G_ = F.G_; asm volatile("" : "+s"(vcu_), "+s"(G_)); const int vcu = vcu_, G = G_; (void)vcu; (void)G
struct Frame {
    LAS unsigned char* lds;
    volatile LAS unsigned* MISC;
    gu32* ctl;
    int vcu_, G_;
};

__device__ __forceinline__ const float* karg_in(int i) {
    unsigned long long v; const unsigned long long kp = (unsigned long long)__builtin_amdgcn_kernarg_segment_ptr(); const int off = __builtin_amdgcn_readfirstlane(i * 8);
    asm volatile("s_load_dwordx2 %0, %1, %2\n\ts_waitcnt lgkmcnt(0)" : "=&s"(v) : "s"(kp), "s"(off) : "memory");
    return (const float*)v;
}
__device__ __forceinline__ float wave_sum(float v) {
#pragma unroll
    for (int o = 1; o < 64; o <<= 1) v += __shfl_xor(v, o);
    return v;
}
__device__ __forceinline__ float wave_max(float v) {
#pragma unroll
    for (int o = 1; o < 64; o <<= 1) v = fmaxf(v, __shfl_xor(v, o));
    return v;
}
__device__ __forceinline__ float bf_lo(unsigned w) { return __builtin_bit_cast(float, w << 16); }
__device__ __forceinline__ float bf_hi(unsigned w) { return __builtin_bit_cast(float, w & 0xffff0000u); }
__device__ __forceinline__ unsigned pkbf(float lo, float hi) { return pg8::cvt_pk_bf16(lo, hi); }
__device__ __forceinline__ float silu_f(float g) { return g * __builtin_amdgcn_rcpf(1.0f + __builtin_amdgcn_exp2f(-g * LOG2E)); }
__device__ __forceinline__ int t5_bucket(int n) {
    const int b = 16 + (n >= 19) + (n >= 21) + (n >= 24) + (n >= 27) + (n >= 31) + (n >= 35) + (n >= 40) + (n >= 46) + (n >= 52) + (n >= 59) + (n >= 67) + (n >= 77) + (n >= 87) + (n >= 99) + (n >= 113);
    return n < 16 ? n : b;
}

__device__ __forceinline__ void p0_transpose_item(const float* W, int K, int N, bf16* WT, LAS float* scr, int item, int lane) {
    const int nblk = N / 32, kb = item / nblk, nb = item % nblk, k0 = 64 * kb, n0 = 32 * nb;
#pragma unroll 8
    for (int i = 0; i < 32; ++i) { const int kk = 2 * i + (lane >> 5); scr[kk * 33 + (lane & 31)] = W[(size_t)(k0 + kk) * N + n0 + (lane & 31)]; }
    LDS_WAIT(); asm volatile("" ::: "memory");
    const int c = lane & 7;
#pragma unroll
    for (int j = 0; j < 4; ++j) { const int n = (lane >> 3) + 8 * j; const LAS float* s = scr + (8 * c) * 33 + n;
        v4u o; o.x = pkbf(s[0 * 33], s[1 * 33]); o.y = pkbf(s[2 * 33], s[3 * 33]); o.z = pkbf(s[4 * 33], s[5 * 33]); o.w = pkbf(s[6 * 33], s[7 * 33]);
        *(GAS v4u*)(WT + (size_t)(n0 + n) * K + k0 + 8 * c) = o; }
    LDS_WAIT(); asm volatile("" ::: "memory");
}
__device__ __forceinline__ void cvt_bf16_stream(const float* src, bf16* dst, size_t n8  , size_t gtid, size_t gthreads) {
    for (size_t i = gtid; i < n8; i += gthreads) { const f32x4 a = *(const GAS f32x4*)(src + i * 8), b = *(const GAS f32x4*)(src + i * 8 + 4);
        v4u o; o.x = pkbf(a.x, a.y); o.y = pkbf(a.z, a.w); o.z = pkbf(b.x, b.y); o.w = pkbf(b.z, b.w); *(GAS v4u*)(dst + i * 8) = o; }
}
struct P0Mat { const float* W; bf16* WT; int K, N, items; };
__device__ __forceinline__ void p0_prologue(Frame& F, unsigned char* ws) {
    PH_IDS();
    LAS float* scr = (LAS float*)(F.lds + RING_OFF + wave * 16384);
    const int gw = vcu * NWAVES + wave, NGW = G * NWAVES;
    constexpr int IT_IN = (DM / 64) * (NPROJ / 32), IT_OUT = (DM / 64) * (DM / 32), IT_XQ = (DM / 64) * (XQW / 32), IT_XO = (XW / 64) * (DM / 32);
    constexpr int IT_LAYER = IT_IN + IT_OUT + 2 * IT_XQ + IT_XO;
    for (int it = gw; it < 2 * IT_LAYER; it += NGW) {
        const int L = it >= IT_LAYER ? 1 : 0; int r = it - L * IT_LAYER;
        unsigned char* wl = ws + WS_W + (size_t)L * W_LAYER;
        if (r < IT_IN) { p0_transpose_item(karg_in(L ? I_WIN1 : I_WIN0), DM, NPROJ, (bf16*)(wl + W_IN), scr, r, lane); continue; } r -= IT_IN;
        if (r < IT_OUT) { p0_transpose_item(karg_in(L ? I_WOUT1 : I_WOUT0), DM, DM, (bf16*)(wl + W_OUT), scr, r, lane); continue; } r -= IT_OUT;
        if (r < IT_XQ) { p0_transpose_item(karg_in(L ? I_WXQ1 : I_WXQ0), DM, XQW, (bf16*)(wl + W_XQ), scr, r, lane); continue; } r -= IT_XQ;
        if (r < IT_XQ) { p0_transpose_item(karg_in(L ? I_WXKV1 : I_WXKV0), DM, XQW, (bf16*)(wl + W_XKV), scr, r, lane); continue; } r -= IT_XQ;
        p0_transpose_item(karg_in(L ? I_WXO1 : I_WXO0), XW, DM, (bf16*)(wl + W_XO), scr, r, lane);
    }
    const size_t gtid = (size_t)vcu * 512 + tid, gth = (size_t)G * 512;
    cvt_bf16_stream(karg_in(I_X), (bf16*)(ws + WS_XM), (size_t)MROWS * DM / 8, gtid, gth);
    cvt_bf16_stream(karg_in(I_MEM), (bf16*)(ws + WS_MEMB), (size_t)BATCH * NMEM * DM / 8, gtid, gth);
}

template <bool WRITE_BF16>
__device__ __forceinline__ void ln_phase(Frame& F, float* X, bf16* XB, const float* g, const float* b) {
    PH_IDS();
    LAS f32x4* gl = (LAS f32x4*)(F.lds + RING_OFF); LAS f32x4* bl = (LAS f32x4*)(F.lds + RING_OFF + 16384);
    for (int i = tid; i < DM / 4; i += NWAVES * 64) { gl[i] = ((const GAS f32x4*)g)[i]; bl[i] = ((const GAS f32x4*)b)[i]; }
    __syncthreads();
    const int gw = vcu * NWAVES + wave, NGW = G * NWAVES;
    for (int m = gw; m < MROWS; m += NGW) {
        GAS f32x4* xr = (GAS f32x4*)(X + (size_t)m * DM) + lane;
        f32x4 v[16]; float s = 0.f;
#pragma unroll
        for (int j = 0; j < 16; ++j) { v[j] = xr[64 * j]; s += (v[j].x + v[j].y) + (v[j].z + v[j].w); }
        const float mean = wave_sum(s) * (1.f / DM); float s2 = 0.f;
#pragma unroll
        for (int j = 0; j < 16; ++j) { v[j] = v[j] - mean; s2 += (v[j].x * v[j].x + v[j].y * v[j].y) + (v[j].z * v[j].z + v[j].w * v[j].w); }
        const float rstd = 1.f / sqrtf(wave_sum(s2) * (1.f / DM) + LN_EPS);
        GAS unsigned long long* o8 = (GAS unsigned long long*)(XB + (size_t)m * DM) + lane;
#pragma unroll
        for (int j = 0; j < 16; ++j) { const f32x4 o = v[j] * rstd * gl[64 * j + lane] + bl[64 * j + lane]; xr[64 * j] = o;
            if (WRITE_BF16) o8[64 * j] = (unsigned long long)pkbf(o.x, o.y) | ((unsigned long long)pkbf(o.z, o.w) << 32); }
    }
    __syncthreads();
}

__device__ __forceinline__ void conv_phase(Frame& F, const bf16* P, bf16* MIX, const float* cw) {
    PH_IDS();
    const int half = tid >> 8, c0 = (tid & 255) * 8;
    float w0[8], w1[8], w2[8];
#pragma unroll
    for (int i = 0; i < 8; ++i) { w0[i] = cw[c0 + i]; w1[i] = cw[CONVW + c0 + i]; w2[i] = cw[2 * CONVW + c0 + i]; }
    for (int item = vcu; item < MROWS / 32; item += G) {
        const int m0 = item * 32 + half * 16; const bool hist = (m0 & (SEQ - 1)) != 0;
        float p2[8], p1[8];
#pragma unroll
        for (int i = 0; i < 8; ++i) { p2[i] = 0.f; p1[i] = 0.f; }
        if (hist) {
            const bf16* r2 = P + (size_t)(m0 - 2) * NPROJ + c0; const bf16* r1 = P + (size_t)(m0 - 1) * NPROJ + c0;
            const v4u h2 = *(const GAS v4u*)(r2 + L0_H), c2 = *(const GAS v4u*)(r2 + L0_C), h1 = *(const GAS v4u*)(r1 + L0_H), c1 = *(const GAS v4u*)(r1 + L0_C);
#pragma unroll
            for (int i = 0; i < 4; ++i) { p2[2 * i] = bf_lo(h2[i]) * bf_lo(c2[i]); p2[2 * i + 1] = bf_hi(h2[i]) * bf_hi(c2[i]); p1[2 * i] = bf_lo(h1[i]) * bf_lo(c1[i]); p1[2 * i + 1] = bf_hi(h1[i]) * bf_hi(c1[i]); }
        }
#pragma unroll 2
        for (int r = 0; r < 16; ++r) {
            const bf16* rp = P + (size_t)(m0 + r) * NPROJ + c0;
            const v4u hv = *(const GAS v4u*)(rp + L0_H), bv = *(const GAS v4u*)(rp + L0_B), cv = *(const GAS v4u*)(rp + L0_C), gv = *(const GAS v4u*)(rp + L0_GA);
            float y[8];
#pragma unroll
            for (int i = 0; i < 4; ++i) {
                const float ch0 = bf_lo(hv[i]) * bf_lo(cv[i]), ch1 = bf_hi(hv[i]) * bf_hi(cv[i]);
                const float cv0 = w0[2 * i] * p2[2 * i] + w1[2 * i] * p1[2 * i] + w2[2 * i] * ch0, cv1 = w0[2 * i + 1] * p2[2 * i + 1] + w1[2 * i + 1] * p1[2 * i + 1] + w2[2 * i + 1] * ch1;
                y[2 * i] = bf_lo(bv[i]) * cv0 * silu_f(bf_lo(gv[i])); y[2 * i + 1] = bf_hi(bv[i]) * cv1 * silu_f(bf_hi(gv[i]));
                p2[2 * i] = p1[2 * i]; p2[2 * i + 1] = p1[2 * i + 1]; p1[2 * i] = ch0; p1[2 * i + 1] = ch1;
            }
            v4u o; o.x = pkbf(y[0], y[1]); o.y = pkbf(y[2], y[3]); o.z = pkbf(y[4], y[5]); o.w = pkbf(y[6], y[7]);
            *(GAS v4u*)(MIX + (size_t)(m0 + r) * DM + c0) = o;
        }
    }
}
__device__ __forceinline__ void kbar_phase(Frame& F, const bf16* P, float* KBAR) {
    PH_IDS();
    LAS float* red = (LAS float*)(F.lds + RING_OFF);
    const int rg = tid >> 5, cgp = tid & 31;
    for (int item = vcu; item < BATCH * MOBA_NB * 8; item += G) {
        const int cgrp = item & 7, bn = item >> 3;
        const bf16* src = P + (size_t)(bn * MOBA_BLK + rg * 16) * NPROJ + L0_K + cgrp * 256 + cgp * 8;
        float a[8];
#pragma unroll
        for (int i = 0; i < 8; ++i) a[i] = 0.f;
#pragma unroll 4
        for (int r = 0; r < 16; ++r) { const v4u v = *(const GAS v4u*)(src + (size_t)r * NPROJ);
#pragma unroll
            for (int i = 0; i < 4; ++i) { a[2 * i] += bf_lo(v[i]); a[2 * i + 1] += bf_hi(v[i]); } }
#pragma unroll
        for (int i = 0; i < 8; ++i) red[rg * 256 + cgp * 8 + i] = a[i];
        __syncthreads();
        if (tid < 256) { float s = 0.f;
#pragma unroll
            for (int q = 0; q < 16; ++q) s += red[q * 256 + tid];
            KBAR[(size_t)bn * 2048 + cgrp * 256 + tid] = s * (1.f / MOBA_BLK); }
        __syncthreads();
    }
}

template <int D> __device__ __forceinline__ float dot_row(const LAS float* qs, const bf16* kp) {
    float s0 = 0.f, s1 = 0.f;
#pragma unroll 4
    for (int c = 0; c < D / 8; ++c) { const v4u kv = *(const GAS v4u*)(kp + c * 8); const f32x4 qa = *(const LAS f32x4*)(qs + c * 8), qb = *(const LAS f32x4*)(qs + c * 8 + 4);
        s0 += bf_lo(kv.x) * qa.x + bf_hi(kv.x) * qa.y + bf_lo(kv.y) * qa.z + bf_hi(kv.y) * qa.w;
        s1 += bf_lo(kv.z) * qb.x + bf_hi(kv.z) * qb.y + bf_lo(kv.w) * qb.z + bf_hi(kv.w) * qb.w; }
    return s0 + s1;
}
__device__ __forceinline__ float log_sigmoid_f(float x) { return fminf(x, 0.f) - __logf(1.f + __expf(-fabsf(x))); }

__device__ __forceinline__ void moba_naive_phase(Frame& F, const bf16* P, const float* KBAR, const float* relb, bf16* MIX) {
    PH_IDS();
    LAS float* qs = (LAS float*)(F.lds + RING_OFF + wave * 8192);
    LAS float* sc = qs + 256;
    const int gw = vcu * NWAVES + wave, NGW = G * NWAVES;
    const float scale = 0.08838834764831845f, NEG = -__builtin_inff();
    for (int task = gw; task < MROWS * MOBA_H; task += NGW) {
        const int h = task & 15, m = task >> 4, b = m >> 11, t = m & (SEQ - 1), qb = t >> 8;
        const unsigned qw = *(const GAS unsigned*)(P + (size_t)m * NPROJ + L0_Q + h * HD + 2 * lane);
        const float q0 = bf_lo(qw), q1 = bf_hi(qw);
        qs[2 * lane] = q0; qs[2 * lane + 1] = q1;
        LDS_WAIT();
        float gate[7];
#pragma unroll
        for (int n = 0; n < 7; ++n) { float pg = 0.f;
            if (n < qb) { const f32x2v kb = *(const GAS f32x2v*)(KBAR + (size_t)(b * 8 + n) * 2048 + h * HD + 2 * lane); pg = q0 * kb.x + q1 * kb.y; }
            gate[n] = wave_sum(pg); }
        unsigned sel = 0;
#pragma unroll
        for (int n = 0; n < 7; ++n) { int rank = 0;
#pragma unroll
            for (int n2 = 0; n2 < 7; ++n2) rank += (n2 < qb && (gate[n2] > gate[n] || (gate[n2] == gate[n] && n2 < n))) ? 1 : 0;
            if (n < qb && (qb <= 3 || rank < 3)) sel |= 1u << n; }
        sel = (unsigned)__builtin_amdgcn_readfirstlane((int)sel);
        int nk = 0; float mx = NEG;
        for (int n = 0; n <= qb; ++n) {
            if (n < qb && !((sel >> n) & 1u)) continue;
            const int kend = (n == qb) ? (t & 255) + 1 : MOBA_BLK;
            for (int k0 = 0; k0 < kend; k0 += 64) {
                const int kin = k0 + lane, key = n * MOBA_BLK + kin;
                float s = dot_row<HD>(qs, P + (size_t)(b * SEQ + key) * NPROJ + L0_K + h * HD);
                const int dist = t - key;
                s = s * scale + relb[t5_bucket(dist < 0 ? 0 : dist) * MOBA_H + h];
                s = kin < kend ? s : NEG;
                sc[nk + lane] = s; mx = fmaxf(mx, s); nk += 64;
            }
        }
        mx = wave_max(mx);
        LDS_WAIT();
        float lsum = 0.f;
        for (int i = lane; i < nk; i += 64) { const float p = __builtin_amdgcn_exp2f((sc[i] - mx) * LOG2E); sc[i] = p; lsum += p; }
        lsum = wave_sum(lsum);
        LDS_WAIT();
        float o0 = 0.f, o1 = 0.f; int idx = 0;
        for (int n = 0; n <= qb; ++n) {
            if (n < qb && !((sel >> n) & 1u)) continue;
            const int kend = (n == qb) ? (t & 255) + 1 : MOBA_BLK;
            const bf16* vp = P + (size_t)(b * SEQ + n * MOBA_BLK) * NPROJ + L0_V + h * HD + 2 * lane;
#pragma unroll 4
            for (int j = 0; j < kend; ++j) { const float p = sc[idx + j]; const unsigned vw = *(const GAS unsigned*)(vp + (size_t)j * NPROJ); o0 += p * bf_lo(vw); o1 += p * bf_hi(vw); }
            idx += (kend + 63) & ~63;
        }
        const float inv = 1.f / lsum;
        const unsigned gwd = *(const GAS unsigned*)(P + (size_t)m * NPROJ + L0_GB + h * HD + 2 * lane);
        *(GAS unsigned*)(MIX + (size_t)m * DM + CONVW + h * HD + 2 * lane) = pkbf(o0 * inv * silu_f(bf_lo(gwd)), o1 * inv * silu_f(bf_hi(gwd)));
        LDS_WAIT();
    }
}

__device__ __forceinline__ void sb_naive_phase(Frame& F, const bf16* P, bf16* MIX) {
    PH_IDS();
    LAS float* qs = (LAS float*)(F.lds + RING_OFF + wave * 8192);
    LAS float* sc = qs + 256;
    const int gw = vcu * NWAVES + wave, NGW = G * NWAVES;
    const float scale = 0.08838834764831845f;
    for (int task = gw; task < MROWS * SB_H; task += NGW) {
        const int h = task & 31, m = task >> 5, b = m >> 11, t = m & (SEQ - 1);
        const unsigned qw = *(const GAS unsigned*)(P + (size_t)m * NPROJ + L1_Q + h * HD + 2 * lane);
        qs[2 * lane] = bf_lo(qw); qs[2 * lane + 1] = bf_hi(qw);
        LDS_WAIT();
        float R = 0.f, o0 = 0.f, o1 = 0.f;
        for (int kend = t; kend > 0; kend -= 64) {
            const int key = kend - 1 - lane; const bool valid = key >= 0;
            const float z = dot_row<HD>(qs, P + (size_t)(b * SEQ + (valid ? key : 0)) * NPROJ + L1_K + h * HD) * scale;
            const float lsn = valid ? log_sigmoid_f(-z) : 0.f;
            float inc = lsn;
#pragma unroll
            for (int d = 1; d < 64; d <<= 1) { const float u = __shfl_up(inc, d); if (lane >= d) inc += u; }
            const float excl = inc - lsn, total = __shfl(inc, 63);
            sc[lane] = valid ? __expf(log_sigmoid_f(z) + R + excl) : 0.f;
            LDS_WAIT();
            const int cnt = kend < 64 ? kend : 64;
            const bf16* vp = P + (size_t)(b * SEQ + kend - 1) * NPROJ + L1_V + h * HD + 2 * lane;
#pragma unroll 4
            for (int j = 0; j < cnt; ++j) { const float p = sc[j]; const unsigned vw = *(const GAS unsigned*)(vp - (size_t)j * NPROJ); o0 += p * bf_lo(vw); o1 += p * bf_hi(vw); }
            LDS_WAIT();
            R += total;
            if (R < -88.f) break;
        }
        const unsigned gwd = *(const GAS unsigned*)(P + (size_t)m * NPROJ + L1_G + h * HD + 2 * lane);
        *(GAS unsigned*)(MIX + (size_t)m * DM + h * HD + 2 * lane) = pkbf(o0 * silu_f(bf_lo(gwd)), o1 * silu_f(bf_hi(gwd)));
    }
}

__device__ __forceinline__ void xattn_naive_phase(Frame& F, const bf16* QG, const bf16* KVX, bf16* XOIN) {
    PH_IDS();
    LAS float* qs = (LAS float*)(F.lds + RING_OFF + wave * 8192);
    LAS float* sc = qs + 256;
    const int gw = vcu * NWAVES + wave, NGW = G * NWAVES;
    for (int task = gw; task < MROWS * XH; task += NGW) {
        const int xh = task & 3, m = task >> 2, b = m >> 11;
        const unsigned long long qw = *(const GAS unsigned long long*)(QG + (size_t)m * XQW + xh * XHD + 4 * lane);
        qs[4 * lane] = bf_lo((unsigned)qw); qs[4 * lane + 1] = bf_hi((unsigned)qw); qs[4 * lane + 2] = bf_lo((unsigned)(qw >> 32)); qs[4 * lane + 3] = bf_hi((unsigned)(qw >> 32));
        LDS_WAIT();
        float mx = -__builtin_inff();
#pragma unroll 1
        for (int c = 0; c < 4; ++c) { const int key = c * 64 + lane;
            const float s = dot_row<XHD>(qs, KVX + (size_t)(b * NMEM + key) * XQW + xh * XHD) * 0.0625f; sc[key] = s; mx = fmaxf(mx, s); }
        mx = wave_max(mx);
        LDS_WAIT();
        float lsum = 0.f;
#pragma unroll
        for (int c = 0; c < 4; ++c) { const float p = __builtin_amdgcn_exp2f((sc[c * 64 + lane] - mx) * LOG2E); sc[c * 64 + lane] = p; lsum += p; }
        lsum = wave_sum(lsum);
        LDS_WAIT();
        float o[4] = {0.f, 0.f, 0.f, 0.f};
        const bf16* vp = KVX + (size_t)(b * NMEM) * XQW + XW + xh * XHD + 4 * lane;
#pragma unroll 4
        for (int j = 0; j < NMEM; ++j) { const float p = sc[j]; const unsigned long long vw = *(const GAS unsigned long long*)(vp + (size_t)j * XQW);
            o[0] += p * bf_lo((unsigned)vw); o[1] += p * bf_hi((unsigned)vw); o[2] += p * bf_lo((unsigned)(vw >> 32)); o[3] += p * bf_hi((unsigned)(vw >> 32)); }
        const float inv = 1.f / lsum;
        const unsigned long long gq = *(const GAS unsigned long long*)(QG + (size_t)m * XQW + XW + xh * XHD + 4 * lane);
        const unsigned r0 = pkbf(o[0] * inv * silu_f(bf_lo((unsigned)gq)), o[1] * inv * silu_f(bf_hi((unsigned)gq)));
        const unsigned r1 = pkbf(o[2] * inv * silu_f(bf_lo((unsigned)(gq >> 32))), o[3] * inv * silu_f(bf_hi((unsigned)(gq >> 32))));
        *(GAS unsigned long long*)(XOIN + (size_t)m * XW + xh * XHD + 4 * lane) = (unsigned long long)r0 | ((unsigned long long)r1 << 32);
        LDS_WAIT();
    }
}

#ifndef MK_PER_PHASE
#define MK_PER_PHASE 1
#endif
constexpr int NPHASES = 19;
struct Args { const float* in[N_IN]; float* out; unsigned char* ws; int ph_lo, ph_hi; };
template <class Epi> __device__ __forceinline__ void run_gemm(Frame& F, const bf16* A, const bf16* Bt, int M, int N, int K, const Epi& E) {
    int c_ = blockIdx.x, G_ = F.G_; asm volatile("" : "+s"(c_), "+s"(G_));
    pg8::Gemm g{A, Bt, M, N, K}; pg8::StaticOrder S; S.init(M, N, G_, c_);
    pg8::gemm_phase<Epi, pg8::StaticOrder, true, true>(F.lds + RING_OFF, g, S, E);
}
__global__ void __launch_bounds__(NWAVES * 64, 2) mega_fwd(Args args) {
    extern __shared__ __attribute__((aligned(16))) unsigned char lds[];
    Frame F;
    F.lds = (LAS unsigned char*)lds;
    F.MISC = (volatile LAS unsigned*)(F.lds + MISC_OFF);
    F.G_ = gridDim.x; { const int bx = blockIdx.x; F.vcu_ = (F.G_ % 8 == 0) ? (bx % 8) * (F.G_ / 8) + bx / 8 : bx; }
    unsigned char* ws = args.ws;
    F.ctl = (gu32*)(ws + WS_CTL);
    for (int u = threadIdx.x; u < (LDS_BYTES - LDSCTL_OFF) / 4; u += NWAVES * 64) ((LAS unsigned*)(F.lds + LDSCTL_OFF))[u] = 0u;
    __syncthreads();
    XcdBarrier bar = xcd_barrier_post((unsigned*)(F.ctl + CW_BAR), F.MISC + 8);
    const int lo = args.ph_lo, hi = args.ph_hi;
#define IN(k) (lo <= (k) && (k) < hi)
#define SEAM(k) do { if (IN(k) && IN((k) + 1)) xcd_barrier(bar); } while (0)
#define PHASE_PTRS() unsigned char* wsp = ws; int Lp = L; asm volatile("" : "+s"(wsp), "+s"(Lp)); unsigned char* const wl = wsp + WS_W + (size_t)Lp * W_LAYER; (void)wl; \
        bf16* const XM = (bf16*)(wsp + WS_XM); bf16* const PROJ = (bf16*)(wsp + WS_PROJ); bf16* const QG = (bf16*)(wsp + WS_QG); bf16* const XOIN = (bf16*)(wsp + WS_XOIN); \
        bf16* const KVX = (bf16*)(wsp + WS_KVX + (size_t)Lp * KVX_LAYER); (void)XM; (void)PROJ; (void)QG; (void)XOIN; (void)KVX
    float* const OUT = args.out;

    if (IN(0)) { p0_prologue(F, ws); SEAM(0); }

    { constexpr int L = 0;
        const int pb = 1 + 9 * L;
        if (IN(pb + 0)) { PHASE_PTRS(); pg8::EpiBf16 E{PROJ, NPROJ}; run_gemm(F, XM, (const bf16*)(wl + W_IN), MROWS, NPROJ, DM, E); SEAM(pb + 0); }
        if (IN(pb + 1)) { if (L == 0) { PHASE_PTRS(); conv_phase(F, PROJ, XM, karg_in(I_CONVW)); kbar_phase(F, PROJ, (float*)(wsp + WS_KBAR)); SEAM(pb + 1); } }
        if (IN(pb + 2)) { PHASE_PTRS(); if (L == 0) moba_naive_phase(F, PROJ, (const float*)(wsp + WS_KBAR), karg_in(I_RELB), XM); else sb_naive_phase(F, PROJ, XM); SEAM(pb + 2); }
        if (IN(pb + 3)) { PHASE_PTRS(); pg8::EpiResF32 E{L == 0 ? karg_in(I_X) : (const float*)OUT, OUT, DM, DN_ALPHA}; run_gemm(F, XM, (const bf16*)(wl + W_OUT), MROWS, DM, DM, E); SEAM(pb + 3); }
        if (IN(pb + 4)) { PHASE_PTRS(); ln_phase<true>(F, OUT, XM, karg_in(L ? I_LN1G1 : I_LN1G0), karg_in(L ? I_LN1B1 : I_LN1B0)); SEAM(pb + 4); }
        if (IN(pb + 5)) { { PHASE_PTRS(); pg8::EpiBf16 E{QG, XQW}; run_gemm(F, XM, (const bf16*)(wl + W_XQ), MROWS, XQW, DM, E); }
                          { PHASE_PTRS(); pg8::EpiBf16 E{KVX, XQW}; run_gemm(F, (const bf16*)(wsp + WS_MEMB), (const bf16*)(wl + W_XKV), BATCH * NMEM, XQW, DM, E); } SEAM(pb + 5); }
        if (IN(pb + 6)) { PHASE_PTRS(); xattn_naive_phase(F, QG, KVX, XOIN); SEAM(pb + 6); }
        if (IN(pb + 7)) { PHASE_PTRS(); pg8::EpiResF32 E{(const float*)OUT, OUT, DM, DN_ALPHA}; run_gemm(F, XOIN, (const bf16*)(wl + W_XO), MROWS, DM, XW, E); SEAM(pb + 7); }
        if (IN(pb + 8)) { PHASE_PTRS(); if (L == 0) ln_phase<true>(F, OUT, XM, karg_in(I_LN2G0), karg_in(I_LN2B0)); else ln_phase<false>(F, OUT, XM, karg_in(I_LN2G1), karg_in(I_LN2B1)); SEAM(pb + 8); }

    }
    { constexpr int L = 1;
        const int pb = 1 + 9 * L;
        if (IN(pb + 0)) { PHASE_PTRS(); pg8::EpiBf16 E{PROJ, NPROJ}; run_gemm(F, XM, (const bf16*)(wl + W_IN), MROWS, NPROJ, DM, E); SEAM(pb + 0); }
        if (IN(pb + 1)) { if (L == 0) { PHASE_PTRS(); conv_phase(F, PROJ, XM, karg_in(I_CONVW)); kbar_phase(F, PROJ, (float*)(wsp + WS_KBAR)); SEAM(pb + 1); } }
        if (IN(pb + 2)) { PHASE_PTRS(); if (L == 0) moba_naive_phase(F, PROJ, (const float*)(wsp + WS_KBAR), karg_in(I_RELB), XM); else sb_naive_phase(F, PROJ, XM); SEAM(pb + 2); }
        if (IN(pb + 3)) { PHASE_PTRS(); pg8::EpiResF32 E{L == 0 ? karg_in(I_X) : (const float*)OUT, OUT, DM, DN_ALPHA}; run_gemm(F, XM, (const bf16*)(wl + W_OUT), MROWS, DM, DM, E); SEAM(pb + 3); }
        if (IN(pb + 4)) { PHASE_PTRS(); ln_phase<true>(F, OUT, XM, karg_in(L ? I_LN1G1 : I_LN1G0), karg_in(L ? I_LN1B1 : I_LN1B0)); SEAM(pb + 4); }
        if (IN(pb + 5)) { { PHASE_PTRS(); pg8::EpiBf16 E{QG, XQW}; run_gemm(F, XM, (const bf16*)(wl + W_XQ), MROWS, XQW, DM, E); }
                          { PHASE_PTRS(); pg8::EpiBf16 E{KVX, XQW}; run_gemm(F, (const bf16*)(wsp + WS_MEMB), (const bf16*)(wl + W_XKV), BATCH * NMEM, XQW, DM, E); } SEAM(pb + 5); }
        if (IN(pb + 6)) { PHASE_PTRS(); xattn_naive_phase(F, QG, KVX, XOIN); SEAM(pb + 6); }
        if (IN(pb + 7)) { PHASE_PTRS(); pg8::EpiResF32 E{(const float*)OUT, OUT, DM, DN_ALPHA}; run_gemm(F, XOIN, (const bf16*)(wl + W_XO), MROWS, DM, XW, E); SEAM(pb + 7); }
        if (IN(pb + 8)) { PHASE_PTRS(); if (L == 0) ln_phase<true>(F, OUT, XM, karg_in(I_LN2G0), karg_in(I_LN2B0)); else ln_phase<false>(F, OUT, XM, karg_in(I_LN2G1), karg_in(I_LN2B1)); SEAM(pb + 8); }

    }
#undef PHASE_PTRS
#undef IN
#undef SEAM
}

extern "C" void kernel_launch(void* const* d_in, const int* in_sizes, int n_in, void* d_out, int out_size, void* d_ws, size_t ws_size, hipStream_t stream) {
    static int grid = 0;
    if (grid == 0) {
        if (n_in != N_IN || in_sizes[0] != MROWS * DM || out_size != MROWS * DM || ws_size < WS_END) { fprintf(stderr, "kernel_launch: unexpected shapes / workspace (n_in %d, ws %zu, need %zu); nothing launched\n", n_in, ws_size, (size_t)WS_END); grid = -1; return; }
        int dev = 0, cus = 0, per_cu = 0;
        if (hipGetDevice(&dev) != hipSuccess || hipDeviceGetAttribute(&cus, hipDeviceAttributeMultiprocessorCount, dev) != hipSuccess) { grid = -1; return; }
        if (hipFuncSetAttribute((const void*)mega_fwd, hipFuncAttributeMaxDynamicSharedMemorySize, LDS_BYTES) != hipSuccess) { fprintf(stderr, "kernel_launch: hipFuncSetAttribute failed\n"); grid = -1; return; }
        if (hipOccupancyMaxActiveBlocksPerMultiprocessor(&per_cu, (const void*)mega_fwd, NWAVES * 64, LDS_BYTES) != hipSuccess || per_cu < 1) { fprintf(stderr, "kernel_launch: occupancy query says %d workgroups per CU\n", per_cu); }
        (void)hipGetLastError();
        grid = cus;
    }
    if (grid < 0) return;
    if (hipMemsetAsync((char*)d_ws + WS_CTL, 0, CTL_ZERO_BYTES, stream) != hipSuccess) return;
    Args a{};
    for (int i = 0; i < N_IN; ++i) a.in[i] = (const float*)d_in[i];
    a.out = (float*)d_out; a.ws = (unsigned char*)d_ws;
#if MK_PER_PHASE
    for (int p = 0; p < NPHASES; ++p) { a.ph_lo = p; a.ph_hi = p + 1; hipLaunchKernelGGL(mega_fwd, dim3(grid), dim3(NWAVES * 64), LDS_BYTES, stream, a); }
#else
    a.ph_lo = 0; a.ph_hi = NPHASES;
    hipLaunchKernelGGL(mega_fwd, dim3(grid), dim3(NWAVES * 64), LDS_BYTES, stream, a);
#endif
    const hipError_t le = hipPeekAtLastError();
    if (le != hipSuccess) fprintf(stderr, "kernel_launch: launch failed: %s\n", hipGetErrorName(le));
}
```

```cpp
#include <hip/hip_runtime.h>
#include <cstdio>
#include <cstdint>
namespace pg8 {
#define PG8_LAS __attribute__((address_space(3)))
typedef unsigned short bf16_t;
typedef short bf16x8 __attribute__((ext_vector_type(8)));
typedef _Float16 f16x8 __attribute__((ext_vector_type(8)));
typedef int i32x4 __attribute__((ext_vector_type(4)));
typedef int i32x8 __attribute__((ext_vector_type(8)));
typedef float f32x4 __attribute__((ext_vector_type(4)));
typedef unsigned u32x4 __attribute__((ext_vector_type(4)));
constexpr int BM = 256, BK = 64, HALF = 128, HTB = HALF * BK * 2  , STAGE_BYTES = 8 * HTB, NXCD = 8, WGM = 8;

__host__ __device__ __forceinline__ int lds_byte(int r, int c) { const int st = (r >> 4) * 2 + (c >> 5), rr = r & 15, cc = c & 31, ob = rr * 64 + cc * 2; return st * 1024 + (ob ^ (((ob >> 9) & 1) << 5)); }
__host__ __device__ __forceinline__ void stage_rc(int b, int& R, int& C) { const int st = b / 1024, sb = b % 1024, swz = sb ^ (((sb >> 9) & 1) << 5); R = (st >> 1) * 16 + swz / 64; C = (st & 1) * 32 + (swz % 64) / 2; }
__host__ __device__ __forceinline__ int perm32(int rho) { const int n = rho >> 4, i = rho & 15; return 8 * (i >> 2) + 4 * n + (i & 3); }

struct Unit { int pm, pn; };
struct Gemm { const bf16_t* A; const bf16_t* Bt; int M, N, K; };

struct StaticOrder {
    int nM, nN, nwg, G, c;
    __host__ __device__ void init(int M, int N, int G_, int c_) { nM = M / BM; nN = N / BM; nwg = nM * nN; G = G_; c = c_; }
    __host__ __device__ bool next(int i, Unit& u) const {
        const long L = (long)i * G + c; if (L >= nwg) return false;
        int wgid = (int)L; { const int q = nwg / NXCD, r = nwg % NXCD, xcd = wgid % NXCD, off = wgid / NXCD; wgid = (xcd < r ? xcd * (q + 1) : r * (q + 1) + (xcd - r) * q) + off; }
        const int nig = WGM * nN, gid = wgid / nig, fm = gid * WGM, gsz = (nM - fm) < WGM ? (nM - fm) : WGM;
        u.pm = fm + ((wgid % nig) % gsz); u.pn = (wgid % nig) / gsz; return true;
    }
    __device__ __forceinline__ void a_ready(const Unit&) const {}
    __device__ __forceinline__ void done(const Unit&) const {}
};

__device__ __forceinline__ unsigned cvt_pk_bf16(float lo, float hi) { unsigned r; asm volatile("v_cvt_pk_bf16_f32 %0, %1, %2" : "=v"(r) : "v"(lo), "v"(hi)); return r; }
typedef float f32x2 __attribute__((ext_vector_type(2)));
struct EpiBf16 {
    static constexpr bool PERM = true, AFTER_DRAIN = false;
    static constexpr int NSTORE = 16;
    bf16_t* O; int ldc; float scale = 1.f;
    __device__ __forceinline__ void operator()(const f32x4 (&acc)[2][2][4][2], const Unit& u, int wr, int wc, int fr, int fq) const {
        const int row0 = u.pm * BM + wr * 64 + fr; const int col0 = u.pn * BM + wc * 32 + 8 * fq;
#pragma unroll
        for (int ai = 0; ai < 2; ++ai)
#pragma unroll
            for (int m = 0; m < 4; ++m) { bf16_t* rowp = O + (size_t)(row0 + ai * HALF + m * 16) * ldc + col0;
#pragma unroll
                for (int bj = 0; bj < 2; ++bj) { const f32x4 v0 = acc[ai][bj][m][0] * scale, v1 = acc[ai][bj][m][1] * scale;
                    u32x4 w; w.x = cvt_pk_bf16(v0[0], v0[1]); w.y = cvt_pk_bf16(v0[2], v0[3]); w.z = cvt_pk_bf16(v1[0], v1[1]); w.w = cvt_pk_bf16(v1[2], v1[3]);
                    *(__attribute__((address_space(1))) u32x4*)(rowp + bj * HALF) = w; } }
    }
};
struct EpiBf16Acc {
    static constexpr bool PERM = true, AFTER_DRAIN = false;
    static constexpr int NSTORE = 16;
    bf16_t* O; int ldc; float scale = 1.f;
    __device__ __forceinline__ void operator()(const f32x4 (&acc)[2][2][4][2], const Unit& u, int wr, int wc, int fr, int fq) const {
        const int row0 = u.pm * BM + wr * 64 + fr; const int col0 = u.pn * BM + wc * 32 + 8 * fq;
#pragma unroll
        for (int ai = 0; ai < 2; ++ai)
#pragma unroll
            for (int m = 0; m < 4; ++m) { bf16_t* rowp = O + (size_t)(row0 + ai * HALF + m * 16) * ldc + col0;
#pragma unroll
                for (int bj = 0; bj < 2; ++bj) { f32x4 v0 = acc[ai][bj][m][0] * scale, v1 = acc[ai][bj][m][1] * scale;
                    const u32x4 o = *(const __attribute__((address_space(1))) u32x4*)(rowp + bj * HALF);
                    v0[0] += __uint_as_float(o.x << 16); v0[1] += __uint_as_float(o.x & 0xffff0000u); v0[2] += __uint_as_float(o.y << 16); v0[3] += __uint_as_float(o.y & 0xffff0000u);
                    v1[0] += __uint_as_float(o.z << 16); v1[1] += __uint_as_float(o.z & 0xffff0000u); v1[2] += __uint_as_float(o.w << 16); v1[3] += __uint_as_float(o.w & 0xffff0000u);
                    u32x4 w; w.x = cvt_pk_bf16(v0[0], v0[1]); w.y = cvt_pk_bf16(v0[2], v0[3]); w.z = cvt_pk_bf16(v1[0], v1[1]); w.w = cvt_pk_bf16(v1[2], v1[3]);
                    *(__attribute__((address_space(1))) u32x4*)(rowp + bj * HALF) = w; } }
    }
};
struct EpiResF32 {
    static constexpr bool PERM = false, AFTER_DRAIN = false;
    static constexpr int NSTORE = 0;
    const float* res; float* out; int ldc; float alpha;
    __device__ __forceinline__ void operator()(const f32x4 (&acc)[2][2][4][2], const Unit& u, int wr, int wc, int fr, int fq) const {
        const int row0 = u.pm * BM + wr * 64 + fr, col0 = u.pn * BM + wc * 32 + 4 * fq;
#pragma unroll
        for (int ai = 0; ai < 2; ++ai)
#pragma unroll
            for (int m = 0; m < 4; ++m) { const size_t off = (size_t)(row0 + ai * HALF + m * 16) * ldc + col0;
                f32x4 r[2][2];
#pragma unroll
                for (int bj = 0; bj < 2; ++bj)
#pragma unroll
                    for (int n = 0; n < 2; ++n) r[bj][n] = *(const f32x4*)(res + off + bj * HALF + n * 16);
#pragma unroll
                for (int bj = 0; bj < 2; ++bj)
#pragma unroll
                    for (int n = 0; n < 2; ++n) *(f32x4*)(out + off + bj * HALF + n * 16) = r[bj][n] * alpha + acc[ai][bj][m][n];
                asm volatile("" ::: "memory"); }
    }
};
#ifndef GEMM_C0
#define GEMM_C0 0
#endif
#ifndef GEMM_RELAX
#define GEMM_RELAX 1
#endif
template <class Epi, class Sched, bool ALIGN_EPI = false, bool SP2 = false, bool F16 = false, bool FP8 = false>
__device__ __forceinline__ void gemm_phase(PG8_LAS unsigned char* lds, const Gemm g, const Sched& S, const Epi& E) {
    int tid_ = threadIdx.x; asm volatile("" : "+v"(tid_));
    const int tid = tid_, wid = __builtin_amdgcn_readfirstlane(tid >> 6), lane = tid & 63, wr = wid >> 2, wc = wid & 3, fr = lane & 15, fq = lane >> 4;
    const int K = g.K, nt = K / BK;
    unsigned voffA[2], voffB[2];
#pragma unroll
    for (int i = 0; i < 2; ++i) { int R, C; stage_rc(tid * 16 + i * 8192, R, C); const int Rb = Epi::PERM ? ((R & ~31) + perm32(R & 31)) : R;
        voffA[i] = (unsigned)(R * K + C) * 2u; voffB[i] = (unsigned)(Rb * K + C) * 2u; }
    const size_t kstep = (size_t)(BK * 2);
    const size_t hstep = (size_t)HALF * K * 2;
    const size_t tstep = 2 * hstep;
    const unsigned ldsw = (unsigned)wid * 1024u;
    const int aoff = lds_byte(wr * 64 + fr, fq * 8), boff = lds_byte(wc * 32 + fr, fq * 8);
    constexpr int KOFF = 1024;
#define PG8_SA(b, h) (((b) * 2 + (h)) * HTB)
#define PG8_SB(b, h) ((4 + (b) * 2 + (h)) * HTB)
#define PG8_STAGE(bufoff, gbase, voff) do { _Pragma("unroll") for (int _i = 0; _i < 2; ++_i) \
        __builtin_amdgcn_global_load_lds((const unsigned*)((const char*)(gbase) + (voff)[_i]), (PG8_LAS unsigned*)(lds + (bufoff) + ldsw + _i * 8192), 16, 0, 0); } while (0)
#define PG8_LDA(dst, b, h) do { if constexpr (FP8) { _Pragma("unroll") for (int m = 0; m < 4; ++m) dst##8[m] = __builtin_shufflevector(*(const PG8_LAS i32x4*)(lds + PG8_SA(b, h) + aoff + m * 2048), *(const PG8_LAS i32x4*)(lds + PG8_SA(b, h) + aoff + m * 2048 + KOFF), 0, 1, 2, 3, 4, 5, 6, 7); } \
        else { _Pragma("unroll") for (int m = 0; m < 4; ++m) _Pragma("unroll") for (int k = 0; k < 2; ++k) dst[m][k] = *(const PG8_LAS bf16x8*)(lds + PG8_SA(b, h) + aoff + m * 2048 + k * KOFF); } } while (0)
#define PG8_LDB(dst, b, h) do { if constexpr (FP8) { _Pragma("unroll") for (int n = 0; n < 2; ++n) dst##8[n] = __builtin_shufflevector(*(const PG8_LAS i32x4*)(lds + PG8_SB(b, h) + boff + n * 2048), *(const PG8_LAS i32x4*)(lds + PG8_SB(b, h) + boff + n * 2048 + KOFF), 0, 1, 2, 3, 4, 5, 6, 7); } \
        else { _Pragma("unroll") for (int n = 0; n < 2; ++n) _Pragma("unroll") for (int k = 0; k < 2; ++k) dst[n][k] = *(const PG8_LAS bf16x8*)(lds + PG8_SB(b, h) + boff + n * 2048 + k * KOFF); } } while (0)
#define PG8_MMA(ai, bj, At, Bt) do { __builtin_amdgcn_s_setprio(1); \
        if constexpr (FP8) { _Pragma("unroll") for (int m = 0; m < 4; ++m) _Pragma("unroll") for (int n = 0; n < 2; ++n) \
            asm volatile("v_mfma_f32_16x16x128_f8f6f4 %0, %1, %2, %0" : "+v"(acc[ai][bj][m][n]) : "v"(Bt##8[n]), "v"(At##8[m])); }     \
        else { _Pragma("unroll") for (int m = 0; m < 4; ++m) _Pragma("unroll") for (int n = 0; n < 2; ++n) _Pragma("unroll") for (int k = 0; k < 2; ++k) \
            acc[ai][bj][m][n] = F16 ? __builtin_amdgcn_mfma_f32_16x16x32_f16(__builtin_bit_cast(f16x8, Bt[n][k]), __builtin_bit_cast(f16x8, At[m][k]), acc[ai][bj][m][n], 0, 0, 0) \
                                    : __builtin_amdgcn_mfma_f32_16x16x32_bf16(Bt[n][k], At[m][k], acc[ai][bj][m][n], 0, 0, 0); } \
        __builtin_amdgcn_s_setprio(0); } while (0)
#define PG8_MMA0(ai, bj, At, Bt) do { __builtin_amdgcn_s_setprio(1);     \
        if constexpr (FP8) { _Pragma("unroll") for (int m = 0; m < 4; ++m) _Pragma("unroll") for (int n = 0; n < 2; ++n) \
            asm volatile("v_mfma_scale_f32_16x16x128_f8f6f4 %0, %1, %2, 0, %3, %3 op_sel_hi:[0,0,0]" : "=&v"(acc[ai][bj][m][n]) : "v"(Bt##8[n]), "v"(At##8[m]), "v"(0x7f7f7f7f)); } \
        else { _Pragma("unroll") for (int m = 0; m < 4; ++m) _Pragma("unroll") for (int n = 0; n < 2; ++n) { \
            acc[ai][bj][m][n] = F16 ? __builtin_amdgcn_mfma_f32_16x16x32_f16(__builtin_bit_cast(f16x8, Bt[n][0]), __builtin_bit_cast(f16x8, At[m][0]), (f32x4){0.f, 0.f, 0.f, 0.f}, 0, 0, 0) \
                                    : __builtin_amdgcn_mfma_f32_16x16x32_bf16(Bt[n][0], At[m][0], (f32x4){0.f, 0.f, 0.f, 0.f}, 0, 0, 0); \
            acc[ai][bj][m][n] = F16 ? __builtin_amdgcn_mfma_f32_16x16x32_f16(__builtin_bit_cast(f16x8, Bt[n][1]), __builtin_bit_cast(f16x8, At[m][1]), acc[ai][bj][m][n], 0, 0, 0) \
                                    : __builtin_amdgcn_mfma_f32_16x16x32_bf16(Bt[n][1], At[m][1], acc[ai][bj][m][n], 0, 0, 0); } } \
        __builtin_amdgcn_s_setprio(0); } while (0)
#if GEMM_C0
#define PG8_MMAF PG8_MMA0
#else
#define PG8_MMAF PG8_MMA
#endif
#define PG8_WAIT_V(n) asm volatile("s_waitcnt vmcnt(" #n ")" ::: "memory")
#define PG8_WAIT_VN(n) asm volatile("s_waitcnt vmcnt(%0)" :: "n"(n) : "memory")
#define PG8_WAIT_L(n) asm volatile("s_waitcnt lgkmcnt(" #n ")" ::: "memory")
#define PG8_BAR __builtin_amdgcn_s_barrier()
#define PG8_SCHED __builtin_amdgcn_sched_barrier(0)
    Unit cur, nxt; int ui = 0;
    if (!S.next(0, cur)) return;
    f32x4 acc[2][2][4][2];
    if constexpr (!(SP2 && (GEMM_RELAX != 0) && (GEMM_C0 != 0))) {
#pragma unroll
    for (int a = 0; a < 2; ++a)
#pragma unroll
        for (int b = 0; b < 2; ++b)
#pragma unroll
            for (int m = 0; m < 4; ++m)
#pragma unroll
                for (int n = 0; n < 2; ++n) acc[a][b][m][n] = (f32x4){0.f, 0.f, 0.f, 0.f};
    }
    bf16x8 At[4][2], B0[2][2], B1[2][2]; i32x8 At8[4], B08[2], B18[2];
    const char* cA = (const char*)g.A + (size_t)cur.pm * tstep; const char* cB = (const char*)g.Bt + (size_t)cur.pn * tstep;
    S.a_ready(cur);
    if constexpr (SP2) {
        PG8_STAGE(PG8_SB(0, 0), cB, voffB); PG8_STAGE(PG8_SB(0, 1), cB + hstep, voffB); PG8_STAGE(PG8_SA(0, 0), cA, voffA); PG8_STAGE(PG8_SA(0, 1), cA + hstep, voffA);
        if (wr == 1) PG8_BAR;
        PG8_WAIT_V(2); PG8_BAR;
        PG8_STAGE(PG8_SB(1, 0), cB + kstep, voffB); PG8_STAGE(PG8_SA(1, 0), cA + kstep, voffA); PG8_STAGE(PG8_SB(1, 1), cB + hstep + kstep, voffB);
        if constexpr (GEMM_RELAX != 0) PG8_WAIT_V(0); else PG8_WAIT_V(6);
        PG8_BAR;
    } else {
        PG8_STAGE(PG8_SB(0, 0), cB, voffB); PG8_STAGE(PG8_SA(0, 0), cA, voffA); PG8_STAGE(PG8_SB(0, 1), cB + hstep, voffB); PG8_STAGE(PG8_SA(0, 1), cA + hstep, voffA);
        if (wr == 1) PG8_BAR;
        PG8_WAIT_V(4); PG8_BAR;
        PG8_STAGE(PG8_SB(1, 0), cB + kstep, voffB); PG8_STAGE(PG8_SA(1, 0), cA + kstep, voffA); PG8_STAGE(PG8_SB(1, 1), cB + hstep + kstep, voffB);
        PG8_WAIT_V(6); PG8_BAR;
    }
    for (;;) {
        const bool has_next = S.next(ui + 1, nxt);
        const char* nA = has_next ? (const char*)g.A + (size_t)nxt.pm * tstep : cA; const char* nB = has_next ? (const char*)g.Bt + (size_t)nxt.pn * tstep : cB;
#define PG8_PTRS(t_) const bool last = ((t_) == nt - 2); const char* a1 = cA + (size_t)((t_) + 1) * kstep; \
            const char* a2 = last ? nA : cA + (size_t)((t_) + 2) * kstep; const char* b2 = last ? nB : cB + (size_t)((t_) + 2) * kstep; const char* a3 = a2 + kstep; const char* b3 = b2 + kstep; (void)a1
#define PG8_SP2_ITER(WAITA, MMAA) \
            PG8_LDB(B0, 0, 0); PG8_LDB(B1, 0, 1); PG8_SCHED; PG8_LDA(At, 0, 0); PG8_STAGE(PG8_SA(1, 1), a1 + hstep, voffA); \
            WAITA; PG8_WAIT_L(0); PG8_BAR; MMAA(0, 0, At, B0); MMAA(0, 1, At, B1); PG8_BAR; PG8_SCHED; \
            PG8_LDA(At, 0, 1); PG8_STAGE(PG8_SB(0, 0), b2, voffB); PG8_STAGE(PG8_SB(0, 1), b2 + hstep, voffB); PG8_STAGE(PG8_SA(0, 0), a2, voffA); \
            WAITA; PG8_WAIT_L(0); PG8_BAR; MMAA(1, 0, At, B0); MMAA(1, 1, At, B1); PG8_BAR; PG8_SCHED; \
            PG8_LDB(B0, 1, 0); PG8_LDB(B1, 1, 1); PG8_SCHED; PG8_LDA(At, 1, 0); PG8_STAGE(PG8_SA(0, 1), a2 + hstep, voffA); \
            PG8_WAIT_V(8); PG8_WAIT_L(0); PG8_BAR; PG8_MMA(0, 0, At, B0); PG8_MMA(0, 1, At, B1); PG8_BAR; PG8_SCHED; \
            PG8_LDA(At, 1, 1); PG8_STAGE(PG8_SB(1, 0), b3, voffB); PG8_STAGE(PG8_SB(1, 1), b3 + hstep, voffB); PG8_STAGE(PG8_SA(1, 0), a3, voffA); \
            PG8_WAIT_V(8); PG8_WAIT_L(0); PG8_BAR; PG8_MMA(1, 0, At, B0); PG8_MMA(1, 1, At, B1); PG8_BAR; PG8_SCHED
        int t0 = 0;
        if constexpr (SP2 && (GEMM_RELAX != 0)) {
            { PG8_PTRS(0); PG8_SP2_ITER(PG8_WAIT_VN(8 + Epi::NSTORE), PG8_MMAF); }
            t0 = 2;
        }
        for (int t = t0; t < nt; t += 2) {
            PG8_PTRS(t);
            if (last && has_next) S.a_ready(nxt);
            if constexpr (SP2) {
            PG8_SP2_ITER(PG8_WAIT_V(8), PG8_MMA);
            } else {
            PG8_LDB(B0, 0, 0); PG8_SCHED; PG8_LDA(At, 0, 0); PG8_STAGE(PG8_SA(1, 1), a1 + hstep, voffA);
            PG8_WAIT_L(8); PG8_BAR; PG8_WAIT_L(0); PG8_MMA(0, 0, At, B0); PG8_BAR; PG8_SCHED;
            PG8_LDB(B1, 0, 1); PG8_STAGE(PG8_SB(0, 0), b2, voffB);
            PG8_BAR; PG8_WAIT_L(0); PG8_MMA(0, 1, At, B1); PG8_BAR;
            PG8_LDA(At, 0, 1); PG8_STAGE(PG8_SA(0, 0), a2, voffA);
            PG8_BAR; PG8_WAIT_L(0); PG8_MMA(1, 0, At, B0); PG8_BAR; PG8_SCHED;
            PG8_STAGE(PG8_SB(0, 1), b2 + hstep, voffB);
            PG8_WAIT_V(6); PG8_BAR; PG8_MMA(1, 1, At, B1); PG8_BAR;
            PG8_LDB(B0, 1, 0); PG8_SCHED; PG8_LDA(At, 1, 0); PG8_STAGE(PG8_SA(0, 1), a2 + hstep, voffA);
            PG8_WAIT_L(8); PG8_BAR; PG8_WAIT_L(0); PG8_MMA(0, 0, At, B0); PG8_BAR; PG8_SCHED;
            PG8_LDB(B1, 1, 1); PG8_STAGE(PG8_SB(1, 0), b3, voffB);
            PG8_BAR; PG8_WAIT_L(0); PG8_MMA(0, 1, At, B1); PG8_BAR;
            PG8_LDA(At, 1, 1); PG8_STAGE(PG8_SA(1, 0), a3, voffA);
            PG8_BAR; PG8_WAIT_L(0); PG8_MMA(1, 0, At, B0); PG8_BAR; PG8_SCHED;
            PG8_STAGE(PG8_SB(1, 1), b3 + hstep, voffB);
            PG8_WAIT_V(6); PG8_BAR; PG8_MMA(1, 1, At, B1); PG8_BAR;
            }
        }
        if constexpr (ALIGN_EPI) { if (wr == 0) PG8_BAR; }
        if constexpr (!Epi::AFTER_DRAIN) { E(acc, cur, wr, wc, fr, fq); S.done(cur); }
        if (!has_next) break;
        if constexpr (!(SP2 && (GEMM_RELAX != 0) && (GEMM_C0 != 0))) {
#pragma unroll
        for (int a = 0; a < 2; ++a)
#pragma unroll
            for (int b = 0; b < 2; ++b)
#pragma unroll
                for (int m = 0; m < 4; ++m)
#pragma unroll
                    for (int n = 0; n < 2; ++n) acc[a][b][m][n] = (f32x4){0.f, 0.f, 0.f, 0.f};
        }
        cur = nxt; cA = nA; cB = nB; ++ui;
        if constexpr (ALIGN_EPI) { if (wr == 1) PG8_BAR; }
    }
    PG8_WAIT_V(0);
    if constexpr (!ALIGN_EPI) { if (wr == 0) PG8_BAR; }
    PG8_BAR;
    if constexpr (Epi::AFTER_DRAIN) { E.fused(acc, cur, wr, wc, fr, fq, lds, wid, lane); S.done(cur); }
#undef PG8_SA
#undef PG8_SB
#undef PG8_STAGE
#undef PG8_LDA
#undef PG8_LDB
#undef PG8_MMA
#undef PG8_WAIT_V
#undef PG8_WAIT_VN
#undef PG8_PTRS
#undef PG8_MMA0
#undef PG8_MMAF
#undef PG8_SP2_ITER
#undef PG8_WAIT_L
#undef PG8_BAR
#undef PG8_SCHED
}
}
#define GAS __attribute__((address_space(1)))
#define LAS __attribute__((address_space(3)))
typedef unsigned short bf16;
typedef unsigned v4u __attribute__((ext_vector_type(4)));
typedef float f32x4 __attribute__((ext_vector_type(4)));
typedef short bf16x8 __attribute__((ext_vector_type(8)));
typedef GAS unsigned gu32;
typedef GAS unsigned long long gu64;
#define RLX_AGENT __ATOMIC_RELAXED, __HIP_MEMORY_SCOPE_AGENT
#define LDS_WAIT() asm volatile("s_waitcnt lgkmcnt(0)" ::: "memory")
#define VM_WAIT() asm volatile("s_waitcnt vmcnt(0)" ::: "memory")
__device__ __forceinline__ unsigned long long rt() { return __builtin_amdgcn_s_memrealtime(); }
__device__ __forceinline__ unsigned f2bf(float f) { unsigned u = __builtin_bit_cast(unsigned, f); return (u + 0x7fffu + ((u >> 16) & 1u)) >> 16; }
__device__ __forceinline__ unsigned pk2(float lo, float hi) { return f2bf(lo) | (f2bf(hi) << 16); }

#define XB_TMO      128
#define XB_XCNT(j)  (256  + 64 * (j))
#define XB_XSUB(j)  (1280 + 64 * (j))
#define XB_XGEN(j)  (2304 + 64 * (j))
#define XB_TOP      3328
#define XB_TOPGEN   3392
#define XCD_BAR_WORDS 3456
#define XB_SPIN_CAP (1u << 22)

__device__ __forceinline__ unsigned xb_ld(unsigned* p)              { return __hip_atomic_load(p, __ATOMIC_RELAXED, __HIP_MEMORY_SCOPE_AGENT); }
__device__ __forceinline__ unsigned xb_add(unsigned* p, unsigned v) { return __hip_atomic_fetch_add(p, v, __ATOMIC_RELAXED, __HIP_MEMORY_SCOPE_AGENT); }
__device__ __forceinline__ unsigned xb_xcc_id() { return (unsigned)__builtin_amdgcn_s_getreg((3 << 11) | 20) & 0xFu; }
#define XB_SPIN(cond, bar) do { unsigned _sp = 0; while (cond) { __builtin_amdgcn_s_sleep(1); \
    if ((++_sp & 255u) == 0u) { if (xb_ld(&(bar)[XB_TMO])) break; if (_sp > XB_SPIN_CAP) { atomicAdd(&(bar)[XB_TMO], 1u); break; } } } } while (0)

struct XcdBarrier {
    unsigned* bar; unsigned x;
    volatile LAS unsigned* st;
};

__device__ __forceinline__ XcdBarrier xcd_barrier_post(unsigned* bar, volatile LAS unsigned* st) {
    XcdBarrier b; b.bar = bar; b.x = xb_xcc_id(); b.st = st;
    if (threadIdx.x == 0) (void)xb_add(&bar[XB_XCNT(b.x)], 1u);
    return b;
}
__device__ __forceinline__ void xcd_barrier_complete(unsigned* bar, unsigned x, unsigned& nloc, unsigned& nx) {
    const unsigned G = gridDim.x * gridDim.y * gridDim.z;
    unsigned sum, cnt, mine, sp = 0u;
    for (;;) {
        sum = 0u; cnt = 0u; mine = 0u;
#pragma unroll
        for (unsigned j = 0; j < 16; ++j) { const unsigned c = xb_ld(&bar[XB_XCNT(j)]); sum += c; cnt += (c > 0u) ? 1u : 0u; mine = (j == x) ? c : mine; }
        if (sum == G) break;
        __builtin_amdgcn_s_sleep(1);
        if ((++sp & 255u) == 0u) { if (xb_ld(&bar[XB_TMO])) break; if (sp > XB_SPIN_CAP) { atomicAdd(&bar[XB_TMO], 1u); break; } }
    }
    nloc = mine > 0u ? mine : 1u; nx = cnt > 0u ? cnt : 1u;
}

__device__ __forceinline__ void xcd_barrier(const XcdBarrier& b) {
    asm volatile("s_waitcnt vmcnt(0)" ::: "memory");
    __syncthreads();
    if (threadIdx.x == 0) {
        unsigned* bar = b.bar;
        __builtin_amdgcn_s_waitcnt(0);
        unsigned nloc = b.st[0], nx = b.st[1];
        if (nloc == 0u) { xcd_barrier_complete(bar, b.x, nloc, nx); b.st[0] = nloc; b.st[1] = nx; }
        const unsigned old = xb_add(&bar[XB_XSUB(b.x)], 1u);
        const unsigned gen = old / nloc;
        if (old + 1u == (gen + 1u) * nloc) {
            __builtin_amdgcn_fence(__ATOMIC_RELEASE, "agent");
            asm volatile("s_waitcnt vmcnt(0)" ::: "memory");
            const unsigned og = xb_add(&bar[XB_TOP], 1u);
            const unsigned tg = og / nx;
            if (og + 1u == (tg + 1u) * nx) xb_add(&bar[XB_TOPGEN], 1u);
            else XB_SPIN(xb_ld(&bar[XB_TOPGEN]) == tg, bar);
            __builtin_amdgcn_fence(__ATOMIC_ACQUIRE, "agent");
            xb_add(&bar[XB_XGEN(b.x)], 1u);
            asm volatile("s_waitcnt vmcnt(0)" ::: "memory");
        } else {
            XB_SPIN(xb_ld(&bar[XB_XGEN(b.x)]) == gen, bar);
            __builtin_amdgcn_fence(__ATOMIC_ACQUIRE, "agent");
            asm volatile("s_waitcnt vmcnt(0)" ::: "memory");
        }
    }
    __syncthreads();
}


constexpr int NWAVES = 8;
constexpr int BATCH = 8, SEQ = 2048, DM = 4096, MROWS = BATCH * SEQ;
constexpr int NPROJ = 16384;
constexpr int HD = 128;
constexpr int L0_H = 0, L0_B = 2048, L0_C = 4096, L0_GA = 6144, L0_Q = 8192, L0_K = 10240, L0_V = 12288, L0_GB = 14336;
constexpr int L1_Q = 0, L1_K = 4096, L1_V = 8192, L1_G = 12288;
constexpr int CONVW = 2048, MOBA_H = 16, MOBA_BLK = 256, MOBA_NB = 8, SB_H = 32;
constexpr int NMEM = 256, XH = 4, XHD = 256, XW = 1024, XQW = 2048;
constexpr float LN_EPS = 1e-5f;
constexpr float DN_ALPHA = 1.41421356237309515f;
constexpr float LOG2E = 1.4426950408889634f;
#ifndef FP8_VG
#define FP8_VG 1
#endif
constexpr int NP8 = 8192, NPB0 = NPROJ - NP8;
#ifndef FP8_XQ
#define FP8_XQ 2
#endif
#ifndef FP8_XO
#define FP8_XO 1
#endif
constexpr float XO8_SCALE = 16.f;
#ifndef FP8_OP0
#define FP8_OP0 1
#endif
constexpr float MO8_SCALE = 16.f;
constexpr size_t MIX8_OFF = 64u << 20;
constexpr size_t WOUT8_OFF = 16u << 20;
#ifndef FP8_L1
#define FP8_L1 0
#endif
constexpr int NP8_1 = 8192, NPB1 = NPROJ - NP8_1;
constexpr size_t OUT_X8 = 0, OUT_W8 = 64u << 20;
constexpr int N_IN = 22;
typedef float f32x2v __attribute__((ext_vector_type(2)));
enum { I_X = 0, I_MEM, I_RELB, I_WIN0, I_CONVW, I_WOUT0, I_LN1G0, I_LN1B0, I_WXQ0, I_WXKV0, I_WXO0, I_LN2G0, I_LN2B0, I_WIN1, I_WOUT1, I_LN1G1, I_LN1B1, I_WXQ1, I_WXKV1, I_WXO1, I_LN2G1, I_LN2B1 };

constexpr size_t MiB = 1u << 20;
constexpr size_t WS_CTL = 0, CTL_ZERO_BYTES = 1 * MiB;
constexpr size_t WS_KBAR = 1 * MiB;
constexpr size_t WS_W = 2 * MiB, W_LAYER = 184 * MiB;
constexpr size_t W_IN = 0, W_OUT = 128 * MiB, W_XQ = 160 * MiB, W_XO = 176 * MiB;
constexpr size_t WS_WXKV = 370 * MiB;
constexpr size_t WS_MEMB = 402 * MiB;
constexpr size_t WS_KVX = 418 * MiB; constexpr int KVLD = 4096;
constexpr size_t WS_XM = 434 * MiB;
constexpr size_t WS_PROJ = 562 * MiB;
constexpr size_t WS_QG = WS_PROJ, WS_XOIN = WS_PROJ + 64 * MiB;
constexpr size_t WS_RH = WS_PROJ + 256 * MiB;
constexpr size_t WS_YB = WS_PROJ + 128 * MiB;
constexpr size_t WS_X8Q = WS_PROJ + 384 * MiB;
constexpr size_t WS_END = 1074 * MiB;
constexpr size_t W1_W8_OFF = (size_t)NPB1 * DM * 2;
constexpr size_t WS_X1B = WS_W + W_IN;
constexpr size_t WS_X8_1 = WS_W + W_IN;
constexpr int CW_TMO = 0, CW_CODE = 1;
constexpr int CW_BAR = 4096;
constexpr int RING_OFF = 0, RING_BYTES = 131072;
constexpr int LDSCTL_OFF = RING_BYTES, MISC_OFF = LDSCTL_OFF + 320;
constexpr int LDS_BYTES = 147456;

#define PH_IDS() int tid_ = threadIdx.x; asm volatile("" : "+v"(tid_)); const int tid = tid_, lane = tid & 63, wave = __builtin_amdgcn_readfirstlane(tid >> 6); (void)lane; (void)wave; \
    int vcu_ = F.vcu_, G_ = F.G_; asm volatile("" : "+s"(vcu_), "+s"(G_)); const int vcu = vcu_, G = G_; (void)vcu; (void)G
struct Frame {
    LAS unsigned char* lds;
    volatile LAS unsigned* MISC;
    gu32* ctl;
    int vcu_, G_;
};

__device__ __forceinline__ const float* karg_in(int i) {
    unsigned long long v; const unsigned long long kp = (unsigned long long)__builtin_amdgcn_kernarg_segment_ptr(); const int off = __builtin_amdgcn_readfirstlane(i * 8);
    asm volatile("s_load_dwordx2 %0, %1, %2\n\ts_waitcnt lgkmcnt(0)" : "=&s"(v) : "s"(kp), "s"(off) : "memory");
    return (const float*)v;
}
__device__ __forceinline__ float wave_sum(float v) {
#pragma unroll
    for (int o = 1; o < 64; o <<= 1) v += __shfl_xor(v, o);
    return v;
}
__device__ __forceinline__ float wave_max(float v) {
#pragma unroll
    for (int o = 1; o < 64; o <<= 1) v = fmaxf(v, __shfl_xor(v, o));
    return v;
}
__device__ __forceinline__ float bf_lo(unsigned w) { return __builtin_bit_cast(float, w << 16); }
__device__ __forceinline__ float bf_hi(unsigned w) { return __builtin_bit_cast(float, w & 0xffff0000u); }
__device__ __forceinline__ unsigned pkbf(float lo, float hi) { return pg8::cvt_pk_bf16(lo, hi); }
__device__ __forceinline__ unsigned pk8(float a, float b, float c_, float d) { int w = 0; w = __builtin_amdgcn_cvt_pk_fp8_f32(a, b, w, false); w = __builtin_amdgcn_cvt_pk_fp8_f32(c_, d, w, true); return (unsigned)w; }
__device__ __forceinline__ unsigned pkh(float lo, float hi) { typedef _Float16 h2_ __attribute__((ext_vector_type(2))); const h2_ v = {(_Float16)lo, (_Float16)hi}; return __builtin_bit_cast(unsigned, v); }
__device__ __forceinline__ float silu_f(float g) { return g * __builtin_amdgcn_rcpf(1.0f + __builtin_amdgcn_exp2f(-g * LOG2E)); }
__device__ __forceinline__ int t5_bucket(int n) {
    const int b = 16 + (n >= 19) + (n >= 21) + (n >= 24) + (n >= 27) + (n >= 31) + (n >= 35) + (n >= 40) + (n >= 46) + (n >= 52) + (n >= 59) + (n >= 67) + (n >= 77) + (n >= 87) + (n >= 99) + (n >= 113);
    return n < 16 ? n : b;
}

#ifndef LATE_CONV
#define LATE_CONV 1
#endif
#ifndef P1_WOUT1
#define P1_WOUT1 0
#endif
struct P0Item { const float* W; bf16* WT; int K, N, item, f16; int ldt = 0, koff = 0; };
__device__ __forceinline__ void p0_item_load(float (&v)[32], const P0Item& I, int lane) {
    const int nblk = I.N / 32, kb = I.item / nblk, nb = I.item % nblk, k0 = 64 * kb, n0 = 32 * nb;
    const GAS float* src = (const GAS float*)I.W + (size_t)(k0 + (lane >> 5)) * I.N + n0 + (lane & 31);
#pragma unroll
    for (int i = 0; i < 32; ++i) v[i] = __builtin_nontemporal_load(src + (size_t)(2 * i) * I.N);
}
__device__ __forceinline__ void p0_item_store(const float (&v)[32], const P0Item& I, LAS float* scr, int lane) {
    const int nblk = I.N / 32, kb = I.item / nblk, nb = I.item % nblk, k0 = 64 * kb, n0 = 32 * nb;
#pragma unroll
    for (int i = 0; i < 32; ++i) scr[(2 * i + (lane >> 5)) * 33 + (lane & 31)] = v[i];
    LDS_WAIT(); asm volatile("" ::: "memory");
    const int c = lane & 7; const int ldt = I.ldt ? I.ldt : I.K, k0s = k0 - I.koff;
#pragma unroll
    for (int j = 0; j < 4; ++j) { const int n = (lane >> 3) + 8 * j; const LAS float* s = scr + (8 * c) * 33 + n;
        if (I.f16 == 2) {
            const unsigned lo8 = pk8(64.f * s[0 * 33], 64.f * s[1 * 33], 64.f * s[2 * 33], 64.f * s[3 * 33]), hi8 = pk8(64.f * s[4 * 33], 64.f * s[5 * 33], 64.f * s[6 * 33], 64.f * s[7 * 33]);
            *(GAS unsigned long long*)((unsigned char*)I.WT + (size_t)(n0 + n) * ldt + k0s + 8 * c) = (unsigned long long)lo8 | ((unsigned long long)hi8 << 32); continue; }
        v4u o;
        if (I.f16) { o.x = pkh(s[0 * 33], s[1 * 33]); o.y = pkh(s[2 * 33], s[3 * 33]); o.z = pkh(s[4 * 33], s[5 * 33]); o.w = pkh(s[6 * 33], s[7 * 33]); }
        else { o.x = pkbf(s[0 * 33], s[1 * 33]); o.y = pkbf(s[2 * 33], s[3 * 33]); o.z = pkbf(s[4 * 33], s[5 * 33]); o.w = pkbf(s[6 * 33], s[7 * 33]); }
        *(GAS v4u*)(I.WT + (size_t)(n0 + n) * ldt + k0s + 8 * c) = o; }
    LDS_WAIT(); asm volatile("" ::: "memory");
}
__device__ __forceinline__ void p0_transpose_item(const float* W, int K, int N, bf16* WT, LAS float* scr, int item, int lane) {
    float v[32]; const P0Item I{W, WT, K, N, item, 0}; p0_item_load(v, I, lane); p0_item_store(v, I, scr, lane);
}
template <bool ALSO_FP8>
__device__ __forceinline__ void cvt_bf16_stream(const float* src, bf16* dst, unsigned char* dst8, size_t n8  , size_t gtid, size_t gthreads) {
    for (size_t i = gtid; i < n8; i += 4 * gthreads) {
        f32x4 a[4], b[4];
#pragma unroll
        for (int u = 0; u < 4; ++u) { const size_t j = i + (size_t)u * gthreads; a[u] = __builtin_nontemporal_load((const GAS f32x4*)(src + j * 8)); b[u] = __builtin_nontemporal_load((const GAS f32x4*)(src + j * 8 + 4)); }
#pragma unroll
        for (int u = 0; u < 4; ++u) { const size_t j = i + (size_t)u * gthreads; v4u o; o.x = pkbf(a[u].x, a[u].y); o.y = pkbf(a[u].z, a[u].w); o.z = pkbf(b[u].x, b[u].y); o.w = pkbf(b[u].z, b[u].w); *(GAS v4u*)(dst + j * 8) = o;
            if (ALSO_FP8) *(GAS unsigned long long*)(dst8 + j * 8) = (unsigned long long)pk8(a[u].x, a[u].y, a[u].z, a[u].w) | ((unsigned long long)pk8(b[u].x, b[u].y, b[u].z, b[u].w) << 32); } }
}
struct P0Mat { const float* W; bf16* WT; int K, N, items; };
__device__ __forceinline__ void p0_prologue(Frame& F, unsigned char* ws, unsigned char* outb) {
    unsigned char* const w8 = outb + OUT_W8;
    PH_IDS();
    LAS float* scr = (LAS float*)(F.lds + RING_OFF + wave * 16384);
    const int gw = vcu * NWAVES + wave, NGW = G * NWAVES;
    constexpr int IT_IN = (DM / 64) * (NPROJ / 32), IT_OUT = (DM / 64) * (DM / 32), IT_XQ = (DM / 64) * (XQW / 32), IT_XO = (XW / 64) * (DM / 32);
    constexpr int IT_LAYER = IT_IN + IT_OUT + 2 * IT_XQ + IT_XO;
    auto item_of = [&](int it, P0Item& I) -> bool {
        if (it >= 2 * IT_LAYER) return false;
        const int L = it >= IT_LAYER ? 1 : 0; int r = it - L * IT_LAYER; unsigned char* wl = ws + WS_W + (size_t)L * W_LAYER;
        if (r < IT_IN) { if (L) return false; const int n0_ = 32 * (r % (NPROJ / 32)); if (FP8_VG && n0_ >= NPB0) I = P0Item{karg_in(I_WIN0), (bf16*)(w8 - (size_t)NPB0 * DM), DM, NPROJ, r, 2}; else I = P0Item{karg_in(I_WIN0), (bf16*)(wl + W_IN), DM, NPROJ, r, 0}; return true; } r -= IT_IN;
        if (r < IT_OUT) { if (LATE_CONV || (L && P1_WOUT1)) return false;
            if (FP8_OP0 && L == 0) { const int k0_ = 64 * (r / (DM / 32));
                if (k0_ < CONVW) I = P0Item{karg_in(I_WOUT0), (bf16*)(wl + W_OUT), DM, DM, r, 0, CONVW, 0}; else I = P0Item{karg_in(I_WOUT0), (bf16*)(wl + W_OUT + WOUT8_OFF), DM, DM, r, 2, CONVW, CONVW}; return true; }
            I = P0Item{karg_in(L ? I_WOUT1 : I_WOUT0), (bf16*)(wl + W_OUT), DM, DM, r, 0}; return true; } r -= IT_OUT;
        if (r < IT_XQ) { if (LATE_CONV) return false; I = P0Item{karg_in(L ? I_WXQ1 : I_WXQ0), (bf16*)(wl + W_XQ), DM, XQW, r, (FP8_XQ == 2 || (FP8_XQ && 32 * (r % (XQW / 32)) < XW)) ? 2 : 1}; return true; }         r -= IT_XQ;
        if (r < IT_XQ) { I = P0Item{karg_in(L ? I_WXKV1 : I_WXKV0), (bf16*)(ws + WS_WXKV) + (size_t)L * XQW * DM, DM, XQW, r, 0}; return true; } r -= IT_XQ;
        if (LATE_CONV) return false; I = P0Item{karg_in(L ? I_WXO1 : I_WXO0), (bf16*)(wl + W_XO), XW, DM, r, FP8_XO ? 2 : 0}; return true; };
    for (int it = gw; it < 2 * IT_LAYER; it += 2 * NGW) {
        P0Item A, B; const bool ha = item_of(it, A), hb = item_of(it + NGW, B);
        float va[32], vb[32];
        if (ha) p0_item_load(va, A, lane);
        if (hb) p0_item_load(vb, B, lane);
        if (ha) p0_item_store(va, A, scr, lane);
        if (hb) p0_item_store(vb, B, scr, lane);
    }
    const size_t gtid = (size_t)vcu * 512 + tid, gth = (size_t)G * 512;
    cvt_bf16_stream<(FP8_VG != 0)>(karg_in(I_X), (bf16*)(ws + WS_XM), outb + OUT_X8, (size_t)MROWS * DM / 8, gtid, gth);
    cvt_bf16_stream<false>(karg_in(I_MEM), (bf16*)(ws + WS_MEMB), nullptr, (size_t)BATCH * NMEM * DM / 8, gtid, gth);
}

__device__ __forceinline__ void p1_convert_win1(Frame& F, unsigned char* ws, int rank, int nranks) {
    PH_IDS();
    LAS float* scr = (LAS float*)(F.lds + RING_OFF + wave * 16384);
    constexpr int IT_IN = (DM / 64) * (NPROJ / 32);
    const float* w = karg_in(I_WIN1); bf16* wt = (bf16*)(ws + WS_W + W_LAYER + W_IN);
    unsigned char* const wt8 = (unsigned char*)wt + W1_W8_OFF - (size_t)NPB1 * DM;
    for (int it = rank * NWAVES + wave; it < IT_IN; it += nranks * NWAVES) { float v[32]; const bool f8 = FP8_L1 && 32 * (it % (NPROJ / 32)) >= NPB1;
        const P0Item I{w, f8 ? (bf16*)wt8 : wt, DM, NPROJ, it, f8 ? 2 : 0}; p0_item_load(v, I, lane); p0_item_store(v, I, scr, lane); }
    if (P1_WOUT1) {
        constexpr int IT_OUT = (DM / 64) * (DM / 32);
        const float* wo = karg_in(I_WOUT1); bf16* wot = (bf16*)(ws + WS_W + W_LAYER + W_OUT);
        for (int it = rank * NWAVES + wave; it < IT_OUT; it += nranks * NWAVES) { float v[32]; const P0Item I{wo, wot, DM, DM, it, 0}; p0_item_load(v, I, lane); p0_item_store(v, I, scr, lane); } }
}
__device__ __forceinline__ void p_convert_late(Frame& F, unsigned char* ws, int L) {
    PH_IDS();
    LAS float* scr = (LAS float*)(F.lds + RING_OFF + wave * 16384);
    constexpr int IT_OUT = (DM / 64) * (DM / 32), IT_XQ = (DM / 64) * (XQW / 32), IT_XO = (XW / 64) * (DM / 32), IT = IT_OUT + IT_XQ + IT_XO;
    unsigned char* wl = ws + WS_W + (size_t)L * W_LAYER;
    for (int it = vcu * NWAVES + wave; it < IT; it += G * NWAVES) { P0Item I; int r = it;
        if (r < IT_OUT) { const int k0_ = 64 * (r / (DM / 32));
            if (FP8_OP0 && L == 0) { if (k0_ < CONVW) I = P0Item{karg_in(I_WOUT0), (bf16*)(wl + W_OUT), DM, DM, r, 0, CONVW, 0}; else I = P0Item{karg_in(I_WOUT0), (bf16*)(wl + W_OUT + WOUT8_OFF), DM, DM, r, 2, CONVW, CONVW}; }
            else I = P0Item{karg_in(L ? I_WOUT1 : I_WOUT0), (bf16*)(wl + W_OUT), DM, DM, r, 0}; }
        else if ((r -= IT_OUT) < IT_XQ) I = P0Item{karg_in(L ? I_WXQ1 : I_WXQ0), (bf16*)(wl + W_XQ), DM, XQW, r, (FP8_XQ == 2 || (FP8_XQ && 32 * (r % (XQW / 32)) < XW)) ? 2 : 1};
        else { r -= IT_XQ; I = P0Item{karg_in(L ? I_WXO1 : I_WXO0), (bf16*)(wl + W_XO), XW, DM, r, FP8_XO ? 2 : 0}; }
        float v[32]; p0_item_load(v, I, lane); p0_item_store(v, I, scr, lane); }
}
typedef _Float16 f16x4 __attribute__((ext_vector_type(4)));
template <bool RES_F16, bool FINAL, bool WRITE_BF16 = false, bool WRITE_FP8 = false>
__device__ __forceinline__ void ln_phase(Frame& F, const void* RES, const bf16* Y, bf16* XB, _Float16* XH, float* XF, const float* g, const float* b, float alpha, unsigned* X8 = nullptr) {
    PH_IDS();
    LAS f32x4* gl = (LAS f32x4*)(F.lds + RING_OFF); LAS f32x4* bl = (LAS f32x4*)(F.lds + RING_OFF + 16384);
    for (int i = tid; i < DM / 4; i += NWAVES * 64) { gl[i] = ((const GAS f32x4*)g)[i]; bl[i] = ((const GAS f32x4*)b)[i]; }
    __syncthreads();
    const int gw = vcu * NWAVES + wave, NGW = G * NWAVES;
    for (int m = gw; m < MROWS; m += NGW) {
        asm volatile("" ::: "memory");
        const GAS unsigned long long* yr = (const GAS unsigned long long*)(Y + (size_t)m * DM) + lane;
        f32x4 v[16]; unsigned long long yv[16]; float s = 0.f;
        if (RES_F16) { const GAS f16x4* rr = (const GAS f16x4*)((const _Float16*)RES + (size_t)m * DM) + lane;
            f16x4 rv[16];
#pragma unroll
            for (int j = 0; j < 16; ++j) { rv[j] = rr[64 * j]; yv[j] = yr[64 * j]; }
#pragma unroll
            for (int j = 0; j < 16; ++j) v[j] = (f32x4){(float)rv[j].x, (float)rv[j].y, (float)rv[j].z, (float)rv[j].w};
        } else { const GAS f32x4* rr = (const GAS f32x4*)((const float*)RES + (size_t)m * DM) + lane;
#pragma unroll
            for (int j = 0; j < 16; ++j) { v[j] = rr[64 * j]; yv[j] = yr[64 * j]; } }
#pragma unroll
        for (int j = 0; j < 16; ++j) { const unsigned y0 = (unsigned)yv[j], y1 = (unsigned)(yv[j] >> 32);
            v[j].x = v[j].x * alpha + bf_lo(y0); v[j].y = v[j].y * alpha + bf_hi(y0); v[j].z = v[j].z * alpha + bf_lo(y1); v[j].w = v[j].w * alpha + bf_hi(y1);
            s += (v[j].x + v[j].y) + (v[j].z + v[j].w); }
        const float mean = wave_sum(s) * (1.f / DM); float s2 = 0.f;
#pragma unroll
        for (int j = 0; j < 16; ++j) { v[j] = v[j] - mean; s2 += (v[j].x * v[j].x + v[j].y * v[j].y) + (v[j].z * v[j].z + v[j].w * v[j].w); }
        const float rstd = 1.f / sqrtf(wave_sum(s2) * (1.f / DM) + LN_EPS);
        GAS f32x4* xr = (GAS f32x4*)(XF + (size_t)m * DM) + lane; GAS unsigned long long* o8 = (GAS unsigned long long*)(XB + (size_t)m * DM) + lane; GAS f16x4* oh = (GAS f16x4*)(XH + (size_t)m * DM) + lane; GAS unsigned* o1 = (GAS unsigned*)(X8 + (size_t)m * (DM / 4)) + lane;
#pragma unroll
        for (int j = 0; j < 16; ++j) { if ((j & 3) == 0) asm volatile("" ::: "memory");
            const f32x4 o = v[j] * rstd * gl[64 * j + lane] + bl[64 * j + lane];
            if (FINAL) xr[64 * j] = o;
            else { oh[64 * j] = (f16x4){(_Float16)o.x, (_Float16)o.y, (_Float16)o.z, (_Float16)o.w}; if (WRITE_BF16) o8[64 * j] = (unsigned long long)pkbf(o.x, o.y) | ((unsigned long long)pkbf(o.z, o.w) << 32);
                   if (WRITE_FP8) o1[64 * j] = pk8(o.x, o.y, o.z, o.w); } }
    }
    __syncthreads();
}

__device__ __forceinline__ void conv_phase(Frame& F, const bf16* P, bf16* MIX, const float* cw) {
    PH_IDS();
    const int half = tid >> 8, c0 = (tid & 255) * 8;
    float w0[8], w1[8], w2[8];
#pragma unroll
    for (int i = 0; i < 8; ++i) { w0[i] = cw[c0 + i]; w1[i] = cw[CONVW + c0 + i]; w2[i] = cw[2 * CONVW + c0 + i]; }
    for (int item = vcu; item < MROWS / 32; item += G) {
        const int m0 = item * 32 + half * 16; const bool hist = (m0 & (SEQ - 1)) != 0;
        float p2[8], p1[8];
#pragma unroll
        for (int i = 0; i < 8; ++i) { p2[i] = 0.f; p1[i] = 0.f; }
        if (hist) {
            const bf16* r2 = P + (size_t)(m0 - 2) * NPROJ + c0; const bf16* r1 = P + (size_t)(m0 - 1) * NPROJ + c0;
            const v4u h2 = *(const GAS v4u*)(r2 + L0_H), c2 = *(const GAS v4u*)(r2 + L0_C), h1 = *(const GAS v4u*)(r1 + L0_H), c1 = *(const GAS v4u*)(r1 + L0_C);
#pragma unroll
            for (int i = 0; i < 4; ++i) { p2[2 * i] = bf_lo(h2[i]) * bf_lo(c2[i]); p2[2 * i + 1] = bf_hi(h2[i]) * bf_hi(c2[i]); p1[2 * i] = bf_lo(h1[i]) * bf_lo(c1[i]); p1[2 * i + 1] = bf_hi(h1[i]) * bf_hi(c1[i]); }
        }
#pragma unroll 4
        for (int r = 0; r < 16; ++r) {
            const bf16* rp = P + (size_t)(m0 + r) * NPROJ + c0;
            const v4u hv = *(const GAS v4u*)(rp + L0_H), bv = *(const GAS v4u*)(rp + L0_B), cv = *(const GAS v4u*)(rp + L0_C), gv = *(const GAS v4u*)(rp + L0_GA);
            float y[8];
#pragma unroll
            for (int i = 0; i < 4; ++i) {
                const float ch0 = bf_lo(hv[i]) * bf_lo(cv[i]), ch1 = bf_hi(hv[i]) * bf_hi(cv[i]);
                const float cv0 = w0[2 * i] * p2[2 * i] + w1[2 * i] * p1[2 * i] + w2[2 * i] * ch0, cv1 = w0[2 * i + 1] * p2[2 * i + 1] + w1[2 * i + 1] * p1[2 * i + 1] + w2[2 * i + 1] * ch1;
                y[2 * i] = bf_lo(bv[i]) * cv0 * silu_f(bf_lo(gv[i])); y[2 * i + 1] = bf_hi(bv[i]) * cv1 * silu_f(bf_hi(gv[i]));
                p2[2 * i] = p1[2 * i]; p2[2 * i + 1] = p1[2 * i + 1]; p1[2 * i] = ch0; p1[2 * i + 1] = ch1;
            }
            v4u o; o.x = pkbf(y[0], y[1]); o.y = pkbf(y[2], y[3]); o.z = pkbf(y[4], y[5]); o.w = pkbf(y[6], y[7]);
            *(GAS v4u*)(MIX + (size_t)(m0 + r) * (FP8_OP0 ? CONVW : DM) + c0) = o;
        }
    }
}
__device__ __forceinline__ void kbar_phase(Frame& F, const bf16* P, float* KBAR) {
    PH_IDS();
    LAS float* red = (LAS float*)(F.lds + RING_OFF);
    const int rg = tid >> 5, cgp = tid & 31;
    for (int item = vcu; item < BATCH * MOBA_NB * 8; item += G) {
        const int cgrp = item & 7, bn = item >> 3;
        const bf16* src = P + (size_t)(bn * MOBA_BLK + rg * 16) * NPROJ + L0_K + cgrp * 256 + cgp * 8;
        float a[8];
#pragma unroll
        for (int i = 0; i < 8; ++i) a[i] = 0.f;
#pragma unroll
        for (int r = 0; r < 16; ++r) { const v4u v = *(const GAS v4u*)(src + (size_t)r * NPROJ);
#pragma unroll
            for (int i = 0; i < 4; ++i) { a[2 * i] += bf_lo(v[i]); a[2 * i + 1] += bf_hi(v[i]); } }
#pragma unroll
        for (int i = 0; i < 8; ++i) red[rg * 256 + cgp * 8 + i] = a[i];
        __syncthreads();
        if (tid < 256) { float s = 0.f;
#pragma unroll
            for (int q = 0; q < 16; ++q) s += red[q * 256 + tid];
            KBAR[(size_t)bn * 2048 + cgrp * 256 + tid] = s * (1.f / MOBA_BLK); }
        __syncthreads();
    }
}

#ifndef MFMA_MOBA
#define MFMA_MOBA 1
#endif
#ifndef MOBA_QBMASK
#define MOBA_QBMASK 0xff
#endif
#ifndef DBG_MOBA
#define DBG_MOBA 0
#endif
#ifndef DBG_STAT
#define DBG_STAT 3
#endif
template <int D> __device__ __forceinline__ float dot_row(const LAS float* qs, const bf16* kp) {
    float s0 = 0.f, s1 = 0.f;
#pragma unroll 4
    for (int c = 0; c < D / 8; ++c) { const v4u kv = *(const GAS v4u*)(kp + c * 8); const f32x4 qa = *(const LAS f32x4*)(qs + c * 8), qb = *(const LAS f32x4*)(qs + c * 8 + 4);
        s0 += bf_lo(kv.x) * qa.x + bf_hi(kv.x) * qa.y + bf_lo(kv.y) * qa.z + bf_hi(kv.y) * qa.w;
        s1 += bf_lo(kv.z) * qb.x + bf_hi(kv.z) * qb.y + bf_lo(kv.w) * qb.z + bf_hi(kv.w) * qb.w; }
    return s0 + s1;
}
__device__ __forceinline__ float log_sigmoid_f(float x) { return fminf(x, 0.f) - __logf(1.f + __expf(-fabsf(x))); }

__device__ __forceinline__ void moba_naive_phase(Frame& F, const bf16* P, const float* KBAR, const float* relb, bf16* MIX) {
    PH_IDS();
    LAS float* qs = (LAS float*)(F.lds + RING_OFF + wave * 8192);
    LAS float* sc = qs + 256;
    const int gw = vcu * NWAVES + wave, NGW = G * NWAVES;
    const float scale = 0.08838834764831845f, NEG = -__builtin_inff();
    for (int task = gw; task < MROWS * MOBA_H; task += NGW) {
        const int h = task & 15, m = task >> 4, b = m >> 11, t = m & (SEQ - 1), qb = t >> 8;
        if (!DBG_MOBA && MFMA_MOBA && ((MOBA_QBMASK >> qb) & 1)) continue;
        const unsigned qw = *(const GAS unsigned*)(P + (size_t)m * NPROJ + L0_Q + h * HD + 2 * lane);
        const float q0 = bf_lo(qw), q1 = bf_hi(qw);
        qs[2 * lane] = q0; qs[2 * lane + 1] = q1;
        LDS_WAIT();
        float gate[7];
#pragma unroll
        for (int n = 0; n < 7; ++n) { float pg = 0.f;
            if (n < qb) { const f32x2v kb = *(const GAS f32x2v*)(KBAR + (size_t)(b * 8 + n) * 2048 + h * HD + 2 * lane); pg = q0 * kb.x + q1 * kb.y; }
            gate[n] = wave_sum(pg); }
        unsigned sel = 0;
#pragma unroll
        for (int n = 0; n < 7; ++n) { int rank = 0;
#pragma unroll
            for (int n2 = 0; n2 < 7; ++n2) rank += (n2 < qb && (gate[n2] > gate[n] || (gate[n2] == gate[n] && n2 < n))) ? 1 : 0;
            if (n < qb && (qb <= 3 || rank < 3)) sel |= 1u << n; }
        sel = (unsigned)__builtin_amdgcn_readfirstlane((int)sel);
        int nk = 0; float mx = NEG;
        for (int n = 0; n <= qb; ++n) {
            if (n < qb && !((sel >> n) & 1u)) continue;
            const int kend = (n == qb) ? (t & 255) + 1 : MOBA_BLK;
            for (int k0 = 0; k0 < kend; k0 += 64) {
                const int kin = k0 + lane, key = n * MOBA_BLK + kin;
                float s = dot_row<HD>(qs, P + (size_t)(b * SEQ + key) * NPROJ + L0_K + h * HD);
                const int dist = t - key;
                s = s * scale + relb[t5_bucket(dist < 0 ? 0 : dist) * MOBA_H + h];
                s = kin < kend ? s : NEG;
                sc[nk + lane] = s; mx = fmaxf(mx, s); nk += 64;
            }
        }
        mx = wave_max(mx);
        LDS_WAIT();
        float lsum = 0.f;
        for (int i = lane; i < nk; i += 64) { const float p = __builtin_amdgcn_exp2f((sc[i] - mx) * LOG2E); sc[i] = p; lsum += p; }
        lsum = wave_sum(lsum);
        LDS_WAIT();
        float o0 = 0.f, o1 = 0.f; int idx = 0;
        for (int n = 0; n <= qb; ++n) {
            if (n < qb && !((sel >> n) & 1u)) continue;
            const int kend = (n == qb) ? (t & 255) + 1 : MOBA_BLK;
            const bf16* vp = P + (size_t)(b * SEQ + n * MOBA_BLK) * NPROJ + L0_V + h * HD + 2 * lane;
#pragma unroll 4
            for (int j = 0; j < kend; ++j) { const float p = sc[idx + j]; const unsigned vw = *(const GAS unsigned*)(vp + (size_t)j * NPROJ); o0 += p * bf_lo(vw); o1 += p * bf_hi(vw); }
            idx += (kend + 63) & ~63;
        }
        const float inv = 1.f / lsum;
        const unsigned gwd = *(const GAS unsigned*)(P + (size_t)m * NPROJ + L0_GB + h * HD + 2 * lane);
        *(GAS unsigned*)(MIX + (size_t)m * DM + CONVW + h * HD + 2 * lane) = pkbf(o0 * inv * silu_f(bf_lo(gwd)), o1 * inv * silu_f(bf_hi(gwd)));
        LDS_WAIT();
    }
}

__device__ __forceinline__ void sb_naive_phase(Frame& F, const bf16* P, bf16* MIX) {
    PH_IDS();
    LAS float* qs = (LAS float*)(F.lds + RING_OFF + wave * 8192);
    LAS float* sc = qs + 256;
    const int gw = vcu * NWAVES + wave, NGW = G * NWAVES;
    const float scale = 0.08838834764831845f;
    for (int task = gw; task < MROWS * SB_H; task += NGW) {
        const int h = task & 31, m = task >> 5, b = m >> 11, t = m & (SEQ - 1);
        const unsigned qw = *(const GAS unsigned*)(P + (size_t)m * NPROJ + L1_Q + h * HD + 2 * lane);
        qs[2 * lane] = bf_lo(qw); qs[2 * lane + 1] = bf_hi(qw);
        LDS_WAIT();
        float R = 0.f, o0 = 0.f, o1 = 0.f;
        for (int kend = t; kend > 0; kend -= 64) {
            const int key = kend - 1 - lane; const bool valid = key >= 0;
            const float z = dot_row<HD>(qs, P + (size_t)(b * SEQ + (valid ? key : 0)) * NPROJ + L1_K + h * HD) * scale;
            const float lsn = valid ? log_sigmoid_f(-z) : 0.f;
            float inc = lsn;
#pragma unroll
            for (int d = 1; d < 64; d <<= 1) { const float u = __shfl_up(inc, d); if (lane >= d) inc += u; }
            const float excl = inc - lsn, total = __shfl(inc, 63);
            sc[lane] = valid ? __expf(log_sigmoid_f(z) + R + excl) : 0.f;
            LDS_WAIT();
            const int cnt = kend < 64 ? kend : 64;
            const bf16* vp = P + (size_t)(b * SEQ + kend - 1) * NPROJ + L1_V + h * HD + 2 * lane;
#pragma unroll 4
            for (int j = 0; j < cnt; ++j) { const float p = sc[j]; const unsigned vw = *(const GAS unsigned*)(vp - (size_t)j * NPROJ); o0 += p * bf_lo(vw); o1 += p * bf_hi(vw); }
            LDS_WAIT();
            R += total;
            if (R < -88.f) break;
        }
        const unsigned gwd = *(const GAS unsigned*)(P + (size_t)m * NPROJ + L1_G + h * HD + 2 * lane);
        *(GAS unsigned*)(MIX + (size_t)m * DM + h * HD + 2 * lane) = pkbf(o0 * silu_f(bf_lo(gwd)), o1 * silu_f(bf_hi(gwd)));
    }
}

__device__ __forceinline__ void xattn_naive_phase(Frame& F, const bf16* QG, const bf16* KVX, bf16* XOIN) {
    PH_IDS();
    LAS float* qs = (LAS float*)(F.lds + RING_OFF + wave * 8192);
    LAS float* sc = qs + 256;
    const int gw = vcu * NWAVES + wave, NGW = G * NWAVES;
    for (int task = gw; task < MROWS * XH; task += NGW) {
        const int xh = task & 3, m = task >> 2, b = m >> 11;
        const unsigned long long qw = *(const GAS unsigned long long*)(QG + (size_t)m * XQW + xh * XHD + 4 * lane);
        qs[4 * lane] = bf_lo((unsigned)qw); qs[4 * lane + 1] = bf_hi((unsigned)qw); qs[4 * lane + 2] = bf_lo((unsigned)(qw >> 32)); qs[4 * lane + 3] = bf_hi((unsigned)(qw >> 32));
        LDS_WAIT();
        float mx = -__builtin_inff();
#pragma unroll 1
        for (int c = 0; c < 4; ++c) { const int key = c * 64 + lane;
            const float s = dot_row<XHD>(qs, KVX + (size_t)(b * NMEM + key) * KVLD + xh * XHD) * 0.0625f; sc[key] = s; mx = fmaxf(mx, s); }
        mx = wave_max(mx);
        LDS_WAIT();
        float lsum = 0.f;
#pragma unroll
        for (int c = 0; c < 4; ++c) { const float p = __builtin_amdgcn_exp2f((sc[c * 64 + lane] - mx) * LOG2E); sc[c * 64 + lane] = p; lsum += p; }
        lsum = wave_sum(lsum);
        LDS_WAIT();
        float o[4] = {0.f, 0.f, 0.f, 0.f};
        const bf16* vp = KVX + (size_t)(b * NMEM) * KVLD + XW + xh * XHD + 4 * lane;
#pragma unroll 4
        for (int j = 0; j < NMEM; ++j) { const float p = sc[j]; const unsigned long long vw = *(const GAS unsigned long long*)(vp + (size_t)j * KVLD);
            o[0] += p * bf_lo((unsigned)vw); o[1] += p * bf_hi((unsigned)vw); o[2] += p * bf_lo((unsigned)(vw >> 32)); o[3] += p * bf_hi((unsigned)(vw >> 32)); }
        const float inv = 1.f / lsum;
        const unsigned long long gq = *(const GAS unsigned long long*)(QG + (size_t)m * XQW + XW + xh * XHD + 4 * lane);
        const unsigned r0 = pkbf(o[0] * inv * silu_f(bf_lo((unsigned)gq)), o[1] * inv * silu_f(bf_hi((unsigned)gq)));
        const unsigned r1 = pkbf(o[2] * inv * silu_f(bf_lo((unsigned)(gq >> 32))), o[3] * inv * silu_f(bf_hi((unsigned)(gq >> 32))));
        *(GAS unsigned long long*)(XOIN + (size_t)m * XW + xh * XHD + 4 * lane) = (unsigned long long)r0 | ((unsigned long long)r1 << 32);
        LDS_WAIT();
    }
}

#ifndef MOBA_DMA
#define MOBA_DMA 1
#endif
#ifndef MOBA_QBMASK
#define MOBA_QBMASK 0xff
#endif
namespace att {
typedef short s16x4 __attribute__((ext_vector_type(4)));
typedef float f32x16 __attribute__((ext_vector_type(16)));
constexpr int SHM_K = 16384, SHM_V = 16384;
constexpr int OFF_V = 0, OFF_K = 2 * SHM_V;
constexpr int MOFF_V = 0, MOFF_K = 3 * SHM_V;
constexpr int SMALL = LDSCTL_OFF + 1024;
constexpr int OFF_KBAR = SMALL, OFF_TB = SMALL + 4096, OFF_AL = OFF_TB + 512, OFF_LI = OFF_AL + 1024, OFF_FLAG = OFF_LI + 1024;
static_assert(OFF_FLAG + 64 <= LDS_BYTES, "small LDS tables");
#define KSWZ(row, colB) ((row) * 256 + ((colB) ^ (((row) & 7) << 4)))
__device__ __forceinline__ int v_st(int k, int c) { const int kk = (k & ~0xC) | ((k & 4) << 1) | ((k & 8) >> 1); return ((kk >> 3) * 4 + (c >> 5)) * 512 + ((kk & 7) * 32 + (c & 31)) * 2; }
__device__ __forceinline__ int v_rd_base(int lane) { return ((lane & 3) << 3) | (((lane >> 2) & 3) << 6) | (((lane >> 4) & 1) << 5) | (((lane >> 5) & 1) << 8); }
constexpr int v_rd_off(int d0, int ks, int half) { return d0 * 512 + ks * 4096 + half * 2048; }
__device__ __forceinline__ int crow(int r, int hi) { return (r & 3) + 8 * (r >> 2) + 4 * hi; }
__device__ __forceinline__ float swap_max(float x) { auto rr = __builtin_amdgcn_permlane32_swap(__float_as_uint(x), __float_as_uint(x), false, false); const unsigned u0 = rr[0], u1 = rr[1];
    return fmaxf(__uint_as_float(u0), __uint_as_float(u1)); }
__device__ __forceinline__ float swap_add(float x) { auto rr = __builtin_amdgcn_permlane32_swap(__float_as_uint(x), __float_as_uint(x), false, false); const unsigned u0 = rr[0], u1 = rr[1];
    return __uint_as_float(u0) + __uint_as_float(u1); }
__device__ __forceinline__ float swap_get(float x, int hi) { auto rr = __builtin_amdgcn_permlane32_swap(__float_as_uint(x), __float_as_uint(x), false, false); const unsigned u0 = rr[0], u1 = rr[1];
    return __uint_as_float(hi ? u0 : u1); }
#define ATT_PK4(P, B_, OUT) do { const unsigned a0 = pkbf(P[B_ + 0], P[B_ + 1]), a1 = pkbf(P[B_ + 2], P[B_ + 3]), b0 = pkbf(P[B_ + 4], P[B_ + 5]), b1 = pkbf(P[B_ + 6], P[B_ + 7]); \
        auto r0 = __builtin_amdgcn_permlane32_swap(a0, b0, false, false); auto r1 = __builtin_amdgcn_permlane32_swap(a1, b1, false, false); \
        v4u w_ = {r0[0], r1[0], r0[1], r1[1]}; OUT = __builtin_bit_cast(bf16x8, w_); } while (0)
__device__ __forceinline__ void qkt(f32x16& p0, f32x16& p1, const char* kt, int r32, int hi, const bf16x8* qr) {
    p0 = f32x16{}; p1 = f32x16{};
    const char* kb[4];
#pragma unroll
    for (int dd = 0; dd < 4; ++dd) kb[dd] = kt + KSWZ(r32, (dd * 16 + hi * 8) * 2);
#pragma unroll
    for (int d0 = 0; d0 < 8; ++d0) { const char* a = kb[d0 & 3] + (d0 >> 2) * 128;
        const bf16x8 b0 = *reinterpret_cast<const bf16x8*>(a);
        const bf16x8 b1 = *reinterpret_cast<const bf16x8*>(a + 32 * 256);
        p0 = __builtin_amdgcn_mfma_f32_32x32x16_bf16(b0, qr[d0], p0, 0, 0, 0);
        p1 = __builtin_amdgcn_mfma_f32_32x32x16_bf16(b1, qr[d0], p1, 0, 0, 0); }
}
__device__ __forceinline__ void pv_tile(f32x16* o, int vb, bf16x8 pa0, bf16x8 pa1, bf16x8 pa2, bf16x8 pa3) {
#define ATT_TRRD(dst, off) asm volatile("ds_read_b64_tr_b16 %0, %1 offset:%2" : "=&v"(dst) : "v"(vb), "i"(off) : "memory")
#define ATT_PV_D0(d0) do { s16x4 l0, l1, l2, l3, h0, h1, h2, h3; constexpr int b_ = v_rd_off(d0, 0, 0); \
        ATT_TRRD(l0, b_); ATT_TRRD(h0, b_ + 2048); ATT_TRRD(l1, b_ + 4096); ATT_TRRD(h1, b_ + 6144); ATT_TRRD(l2, b_ + 8192); ATT_TRRD(h2, b_ + 10240); ATT_TRRD(l3, b_ + 12288); ATT_TRRD(h3, b_ + 14336); \
        asm volatile("s_waitcnt lgkmcnt(0)" ::: "memory"); __builtin_amdgcn_sched_barrier(0); \
        o[d0] = __builtin_amdgcn_mfma_f32_32x32x16_bf16(pa0, (bf16x8){l0[0], l0[1], l0[2], l0[3], h0[0], h0[1], h0[2], h0[3]}, o[d0], 0, 0, 0); \
        o[d0] = __builtin_amdgcn_mfma_f32_32x32x16_bf16(pa1, (bf16x8){l1[0], l1[1], l1[2], l1[3], h1[0], h1[1], h1[2], h1[3]}, o[d0], 0, 0, 0); \
        o[d0] = __builtin_amdgcn_mfma_f32_32x32x16_bf16(pa2, (bf16x8){l2[0], l2[1], l2[2], l2[3], h2[0], h2[1], h2[2], h2[3]}, o[d0], 0, 0, 0); \
        o[d0] = __builtin_amdgcn_mfma_f32_32x32x16_bf16(pa3, (bf16x8){l3[0], l3[1], l3[2], l3[3], h3[0], h3[1], h3[2], h3[3]}, o[d0], 0, 0, 0); } while (0)
    ATT_PV_D0(0); ATT_PV_D0(1); ATT_PV_D0(2); ATT_PV_D0(3);
#undef ATT_PV_D0
#undef ATT_TRRD
}
struct Stage { bf16x8 k0, k1, v0, v1; };
__device__ __forceinline__ void stage_load(Stage& S, const bf16* Kg, const bf16* Vg, int kbase, int sr) {
    S.k0 = *(const GAS bf16x8*)(Kg + (size_t)(kbase + sr) * NPROJ); S.k1 = *(const GAS bf16x8*)(Kg + (size_t)(kbase + 32 + sr) * NPROJ);
    S.v0 = *(const GAS bf16x8*)(Vg + (size_t)(kbase + sr) * NPROJ); S.v1 = *(const GAS bf16x8*)(Vg + (size_t)(kbase + 32 + sr) * NPROJ);
}
__device__ __forceinline__ void stage_write(const Stage& S, char* lds, int bf, int kws, int vst0, int vst1) {
    *(bf16x8*)(lds + OFF_K + bf * SHM_K + kws) = S.k0; *(bf16x8*)(lds + OFF_K + bf * SHM_K + kws + 32 * 256) = S.k1;
    *(bf16x8*)(lds + OFF_V + bf * SHM_V + vst0) = S.v0; *(bf16x8*)(lds + OFF_V + bf * SHM_V + vst1) = S.v1;
}
__device__ __forceinline__ void mstage_write(const Stage& S, char* lds, int kbf, int vbf, int kws, int vst0, int vst1) {
    *(bf16x8*)(lds + MOFF_K + kbf * SHM_K + kws) = S.k0; *(bf16x8*)(lds + MOFF_K + kbf * SHM_K + kws + 32 * 256) = S.k1;
    *(bf16x8*)(lds + MOFF_V + vbf * SHM_V + vst0) = S.v0; *(bf16x8*)(lds + MOFF_V + vbf * SHM_V + vst1) = S.v1;
}
__device__ __forceinline__ void o_epilogue(const f32x16* o, char* lds, int wave, int lane, int r32, int hi, bool use_li, const bf16* grow  , int ldg, bf16* orow  , int ldo, float f8s = 0.f  ) {
    float* ost = (float*)(lds + wave * 16384);
    const float* lil = (const float*)(lds + OFF_LI) + wave * 32;
    v4u g[8];
#pragma unroll
    for (int i = 0; i < 8; ++i) { const int e = (i * 64 + lane) * 8, row = e >> 7, col = e & 127; g[i] = *(const GAS v4u*)(grow + (size_t)row * ldg + col); }
#pragma unroll
    for (int d0 = 0; d0 < 4; ++d0)
#pragma unroll
        for (int r = 0; r < 16; ++r) ost[crow(r, hi) * 128 + d0 * 32 + r32] = o[d0][r];
    asm volatile("s_waitcnt lgkmcnt(0)" ::: "memory");
#pragma unroll
    for (int i = 0; i < 8; ++i) { const int e = (i * 64 + lane) * 8, row = e >> 7, col = e & 127;
        const f32x4 a = *(const f32x4*)(ost + e), c = *(const f32x4*)(ost + e + 4); const float inv = use_li ? lil[row] : 1.f;
        v4u w; w.x = pkbf(a.x * inv * silu_f(bf_lo(g[i].x)), a.y * inv * silu_f(bf_hi(g[i].x))); w.y = pkbf(a.z * inv * silu_f(bf_lo(g[i].y)), a.w * inv * silu_f(bf_hi(g[i].y)));
        w.z = pkbf(c.x * inv * silu_f(bf_lo(g[i].z)), c.y * inv * silu_f(bf_hi(g[i].z))); w.w = pkbf(c.z * inv * silu_f(bf_lo(g[i].w)), c.w * inv * silu_f(bf_hi(g[i].w)));
        if (f8s != 0.f) { const float t_ = inv * f8s;
            const unsigned lo8 = pk8(a.x * t_ * silu_f(bf_lo(g[i].x)), a.y * t_ * silu_f(bf_hi(g[i].x)), a.z * t_ * silu_f(bf_lo(g[i].y)), a.w * t_ * silu_f(bf_hi(g[i].y)));
            const unsigned hi8 = pk8(c.x * t_ * silu_f(bf_lo(g[i].z)), c.y * t_ * silu_f(bf_hi(g[i].z)), c.z * t_ * silu_f(bf_lo(g[i].w)), c.w * t_ * silu_f(bf_hi(g[i].w)));
            *(GAS unsigned long long*)((unsigned char*)orow + (size_t)row * ldo + col) = (unsigned long long)lo8 | ((unsigned long long)hi8 << 32); continue; }
        *(GAS v4u*)(orow + (size_t)row * ldo + col) = w; }
}

__device__ __forceinline__ void moba_unit(char* lds, const bf16* P, const float* KBAR, const float* relb, bf16* MIX, int b, int h, int qb, int tid_in, int lane_in, int wave) {
    int tid = tid_in, lane = lane_in; asm volatile("" : "+v"(tid), "+v"(lane));
    const int r32 = lane & 31, hi = lane >> 5;
    const int qw0 = qb * MOBA_BLK + wave * 32;
    const size_t rowbase = (size_t)b * SEQ;
    float* kbl = (float*)(lds + OFF_KBAR); float* tbl = (float*)(lds + OFF_TB); float* all = (float*)(lds + OFF_AL) + wave * 32; float* lil = (float*)(lds + OFF_LI) + wave * 32;
    for (int i = tid; i < 1024; i += NWAVES * 64) kbl[i] = KBAR[(size_t)(b * 8 + (i >> 7)) * 2048 + h * HD + (i & 127)];
    if (tid < 128) tbl[tid] = relb[t5_bucket(tid) * MOBA_H + h] * LOG2E;
    bf16x8 qr[8];
    { const bf16* qp = P + (rowbase + qw0 + r32) * NPROJ + L0_Q + h * HD + hi * 8;
#pragma unroll
      for (int d0 = 0; d0 < 8; ++d0) qr[d0] = *(const GAS bf16x8*)(qp + d0 * 16); }
    const int sr = tid >> 4, sc = (tid & 15) * 8, kws = KSWZ(sr, sc * 2), vst0 = v_st(sr, sc), vst1 = v_st(32 + sr, sc);
    const bf16* Kg = P + rowbase * NPROJ + L0_K + h * HD + sc; const bf16* Vg = P + rowbase * NPROJ + L0_V + h * HD + sc;
    const int NT = 4 * (qb + 1);
    Stage S; stage_load(S, Kg, Vg, 0, sr);
    __syncthreads();
    unsigned selmask = 0;
    { float gate[7];
#pragma unroll
      for (int n = 0; n < 7; ++n) { float g = 0.f;
          if (n < qb) {
#pragma unroll
              for (int d0 = 0; d0 < 8; ++d0) { const f32x4 ka = *(const f32x4*)(kbl + n * 128 + d0 * 16 + hi * 8), kc = *(const f32x4*)(kbl + n * 128 + d0 * 16 + hi * 8 + 4);
                  const v4u qw = __builtin_bit_cast(v4u, qr[d0]);
                  g += bf_lo(qw.x) * ka.x + bf_hi(qw.x) * ka.y + bf_lo(qw.y) * ka.z + bf_hi(qw.y) * ka.w + bf_lo(qw.z) * kc.x + bf_hi(qw.z) * kc.y + bf_lo(qw.w) * kc.z + bf_hi(qw.w) * kc.w; }
              g = swap_add(g); }
          gate[n] = g; }
#pragma unroll
      for (int n = 0; n < 7; ++n) { int rank = 0;
#pragma unroll
          for (int n2 = 0; n2 < 7; ++n2) rank += (n2 < qb && (gate[n2] > gate[n] || (gate[n2] == gate[n] && n2 < n))) ? 1 : 0;
          if (n < qb && (qb <= 3 || rank < 3)) selmask |= 1u << n; } }
    asm volatile("s_waitcnt vmcnt(0)" ::: "memory"); mstage_write(S, lds, 0, 0, kws, vst0, vst1);
    __syncthreads();
    const float C2 = 0.08838834764831845f * LOG2E, NEG = -__builtin_inff();
    const float c31 = tbl[127];
    float m_run = -1e30f, l_run = 0.f; f32x16 o[4] = {};
    const int vb0 = (int)(uintptr_t)(lds + MOFF_V) + v_rd_base(lane);
    const bool late = wave >= 4; bool pend = false; int pend_vb = 0; bf16x8 pa0, pa1, pa2, pa3;
    int vbuf = 0;
#if defined(DBG_TLOOP_MOBA)
    unsigned long long tl0_ = 0; if (tid == 0) tl0_ = __builtin_amdgcn_s_memrealtime();
#endif
#if defined(DBG_SEG)
    unsigned long long sg_[5] = {0, 0, 0, 0, 0}; unsigned long long st_ = __builtin_amdgcn_s_memtime();
#define SEG(k) do { const unsigned long long n_ = __builtin_amdgcn_s_memtime(); sg_[k] += n_ - st_; st_ = n_; } while (0)
#else
#define SEG(k) do {} while (0)
#endif
    for (int t = 0; t < NT; ++t) {
        if (t + 1 < NT) stage_load(S, Kg, Vg, (t + 1) * 64, sr);
        const int n = t >> 2, kb = t * 64, bf = t & 1;
        SEG(4);
        if (late && pend) { pv_tile(o, pend_vb, pa0, pa1, pa2, pa3); pend = false; }
        const bool rowsel = n < qb ? ((selmask >> n) & 1u) != 0u : true;
        const bool act = n < qb ? (__ballot(rowsel) != 0ull) : (kb <= qw0 + 31);
        if (act) {
            f32x16 p0, p1;
            qkt(p0, p1, lds + MOFF_K + bf * SHM_K, r32, hi, qr);
            asm volatile("" : "+v"(p0), "+v"(p1)); SEG(0);
            const int dq = qw0 + r32 - kb - 4 * hi;
            if (qw0 - (kb + 63) < 113) {
#pragma unroll
                for (int g = 0; g < 4; ++g) {
#pragma unroll
                    for (int i = 0; i < 4; ++i) { const int r = 4 * g + i, c = i + 8 * g; const int d0_ = dq - c, d1_ = dq - c - 32;
                        const float b0 = tbl[d0_ < 0 ? 0 : (d0_ > 127 ? 127 : d0_)], b1 = tbl[d1_ < 0 ? 0 : (d1_ > 127 ? 127 : d1_)];
                        const float s0 = fmaf(p0[r], C2, b0), s1 = fmaf(p1[r], C2, b1);
                        p0[r] = (d0_ >= 0 && rowsel) ? s0 : NEG; p1[r] = (d1_ >= 0 && rowsel) ? s1 : NEG; }
                    __builtin_amdgcn_sched_barrier(0); }
            } else {
#pragma unroll
                for (int r = 0; r < 16; ++r) { p0[r] = rowsel ? fmaf(p0[r], C2, c31) : NEG; p1[r] = rowsel ? fmaf(p1[r], C2, c31) : NEG; }
            }
            float pmax = p0[0];
#pragma unroll
            for (int r = 1; r < 16; ++r) pmax = fmaxf(pmax, p0[r]);
#pragma unroll
            for (int r = 0; r < 16; ++r) pmax = fmaxf(pmax, p1[r]);
            pmax = swap_max(pmax);
            const float mn = fmaxf(m_run, pmax), alpha = __builtin_amdgcn_exp2f(m_run - mn); m_run = mn;
            float ps = 0.f;
#pragma unroll
            for (int r = 0; r < 16; ++r) { p0[r] = __builtin_amdgcn_exp2f(p0[r] - mn); p1[r] = __builtin_amdgcn_exp2f(p1[r] - mn); ps += p0[r] + p1[r]; }
            ps = swap_add(ps);
            l_run = l_run * alpha + ps;
            if (__any(alpha < 1.f)) {
                if (hi == 0) all[r32] = alpha;
                asm volatile("s_waitcnt lgkmcnt(0)" ::: "memory");
#pragma unroll
                for (int g = 0; g < 4; ++g) { const f32x4 av = *(const f32x4*)(all + 8 * g + 4 * hi);
#pragma unroll
                    for (int d0 = 0; d0 < 4; ++d0) { o[d0][4 * g + 0] *= av.x; o[d0][4 * g + 1] *= av.y; o[d0][4 * g + 2] *= av.z; o[d0][4 * g + 3] *= av.w; } }
            }
            ATT_PK4(p0, 0, pa0); ATT_PK4(p0, 8, pa1); ATT_PK4(p1, 0, pa2); ATT_PK4(p1, 8, pa3);
            asm volatile("" : "+v"(pa0), "+v"(pa1), "+v"(pa2), "+v"(pa3)); SEG(1);
            if (late) { pend = true; pend_vb = vb0 + vbuf * SHM_V; } else pv_tile(o, vb0 + vbuf * SHM_V, pa0, pa1, pa2, pa3);
        }
        asm volatile("" : "+v"(o[0]), "+v"(o[1]), "+v"(o[2]), "+v"(o[3])); SEG(2);
        const int vnext = vbuf == 2 ? 0 : vbuf + 1;
        if (t + 1 < NT) { asm volatile("s_waitcnt vmcnt(0)" ::: "memory"); mstage_write(S, lds, (t + 1) & 1, vnext, kws, vst0, vst1); }
        vbuf = vnext;
        __syncthreads();
        SEG(3);
    }
#if defined(DBG_SEG)
    if (blockIdx.x == 0 && tid == 0) { volatile unsigned* M_ = (volatile unsigned*)(lds + MISC_OFF); const unsigned long long a_ = (((unsigned long long)M_[17] << 32) | M_[16]) + sg_[DBG_SEG]; M_[16] = (unsigned)a_; M_[17] = (unsigned)(a_ >> 32); }
#endif
    if (late && pend) pv_tile(o, pend_vb, pa0, pa1, pa2, pa3);
#if defined(DBG_TLOOP_MOBA)
    if (tid == 0) { volatile unsigned* M_ = (volatile unsigned*)(lds + MISC_OFF); const unsigned long long d_ = __builtin_amdgcn_s_memrealtime() - tl0_; const unsigned long long a_ = (((unsigned long long)M_[17] << 32) | M_[16]) + d_; M_[16] = (unsigned)a_; M_[17] = (unsigned)(a_ >> 32); }
#endif
    __syncthreads();
    if (hi == 0) lil[r32] = 1.f / l_run;
    o_epilogue(o, lds, wave, lane, r32, hi, true, P + (rowbase + qw0) * NPROJ + L0_GB + h * HD, NPROJ, MIX + (rowbase + qw0) * DM + CONVW + h * HD, DM);
    __syncthreads();
}
__device__ __forceinline__ void moba_unit_dma(char* lds, const bf16* P, const float* KBAR, const float* relb, bf16* MIX, int b, int h, int qb, int tid_in, int lane_in, int wave) {
    int tid = tid_in, lane = lane_in; asm volatile("" : "+v"(tid), "+v"(lane));
    const int r32 = lane & 31, hi = lane >> 5;
    const int qw0 = qb * MOBA_BLK + wave * 32;
    const size_t rowbase = (size_t)b * SEQ;
    float* kbl = (float*)(lds + OFF_KBAR); float* tbl = (float*)(lds + OFF_TB); float* all = (float*)(lds + OFF_AL) + wave * 32; float* lil = (float*)(lds + OFF_LI) + wave * 32;
    for (int i = tid; i < 1024; i += NWAVES * 64) kbl[i] = KBAR[(size_t)(b * 8 + (i >> 7)) * 2048 + h * HD + (i & 127)];
    if (tid < 128) tbl[tid] = relb[t5_bucket(tid) * MOBA_H + h] * LOG2E;
    bf16x8 qr[8];
    { const bf16* qp = P + (rowbase + qw0 + r32) * NPROJ + L0_Q + h * HD + hi * 8;
#pragma unroll
      for (int d0 = 0; d0 < 8; ++d0) qr[d0] = *(const GAS bf16x8*)(qp + d0 * 16); }
    unsigned gofK[2], gofV[2];
#pragma unroll
    for (int i = 0; i < 2; ++i) { const int q = 2 * wave + i;
        { const int row = 4 * q + (lane >> 4), colB = ((lane & 15) * 16) ^ ((row & 7) << 4); gofK[i] = (unsigned)(row * NPROJ + (colB >> 1)); }
        { const int sub = 2 * q + (lane >> 5), kk = (sub >> 2) * 8 + ((lane & 31) >> 2), c = (sub & 3) * 32 + (lane & 3) * 8, k = (kk & ~0xC) | ((kk & 4) << 1) | ((kk & 8) >> 1); gofV[i] = (unsigned)(k * NPROJ + c); } }
    const bf16* Kg = P + rowbase * NPROJ + L0_K + h * HD; const bf16* Vg = P + rowbase * NPROJ + L0_V + h * HD;
#define MDMA(t_, buf_) do { _Pragma("unroll") for (int i_ = 0; i_ < 2; ++i_) { \
        __builtin_amdgcn_global_load_lds((const unsigned*)(Kg + (size_t)(t_) * 64 * NPROJ + gofK[i_]), (__attribute__((address_space(3))) unsigned*)(lds + MOFF_K + (buf_) * SHM_K + (2 * wave + i_) * 1024), 16, 0, 0); \
        __builtin_amdgcn_global_load_lds((const unsigned*)(Vg + (size_t)(t_) * 64 * NPROJ + gofV[i_]), (__attribute__((address_space(3))) unsigned*)(lds + MOFF_V + (buf_) * SHM_V + (2 * wave + i_) * 1024), 16, 0, 0); } } while (0)
    const int NT = 4 * (qb + 1);
    __syncthreads();
    MDMA(0, 0); MDMA(1, 1);
    unsigned selmask = 0;
    { float gate[7];
#pragma unroll
      for (int n = 0; n < 7; ++n) { float g = 0.f;
          if (n < qb) {
#pragma unroll
              for (int d0 = 0; d0 < 8; ++d0) { const f32x4 ka = *(const f32x4*)(kbl + n * 128 + d0 * 16 + hi * 8), kc = *(const f32x4*)(kbl + n * 128 + d0 * 16 + hi * 8 + 4);
                  const v4u qw = __builtin_bit_cast(v4u, qr[d0]);
                  g += bf_lo(qw.x) * ka.x + bf_hi(qw.x) * ka.y + bf_lo(qw.y) * ka.z + bf_hi(qw.y) * ka.w + bf_lo(qw.z) * kc.x + bf_hi(qw.z) * kc.y + bf_lo(qw.w) * kc.z + bf_hi(qw.w) * kc.w; }
              g = swap_add(g); }
          gate[n] = g; }
#pragma unroll
      for (int n = 0; n < 7; ++n) { int rank = 0;
#pragma unroll
          for (int n2 = 0; n2 < 7; ++n2) rank += (n2 < qb && (gate[n2] > gate[n] || (gate[n2] == gate[n] && n2 < n))) ? 1 : 0;
          if (n < qb && (qb <= 3 || rank < 3)) selmask |= 1u << n; } }
    asm volatile("s_waitcnt vmcnt(4)" ::: "memory"); __builtin_amdgcn_s_barrier(); asm volatile("" ::: "memory");
    const float C2 = 0.08838834764831845f * LOG2E, NEG = -__builtin_inff();
    const float c31 = tbl[127];
    float m_run = -1e30f, l_run = 0.f; f32x16 o[4] = {};
    const int vb0 = (int)(uintptr_t)(lds + MOFF_V) + v_rd_base(lane);
    bf16x8 pa0, pa1, pa2, pa3;
    int rb = 0;
#if defined(DBG_TLOOP_MOBA)
    unsigned long long tl0_ = 0; if (tid == 0) tl0_ = __builtin_amdgcn_s_memrealtime();
#endif
#if defined(DBG_SEG)
    unsigned long long sg_[5] = {0, 0, 0, 0, 0}; unsigned long long st_ = __builtin_amdgcn_s_memtime();
#define SEG(k) do { const unsigned long long n_ = __builtin_amdgcn_s_memtime(); sg_[k] += n_ - st_; st_ = n_; } while (0)
#else
#define SEG(k) do {} while (0)
#endif
    for (int t = 0; t < NT; ++t) {
        { const int nb2 = rb == 0 ? 2 : rb - 1; if (t + 2 < NT) MDMA(t + 2, nb2); }
        const int n = t >> 2, kb = t * 64;
        SEG(4);
        const bool rowsel = n < qb ? ((selmask >> n) & 1u) != 0u : true;
        const bool act = n < qb ? (__ballot(rowsel) != 0ull) : (kb <= qw0 + 31);
        if (act) {
            f32x16 p0, p1;
            qkt(p0, p1, lds + MOFF_K + rb * SHM_K, r32, hi, qr);
            asm volatile("" : "+v"(p0), "+v"(p1)); SEG(0);
            const int dq = qw0 + r32 - kb - 4 * hi;
            if (qw0 - (kb + 63) < 113) {
#pragma unroll
                for (int g = 0; g < 4; ++g) {
#pragma unroll
                    for (int i = 0; i < 4; ++i) { const int r = 4 * g + i, c = i + 8 * g; const int d0_ = dq - c, d1_ = dq - c - 32;
                        const float b0 = tbl[d0_ < 0 ? 0 : (d0_ > 127 ? 127 : d0_)], b1 = tbl[d1_ < 0 ? 0 : (d1_ > 127 ? 127 : d1_)];
                        const float s0 = fmaf(p0[r], C2, b0), s1 = fmaf(p1[r], C2, b1);
                        p0[r] = (d0_ >= 0 && rowsel) ? s0 : NEG; p1[r] = (d1_ >= 0 && rowsel) ? s1 : NEG; }
                    __builtin_amdgcn_sched_barrier(0); }
            } else {
#pragma unroll
                for (int r = 0; r < 16; ++r) { p0[r] = rowsel ? fmaf(p0[r], C2, c31) : NEG; p1[r] = rowsel ? fmaf(p1[r], C2, c31) : NEG; }
            }
            float pmax = p0[0];
#pragma unroll
            for (int r = 1; r < 16; ++r) pmax = fmaxf(pmax, p0[r]);
#pragma unroll
            for (int r = 0; r < 16; ++r) pmax = fmaxf(pmax, p1[r]);
            pmax = swap_max(pmax);
            const float mn = fmaxf(m_run, pmax), alpha = __builtin_amdgcn_exp2f(m_run - mn); m_run = mn;
            float ps = 0.f;
#pragma unroll
            for (int r = 0; r < 16; ++r) { p0[r] = __builtin_amdgcn_exp2f(p0[r] - mn); p1[r] = __builtin_amdgcn_exp2f(p1[r] - mn); ps += p0[r] + p1[r]; }
            ps = swap_add(ps);
            l_run = l_run * alpha + ps;
            if (__any(alpha < 1.f)) {
                if (hi == 0) all[r32] = alpha;
                asm volatile("s_waitcnt lgkmcnt(0)" ::: "memory");
#pragma unroll
                for (int g = 0; g < 4; ++g) { const f32x4 av = *(const f32x4*)(all + 8 * g + 4 * hi);
#pragma unroll
                    for (int d0 = 0; d0 < 4; ++d0) { o[d0][4 * g + 0] *= av.x; o[d0][4 * g + 1] *= av.y; o[d0][4 * g + 2] *= av.z; o[d0][4 * g + 3] *= av.w; } }
            }
            ATT_PK4(p0, 0, pa0); ATT_PK4(p0, 8, pa1); ATT_PK4(p1, 0, pa2); ATT_PK4(p1, 8, pa3);
            asm volatile("" : "+v"(pa0), "+v"(pa1), "+v"(pa2), "+v"(pa3)); SEG(1);
            pv_tile(o, vb0 + rb * SHM_V, pa0, pa1, pa2, pa3);
        }
        asm volatile("" : "+v"(o[0]), "+v"(o[1]), "+v"(o[2]), "+v"(o[3])); SEG(2);
        rb = rb == 2 ? 0 : rb + 1;
        if (t + 2 < NT) asm volatile("s_waitcnt vmcnt(4) lgkmcnt(0)" ::: "memory"); else asm volatile("s_waitcnt vmcnt(0) lgkmcnt(0)" ::: "memory");
        __builtin_amdgcn_s_barrier(); asm volatile("" ::: "memory");
        SEG(3);
    }
#if defined(DBG_SEG)
    if (blockIdx.x == 0 && tid == 0) { volatile unsigned* M_ = (volatile unsigned*)(lds + MISC_OFF); const unsigned long long a_ = (((unsigned long long)M_[17] << 32) | M_[16]) + sg_[DBG_SEG]; M_[16] = (unsigned)a_; M_[17] = (unsigned)(a_ >> 32); }
#endif
#if defined(DBG_TLOOP_MOBA)
    if (tid == 0) { volatile unsigned* M_ = (volatile unsigned*)(lds + MISC_OFF); const unsigned long long d_ = __builtin_amdgcn_s_memrealtime() - tl0_; const unsigned long long a_ = (((unsigned long long)M_[17] << 32) | M_[16]) + d_; M_[16] = (unsigned)a_; M_[17] = (unsigned)(a_ >> 32); }
#endif
    __syncthreads();
    if (hi == 0) lil[r32] = 1.f / l_run;
    if (FP8_OP0) o_epilogue(o, lds, wave, lane, r32, hi, true, P + (rowbase + qw0) * NPROJ + L0_GB + h * HD, NPROJ, (bf16*)((unsigned char*)MIX + MIX8_OFF + (rowbase + qw0) * CONVW + h * HD), CONVW, MO8_SCALE);
    else o_epilogue(o, lds, wave, lane, r32, hi, true, P + (rowbase + qw0) * NPROJ + L0_GB + h * HD, NPROJ, MIX + (rowbase + qw0) * DM + CONVW + h * HD, DM);
    __syncthreads();
}
#undef MDMA

__device__ __forceinline__ void moba_unit_dma2(char* lds, const bf16* P, const float* KBAR, const float* relb, bf16* MIX, int b, int h, int qb, int tid_in, int lane_in, int wave) {
    int tid = tid_in, lane = lane_in; asm volatile("" : "+v"(tid), "+v"(lane));
    const int r32 = lane & 31, hi = lane >> 5;
    const int qw0 = qb * MOBA_BLK + wave * 32;
    const size_t rowbase = (size_t)b * SEQ;
    constexpr int RV = 0, RK = 4 * SHM_V;
    float* kbl = (float*)(lds + OFF_KBAR); float* tbl = (float*)(lds + OFF_TB); float* all = (float*)(lds + OFF_AL) + wave * 32; float* lil = (float*)(lds + OFF_LI) + wave * 32;
    for (int i = tid; i < 1024; i += NWAVES * 64) kbl[i] = KBAR[(size_t)(b * 8 + (i >> 7)) * 2048 + h * HD + (i & 127)];
    if (tid < 128) tbl[tid] = relb[t5_bucket(tid) * MOBA_H + h] * LOG2E;
    bf16x8 qr[8];
    { const bf16* qp = P + (rowbase + qw0 + r32) * NPROJ + L0_Q + h * HD + hi * 8;
#pragma unroll
      for (int d0 = 0; d0 < 8; ++d0) qr[d0] = *(const GAS bf16x8*)(qp + d0 * 16); }
    unsigned gofK[2], gofV[2];
#pragma unroll
    for (int i = 0; i < 2; ++i) { const int q = 2 * wave + i;
        { const int row = 4 * q + (lane >> 4), colB = ((lane & 15) * 16) ^ ((row & 7) << 4); gofK[i] = (unsigned)(row * NPROJ + (colB >> 1)); }
        { const int sub = 2 * q + (lane >> 5), kk = (sub >> 2) * 8 + ((lane & 31) >> 2), c = (sub & 3) * 32 + (lane & 3) * 8, k = (kk & ~0xC) | ((kk & 4) << 1) | ((kk & 8) >> 1); gofV[i] = (unsigned)(k * NPROJ + c); } }
    const bf16* Kg = P + rowbase * NPROJ + L0_K + h * HD; const bf16* Vg = P + rowbase * NPROJ + L0_V + h * HD;
#define M2DMA(t_, slot_) do { _Pragma("unroll") for (int i_ = 0; i_ < 2; ++i_) { \
        __builtin_amdgcn_global_load_lds((const unsigned*)(Kg + (size_t)(t_) * 64 * NPROJ + gofK[i_]), (__attribute__((address_space(3))) unsigned*)(lds + RK + (slot_) * SHM_K + (2 * wave + i_) * 1024), 16, 0, 0); \
        __builtin_amdgcn_global_load_lds((const unsigned*)(Vg + (size_t)(t_) * 64 * NPROJ + gofV[i_]), (__attribute__((address_space(3))) unsigned*)(lds + RV + (slot_) * SHM_V + (2 * wave + i_) * 1024), 16, 0, 0); } } while (0)
    const int NT = 4 * (qb + 1);
    __syncthreads();
    M2DMA(0, 0); M2DMA(1, 1); M2DMA(2, 2);
    unsigned selmask = 0;
    { float gate[7];
#pragma unroll
      for (int n = 0; n < 7; ++n) { float g = 0.f;
          if (n < qb) {
#pragma unroll
              for (int d0 = 0; d0 < 8; ++d0) { const f32x4 ka = *(const f32x4*)(kbl + n * 128 + d0 * 16 + hi * 8), kc = *(const f32x4*)(kbl + n * 128 + d0 * 16 + hi * 8 + 4);
                  const v4u qw = __builtin_bit_cast(v4u, qr[d0]);
                  g += bf_lo(qw.x) * ka.x + bf_hi(qw.x) * ka.y + bf_lo(qw.y) * ka.z + bf_hi(qw.y) * ka.w + bf_lo(qw.z) * kc.x + bf_hi(qw.z) * kc.y + bf_lo(qw.w) * kc.z + bf_hi(qw.w) * kc.w; }
              g = swap_add(g); }
          gate[n] = g; }
#pragma unroll
      for (int n = 0; n < 7; ++n) { int rank = 0;
#pragma unroll
          for (int n2 = 0; n2 < 7; ++n2) rank += (n2 < qb && (gate[n2] > gate[n] || (gate[n2] == gate[n] && n2 < n))) ? 1 : 0;
          if (n < qb && (qb <= 3 || rank < 3)) selmask |= 1u << n; } }
    asm volatile("s_waitcnt vmcnt(4)" ::: "memory"); __builtin_amdgcn_s_barrier(); asm volatile("" ::: "memory");
    const float C2 = 0.08838834764831845f * LOG2E, NEG = -__builtin_inff();
    const float c31 = tbl[127];
    float m_run = -1e30f, l_run = 0.f; f32x16 o[4] = {};
    const int vb0 = (int)(uintptr_t)(lds + RV) + v_rd_base(lane);
#define M2ACT(t_) (((t_) >> 2) < qb ? (__ballot(((selmask >> ((t_) >> 2)) & 1u) != 0u) != 0ull) : ((t_) * 64 <= qw0 + 31))
    f32x16 p0, p1;
    if (M2ACT(0)) qkt(p0, p1, lds + RK, r32, hi, qr);
    for (int t = 0; t < NT; ++t) {
        if (t + 3 < NT) M2DMA(t + 3, (t + 3) & 3);
        const int n = t >> 2, kb = t * 64, slot = t & 3;
        const bool rowsel = n < qb ? ((selmask >> n) & 1u) != 0u : true;
        const bool act = M2ACT(t), actn = (t + 1 < NT) && M2ACT(t + 1);
        f32x16 q0, q1;
        if (act) {
            const int dq = qw0 + r32 - kb - 4 * hi;
            if (qw0 - (kb + 63) < 113) {
#pragma unroll
                for (int g = 0; g < 4; ++g) {
#pragma unroll
                    for (int i = 0; i < 4; ++i) { const int r = 4 * g + i, c = i + 8 * g; const int d0_ = dq - c, d1_ = dq - c - 32;
                        const float b0 = tbl[d0_ < 0 ? 0 : (d0_ > 127 ? 127 : d0_)], b1 = tbl[d1_ < 0 ? 0 : (d1_ > 127 ? 127 : d1_)];
                        const float s0 = fmaf(p0[r], C2, b0), s1 = fmaf(p1[r], C2, b1);
                        p0[r] = (d0_ >= 0 && rowsel) ? s0 : NEG; p1[r] = (d1_ >= 0 && rowsel) ? s1 : NEG; }
                    __builtin_amdgcn_sched_barrier(0); }
            } else {
#pragma unroll
                for (int r = 0; r < 16; ++r) { p0[r] = rowsel ? fmaf(p0[r], C2, c31) : NEG; p1[r] = rowsel ? fmaf(p1[r], C2, c31) : NEG; }
            }
            float pmax = p0[0];
#pragma unroll
            for (int r = 1; r < 16; ++r) pmax = fmaxf(pmax, p0[r]);
#pragma unroll
            for (int r = 0; r < 16; ++r) pmax = fmaxf(pmax, p1[r]);
            pmax = swap_max(pmax);
            const float mn = fmaxf(m_run, pmax), alpha = __builtin_amdgcn_exp2f(m_run - mn); m_run = mn;
            bf16x8 pa0, pa1, pa2, pa3; float ps = 0.f;
#define M2TAIL() do { _Pragma("unroll") for (int r = 0; r < 16; ++r) { p0[r] = __builtin_amdgcn_exp2f(p0[r] - mn); p1[r] = __builtin_amdgcn_exp2f(p1[r] - mn); ps += p0[r] + p1[r]; } \
                ATT_PK4(p0, 0, pa0); ATT_PK4(p0, 8, pa1); ATT_PK4(p1, 0, pa2); ATT_PK4(p1, 8, pa3); } while (0)
            if (actn) { qkt(q0, q1, lds + RK + ((t + 1) & 3) * SHM_K, r32, hi, qr); M2TAIL();
}
            else M2TAIL();
#undef M2TAIL
            ps = swap_add(ps);
            l_run = l_run * alpha + ps;
            if (__any(alpha < 1.f)) {
                if (hi == 0) all[r32] = alpha;
                asm volatile("s_waitcnt lgkmcnt(0)" ::: "memory");
#pragma unroll
                for (int g = 0; g < 4; ++g) { const f32x4 av = *(const f32x4*)(all + 8 * g + 4 * hi);
#pragma unroll
                    for (int d0 = 0; d0 < 4; ++d0) { o[d0][4 * g + 0] *= av.x; o[d0][4 * g + 1] *= av.y; o[d0][4 * g + 2] *= av.z; o[d0][4 * g + 3] *= av.w; } }
            }
            pv_tile(o, vb0 + slot * SHM_V, pa0, pa1, pa2, pa3);
        } else if (actn) qkt(q0, q1, lds + RK + ((t + 1) & 3) * SHM_K, r32, hi, qr);
        p0 = q0; p1 = q1;
        if (t + 3 < NT) asm volatile("s_waitcnt vmcnt(4) lgkmcnt(0)" ::: "memory"); else asm volatile("s_waitcnt vmcnt(0) lgkmcnt(0)" ::: "memory");
        __builtin_amdgcn_s_barrier(); asm volatile("" ::: "memory");
    }
#undef M2ACT
#undef M2DMA
    __syncthreads();
    if (hi == 0) lil[r32] = 1.f / l_run;
    o_epilogue(o, lds, wave, lane, r32, hi, true, P + (rowbase + qw0) * NPROJ + L0_GB + h * HD, NPROJ, MIX + (rowbase + qw0) * DM + CONVW + h * HD, DM);
    __syncthreads();
}
__device__ __forceinline__ void moba_phase(Frame& F, const bf16* P, const float* KBAR, const float* relb, bf16* MIX, int conv_slot = -1, const float* cw = nullptr, unsigned char* wsl = nullptr) {
    PH_IDS();
    char* lds = (char*)(F.lds + RING_OFF);
    int slot = 0;
    for (int item = vcu; item < BATCH * MOBA_H * 4; item += G, ++slot) {
        if (slot == conv_slot) { __syncthreads(); ::conv_phase(F, P, MIX, cw); if (wsl) ::p_convert_late(F, wsl, 0); __syncthreads(); }
        const int pr = item & 3, bh = item >> 2, b = bh >> 4, h = bh & 15;
#pragma unroll 1
        for (int k = 0; k < 2; ++k) { const int qb_ = k ? 7 - pr : pr; if ((MOBA_QBMASK >> qb_) & 1) { if (MOBA_DMA == 2) moba_unit_dma2(lds, P, KBAR, relb, MIX, b, h, qb_, tid, lane, wave); else if (MOBA_DMA) moba_unit_dma(lds, P, KBAR, relb, MIX, b, h, qb_, tid, lane, wave); else moba_unit(lds, P, KBAR, relb, MIX, b, h, qb_, tid, lane, wave); } }
    }
    if (conv_slot >= slot) { __syncthreads(); ::conv_phase(F, P, MIX, cw); if (wsl) ::p_convert_late(F, wsl, 0); __syncthreads(); }
}

#ifndef SB_DUAL
#define SB_DUAL 3
#endif
__device__ __forceinline__ void sb_unit(char* lds, const bf16* P, bf16* MIX, int b, int h, int qb, int tid_in, int lane_in, int wave) {
    int tid = tid_in, lane = lane_in; asm volatile("" : "+v"(tid), "+v"(lane));
    const int r32 = lane & 31, hi = lane >> 5;
    const int qw0 = qb * 256 + wave * 32;
    const size_t rowbase = (size_t)b * SEQ;
    unsigned* flags = (unsigned*)(lds + OFF_FLAG);
    if (tid < 16) flags[tid] = 0u;
    bf16x8 qr[8];
    { const bf16* qp = P + (rowbase + qw0 + r32) * NPROJ + L1_Q + h * HD + hi * 8;
#pragma unroll
      for (int d0 = 0; d0 < 8; ++d0) qr[d0] = *(const GAS bf16x8*)(qp + d0 * 16); }
    const int sr = tid >> 4, sc = (tid & 15) * 8, kws = KSWZ(sr, sc * 2), vst0 = v_st(sr, sc), vst1 = v_st(32 + sr, sc);
    const bf16* Kg = P + rowbase * NPROJ + L1_K + h * HD + sc; const bf16* Vg = P + rowbase * NPROJ + L1_V + h * HD + sc;
    const int t_hi = 4 * qb + 3;
    Stage S; stage_load(S, Kg, Vg, t_hi * 64, sr);
    asm volatile("s_waitcnt vmcnt(0)" ::: "memory"); stage_write(S, lds, 0, kws, vst0, vst1);
    __syncthreads();
    const float C2 = 0.08838834764831845f * LOG2E, NEG = -__builtin_inff();
    float R = 0.f; f32x16 o[4] = {}; bool done_w = false;
    const int vb0 = (int)(uintptr_t)(lds + OFF_V) + v_rd_base(lane);
    for (int it = 0; it <= t_hi; ++it) {
        const int t = t_hi - it, kb = t * 64, bf = it & 1;
        if (t > 0) stage_load(S, Kg, Vg, (t - 1) * 64, sr);
        const bool act = !done_w && (kb < qw0 + 31);
        if (act) {
            f32x16 p0, p1, l0, l1;
            qkt(p0, p1, lds + OFF_K + bf * SHM_K, r32, hi, qr);
            const int dq = qw0 + r32 - kb - 4 * hi;
            const bool diag = kb + 63 >= qw0;
#pragma unroll
            for (int r = 0; r < 16; ++r) { const int c = (r & 3) + 8 * (r >> 2);
                { const float z = p0[r] * C2, e = __builtin_amdgcn_exp2f(-fabsf(z)), sp = fmaxf(z, 0.f) + __builtin_amdgcn_logf(1.f + e); const bool ok = !diag || (dq - c > 0);
                  l0[r] = ok ? -sp : 0.f; p0[r] = ok ? z - sp : NEG; }
                { const float z = p1[r] * C2, e = __builtin_amdgcn_exp2f(-fabsf(z)), sp = fmaxf(z, 0.f) + __builtin_amdgcn_logf(1.f + e); const bool ok = !diag || (dq - c - 32 > 0);
                  l1[r] = ok ? -sp : 0.f; p1[r] = ok ? z - sp : NEG; } }
            float T0[4], T1[4], Q0[4], Q1[4];
#pragma unroll
            for (int g = 0; g < 4; ++g) { T0[g] = (l0[4 * g] + l0[4 * g + 1]) + (l0[4 * g + 2] + l0[4 * g + 3]); T1[g] = (l1[4 * g] + l1[4 * g + 1]) + (l1[4 * g + 2] + l1[4 * g + 3]); }
#pragma unroll
            for (int g = 0; g < 4; ++g) { Q0[g] = swap_get(T0[g], hi); Q1[g] = swap_get(T1[g], hi); }
            float SO0[4], SO1[4]; float run = 0.f;
#pragma unroll
            for (int g = 3; g >= 0; --g) { SO1[g] = run; run += T1[g] + Q1[g]; }
#pragma unroll
            for (int g = 3; g >= 0; --g) { SO0[g] = run; run += T0[g] + Q0[g]; }
#pragma unroll
            for (int g = 0; g < 4; ++g) {
                const float g0 = R + SO0[g] + (hi == 0 ? Q0[g] : 0.f), g1 = R + SO1[g] + (hi == 0 ? Q1[g] : 0.f);
                const float a32 = l0[4 * g + 3] + l0[4 * g + 2], c32 = l1[4 * g + 3] + l1[4 * g + 2];
                p0[4 * g + 3] = __builtin_amdgcn_exp2f(p0[4 * g + 3] + g0); p0[4 * g + 2] = __builtin_amdgcn_exp2f(p0[4 * g + 2] + (g0 + l0[4 * g + 3]));
                p0[4 * g + 1] = __builtin_amdgcn_exp2f(p0[4 * g + 1] + (g0 + a32)); p0[4 * g] = __builtin_amdgcn_exp2f(p0[4 * g] + (g0 + (a32 + l0[4 * g + 1])));
                p1[4 * g + 3] = __builtin_amdgcn_exp2f(p1[4 * g + 3] + g1); p1[4 * g + 2] = __builtin_amdgcn_exp2f(p1[4 * g + 2] + (g1 + l1[4 * g + 3]));
                p1[4 * g + 1] = __builtin_amdgcn_exp2f(p1[4 * g + 1] + (g1 + c32)); p1[4 * g] = __builtin_amdgcn_exp2f(p1[4 * g] + (g1 + (c32 + l1[4 * g + 1])));
            }
            R += run;
            bf16x8 pa0, pa1, pa2, pa3;
            ATT_PK4(p0, 0, pa0); ATT_PK4(p0, 8, pa1); ATT_PK4(p1, 0, pa2); ATT_PK4(p1, 8, pa3);
            pv_tile(o, vb0 + bf * SHM_V, pa0, pa1, pa2, pa3);
            done_w = __all(R < -130.f);
        }
        if (lane == 0) flags[bf * 8 + wave] = done_w ? 1u : 0u;
        if (t > 0) { asm volatile("s_waitcnt vmcnt(0)" ::: "memory"); stage_write(S, lds, (it + 1) & 1, kws, vst0, vst1); }
        __syncthreads();
        unsigned alld = 1u;
#pragma unroll
        for (int w = 0; w < 8; ++w) alld &= flags[bf * 8 + w];
        if (alld) break;
    }
    o_epilogue(o, lds, wave, lane, r32, hi, false, P + (rowbase + qw0) * NPROJ + L1_G + h * HD, NPROJ, MIX + (rowbase + qw0) * DM + h * HD, DM);
    __syncthreads();
}
struct SbSeam { bf16x8 qr[8]; Stage SA, SB_; };
__device__ __forceinline__ void sb_prefetch(SbSeam& Z, const bf16* P, int b, int h, int qb, int tid, int lane, int wave) {
    const int r32 = lane & 31, hi = lane >> 5, qw0 = qb * 256 + wave * 32, sr = tid >> 4, sc = (tid & 15) * 8, t_hi = 4 * qb + 3; const size_t rowbase = (size_t)b * SEQ;
    const bf16* Kg = P + rowbase * NPROJ + L1_K + h * HD + sc; const bf16* Vg = P + rowbase * NPROJ + L1_V + h * HD + sc;
    stage_load(Z.SA, Kg, Vg, t_hi * 64, sr); stage_load(Z.SB_, Kg, Vg, (t_hi - 2) * 64, sr);
    const bf16* qp = P + (rowbase + qw0 + r32) * NPROJ + L1_Q + h * HD + hi * 8;
#pragma unroll
    for (int d0 = 0; d0 < 8; ++d0) Z.qr[d0] = *(const GAS bf16x8*)(qp + d0 * 16);
}
__device__ __forceinline__ void sb_unit2(char* lds, const bf16* P, bf16* MIX, int b, int h, int qb, int tid_in, int lane_in, int wave, SbSeam& Z, bool has_next, int nb, int nh, int nqb) {
    int tid = tid_in, lane = lane_in; asm volatile("" : "+v"(tid), "+v"(lane));
    const int r32 = lane & 31, hi = lane >> 5;
    const int qw0 = qb * 256 + wave * 32;
    const size_t rowbase = (size_t)b * SEQ;
    unsigned* flags = (unsigned*)(lds + OFF_FLAG);
    if (tid < 16) flags[tid] = 0u;
    bf16x8 (&qr)[8] = Z.qr; Stage& SA = Z.SA; Stage& SB_ = Z.SB_;
    const int sr = tid >> 4, sc = (tid & 15) * 8, kws = KSWZ(sr, sc * 2), vst0 = v_st(sr, sc), vst1 = v_st(32 + sr, sc);
    const bf16* Kg = P + rowbase * NPROJ + L1_K + h * HD + sc; const bf16* Vg = P + rowbase * NPROJ + L1_V + h * HD + sc;
    const int t_hi = 4 * qb + 3, half = wave >> 2, SETB = 65536;
    char* ldsw = lds + (half ? 0 : SETB);
    asm volatile("s_waitcnt vmcnt(0)" ::: "memory"); stage_write(SA, lds, 0, kws, vst0, vst1); stage_write(SB_, lds + SETB, 0, kws, vst0, vst1);
    __syncthreads();
    const float C2 = 0.08838834764831845f * LOG2E, NEG = -__builtin_inff();
    float R = 1.f; f32x16 o[4] = {}; bool done_w = false;
    const int vb0 = (int)(uintptr_t)(ldsw + OFF_V) + v_rd_base(lane);
#if defined(DBG_TLOOP)
    unsigned long long tl0_ = 0; if (tid == 0) tl0_ = __builtin_amdgcn_s_memrealtime();
#endif
#if defined(DBG_SEGSB)
    unsigned long long sg_[5] = {0, 0, 0, 0, 0}; unsigned long long st_ = __builtin_amdgcn_s_memtime();
#define SEGS(k) do { const unsigned long long n_ = __builtin_amdgcn_s_memtime(); sg_[k] += n_ - st_; st_ = n_; } while (0)
#else
#define SEGS(k) do {} while (0)
#endif
    for (int it = 0; it <= t_hi; ++it) {
        const int tA = t_hi - it, tB = tA - 2, t = half ? tA : tB, kb = t * 64, bf = it & 1;
        if (tA > 0) stage_load(SA, Kg, Vg, (tA - 1) * 64, sr);
        if (tB > 0) stage_load(SB_, Kg, Vg, (tB - 1) * 64, sr);
        if (t < 0) done_w = true;
        const bool act = !done_w && (kb < qw0 + 31);
        SEGS(4);
        if (act) {
            f32x16 p0, p1, l0, l1;
            qkt(p0, p1, ldsw + OFF_K + bf * SHM_K, r32, hi, qr);
            asm volatile("" : "+v"(p0), "+v"(p1)); SEGS(0);
            const int dq = qw0 + r32 - kb - 4 * hi;
            const bool diag = kb + 63 >= qw0;
#pragma unroll
            for (int r = 0; r < 16; ++r) { const int c = (r & 3) + 8 * (r >> 2);
                { const float e = __builtin_amdgcn_exp2f(fminf(p0[r] * C2, 100.f)), om = __builtin_amdgcn_rcpf(1.f + e); const bool ok = !diag || (dq - c > 0);
                  l0[r] = ok ? om : 1.f; p0[r] = ok ? e * om : 0.f; }
                { const float e = __builtin_amdgcn_exp2f(fminf(p1[r] * C2, 100.f)), om = __builtin_amdgcn_rcpf(1.f + e); const bool ok = !diag || (dq - c - 32 > 0);
                  l1[r] = ok ? om : 1.f; p1[r] = ok ? e * om : 0.f; } }
            float T0[4], T1[4], Q0[4], Q1[4];
#pragma unroll
            for (int g = 0; g < 4; ++g) { T0[g] = (l0[4 * g] * l0[4 * g + 1]) * (l0[4 * g + 2] * l0[4 * g + 3]); T1[g] = (l1[4 * g] * l1[4 * g + 1]) * (l1[4 * g + 2] * l1[4 * g + 3]); }
#pragma unroll
            for (int g = 0; g < 4; ++g) { Q0[g] = swap_get(T0[g], hi); Q1[g] = swap_get(T1[g], hi); }
            float SO0[4], SO1[4]; float run = 1.f;
#pragma unroll
            for (int g = 3; g >= 0; --g) { SO1[g] = run; run *= T1[g] * Q1[g]; }
#pragma unroll
            for (int g = 3; g >= 0; --g) { SO0[g] = run; run *= T0[g] * Q0[g]; }
#pragma unroll
            for (int g = 0; g < 4; ++g) {
                const float g0 = R * SO0[g] * (hi == 0 ? Q0[g] : 1.f), g1 = R * SO1[g] * (hi == 0 ? Q1[g] : 1.f);
                const float a3 = g0 * l0[4 * g + 3], a32 = a3 * l0[4 * g + 2], c3 = g1 * l1[4 * g + 3], c32 = c3 * l1[4 * g + 2];
                p0[4 * g + 3] *= g0; p0[4 * g + 2] *= a3; p0[4 * g + 1] *= a32; p0[4 * g] *= a32 * l0[4 * g + 1];
                p1[4 * g + 3] *= g1; p1[4 * g + 2] *= c3; p1[4 * g + 1] *= c32; p1[4 * g] *= c32 * l1[4 * g + 1];
            }
            R *= run;
            bf16x8 pa0, pa1, pa2, pa3;
            ATT_PK4(p0, 0, pa0); ATT_PK4(p0, 8, pa1); ATT_PK4(p1, 0, pa2); ATT_PK4(p1, 8, pa3);
            asm volatile("" : "+v"(pa0), "+v"(pa1), "+v"(pa2), "+v"(pa3)); SEGS(1);
            pv_tile(o, vb0 + bf * SHM_V, pa0, pa1, pa2, pa3);
            asm volatile("" : "+v"(o[0]), "+v"(o[1]), "+v"(o[2]), "+v"(o[3])); SEGS(2);
            done_w = __all(R < 1.2e-38f);
        }
        if (lane == 0) flags[bf * 8 + wave] = done_w ? 1u : 0u;
        if (tA > 0) { asm volatile("s_waitcnt vmcnt(0)" ::: "memory"); stage_write(SA, lds, (it + 1) & 1, kws, vst0, vst1); if (tB > 0) stage_write(SB_, lds + SETB, (it + 1) & 1, kws, vst0, vst1); }
        __syncthreads();
        SEGS(3);
        unsigned alld = 1u;
#pragma unroll
        for (int w = 0; w < 8; ++w) alld &= flags[bf * 8 + w];
        if (alld) break;
    }
#if defined(DBG_SEGSB)
    if (blockIdx.x == DBG_SEGBLK && tid == DBG_SEGTID) { volatile unsigned* M_ = (volatile unsigned*)(lds + MISC_OFF); const unsigned long long a_ = (((unsigned long long)M_[17] << 32) | M_[16]) + sg_[DBG_SEGSB]; M_[16] = (unsigned)a_; M_[17] = (unsigned)(a_ >> 32); }
#endif
#if defined(DBG_TLOOP)
    if (tid == 0) { volatile unsigned* M_ = (volatile unsigned*)(lds + MISC_OFF); const unsigned long long d_ = __builtin_amdgcn_s_memrealtime() - tl0_; const unsigned long long a_ = (((unsigned long long)M_[17] << 32) | M_[16]) + d_; M_[16] = (unsigned)a_; M_[17] = (unsigned)(a_ >> 32); }
#endif
    if (has_next) sb_prefetch(Z, P, nb, nh, nqb, tid, lane, wave);
    o_epilogue(o, lds, wave, lane, r32, hi, false, P + (rowbase + qw0) * NPROJ + L1_G + h * HD, NPROJ, MIX + (rowbase + qw0) * DM + h * HD, DM);
    __syncthreads();
}


__device__ __forceinline__ void sb_tile_load(bf16x8 (&kr)[8], bf16x8 (&vr)[8], const bf16* Kg, const bf16* Vg, int k0, int lane) {
    const int loff = (lane >> 4) * NPROJ + (lane & 15) * 8;
#pragma unroll
    for (int j = 0; j < 8; ++j) { const bf16* kp = Kg + (size_t)(k0 + 4 * j) * NPROJ; const bf16* vp = Vg + (size_t)(k0 + 4 * j) * NPROJ;
        kr[j] = *(const GAS bf16x8*)(kp + loff); vr[j] = *(const GAS bf16x8*)(vp + loff); }
}
__device__ __forceinline__ void sb_unit3(char* lds, const bf16* P, bf16* MIX, int b, int h, int qb, int lane_in, int wave) {
    int lane = lane_in; asm volatile("" : "+v"(lane));
    const int r32 = lane & 31, hi = lane >> 5;
    const int qw0 = qb * 256 + wave * 32;
    const size_t rowbase = (size_t)b * SEQ;
    char* wl = lds + wave * 16384;
    const bf16* Kg = P + rowbase * NPROJ + L1_K + h * HD; const bf16* Vg = P + rowbase * NPROJ + L1_V + h * HD;
    const int tw = qw0 >> 5;
    bf16x8 kr[8], vr[8]; sb_tile_load(kr, vr, Kg, Vg, tw * 32, lane);
    bf16x8 qr[8];
    { const bf16* qp = P + (rowbase + qw0 + r32) * NPROJ + L1_Q + h * HD + hi * 8;
#pragma unroll
      for (int d0 = 0; d0 < 8; ++d0) qr[d0] = *(const GAS bf16x8*)(qp + d0 * 16); }
    const float C2 = 0.08838834764831845f * LOG2E;
    float R = 1.f; f32x16 o[4] = {};
    const int vb = (int)(uintptr_t)(wl + 8192) + v_rd_base(lane);
    for (int t = tw; t >= 0; --t) {
#pragma unroll
        for (int j = 0; j < 8; ++j) { const int pc = j * 64 + lane, row = pc >> 4, sc = (pc & 15) * 8;
            *(bf16x8*)(wl + KSWZ(row, sc * 2)) = kr[j]; *(bf16x8*)(wl + 8192 + v_st(row, sc)) = vr[j]; }
        if (t > 0) sb_tile_load(kr, vr, Kg, Vg, (t - 1) * 32, lane);
        asm volatile("s_waitcnt lgkmcnt(0)" ::: "memory");
        f32x16 p0 = f32x16{}, l0;
        { const char* kb4[4];
#pragma unroll
          for (int dd = 0; dd < 4; ++dd) kb4[dd] = wl + KSWZ(r32, (dd * 16 + hi * 8) * 2);
#pragma unroll
          for (int d0 = 0; d0 < 8; ++d0) { const bf16x8 b0 = *reinterpret_cast<const bf16x8*>(kb4[d0 & 3] + (d0 >> 2) * 128); p0 = __builtin_amdgcn_mfma_f32_32x32x16_bf16(b0, qr[d0], p0, 0, 0, 0); } }
        const int dq = qw0 + r32 - t * 32 - 4 * hi; const bool diag = t == tw;
#pragma unroll
        for (int r = 0; r < 16; ++r) { const int c = (r & 3) + 8 * (r >> 2);
            const float e = __builtin_amdgcn_exp2f(fminf(p0[r] * C2, 100.f)), om = __builtin_amdgcn_rcpf(1.f + e); const bool ok = !diag || (dq - c > 0);
            l0[r] = ok ? om : 1.f; p0[r] = ok ? e * om : 0.f; }
        float T0[4], Q0[4];
#pragma unroll
        for (int g = 0; g < 4; ++g) T0[g] = (l0[4 * g] * l0[4 * g + 1]) * (l0[4 * g + 2] * l0[4 * g + 3]);
#pragma unroll
        for (int g = 0; g < 4; ++g) Q0[g] = swap_get(T0[g], hi);
        float SO0[4]; float run = 1.f;
#pragma unroll
        for (int g = 3; g >= 0; --g) { SO0[g] = run; run *= T0[g] * Q0[g]; }
#pragma unroll
        for (int g = 0; g < 4; ++g) { const float g0 = R * SO0[g] * (hi == 0 ? Q0[g] : 1.f), a3 = g0 * l0[4 * g + 3], a32 = a3 * l0[4 * g + 2];
            p0[4 * g + 3] *= g0; p0[4 * g + 2] *= a3; p0[4 * g + 1] *= a32; p0[4 * g] *= a32 * l0[4 * g + 1]; }
        R *= run;
        bf16x8 pa0, pa1;
        ATT_PK4(p0, 0, pa0); ATT_PK4(p0, 8, pa1);
#define SB3_TR(dst, off) asm volatile("ds_read_b64_tr_b16 %0, %1 offset:%2" : "=&v"(dst) : "v"(vb), "i"(off) : "memory")
#define SB3_PV(d0) do { s16x4 x0, y0, x1, y1; SB3_TR(x0, d0 * 512); SB3_TR(y0, d0 * 512 + 2048); SB3_TR(x1, d0 * 512 + 4096); SB3_TR(y1, d0 * 512 + 6144); \
        asm volatile("s_waitcnt lgkmcnt(0)" ::: "memory"); __builtin_amdgcn_sched_barrier(0); \
        o[d0] = __builtin_amdgcn_mfma_f32_32x32x16_bf16(pa0, (bf16x8){x0[0], x0[1], x0[2], x0[3], y0[0], y0[1], y0[2], y0[3]}, o[d0], 0, 0, 0); \
        o[d0] = __builtin_amdgcn_mfma_f32_32x32x16_bf16(pa1, (bf16x8){x1[0], x1[1], x1[2], x1[3], y1[0], y1[1], y1[2], y1[3]}, o[d0], 0, 0, 0); } while (0)
        SB3_PV(0); SB3_PV(1); SB3_PV(2); SB3_PV(3);
#undef SB3_PV
#undef SB3_TR
        if (__all(R < 1.2e-38f)) break;
    }
    o_epilogue(o, lds, wave, lane, r32, hi, false, P + (rowbase + qw0) * NPROJ + L1_G + h * HD, NPROJ, MIX + (rowbase + qw0) * DM + h * HD, DM);
    asm volatile("s_waitcnt lgkmcnt(0)" ::: "memory");
}

struct Sb4Seam { bf16x8 qr[8]; bf16x8 kr[4], vr[4]; };
__device__ __forceinline__ void sb4_prefetch(Sb4Seam& Z, const bf16* P, int b, int h, int qb, int tid, int lane, int wave) {
    const int r32 = lane & 31, hi = lane >> 5, g4 = wave >> 1, ltid = tid & 127, qw0 = qb * 256 + wave * 32, tstart = 8 * qb + 2 * g4 + 1; const size_t rowbase = (size_t)b * SEQ;
    const bf16* Kg = P + rowbase * NPROJ + L1_K + h * HD; const bf16* Vg = P + rowbase * NPROJ + L1_V + h * HD; const int loff = (ltid >> 4) * NPROJ + (ltid & 15) * 8;
#pragma unroll
    for (int j = 0; j < 4; ++j) { const bf16* kp = Kg + (size_t)(tstart * 32 + 8 * j) * NPROJ; const bf16* vp = Vg + (size_t)(tstart * 32 + 8 * j) * NPROJ; Z.kr[j] = *(const GAS bf16x8*)(kp + loff); Z.vr[j] = *(const GAS bf16x8*)(vp + loff); }
    const bf16* qp = P + (rowbase + qw0 + r32) * NPROJ + L1_Q + h * HD + hi * 8;
#pragma unroll
    for (int d0 = 0; d0 < 8; ++d0) Z.qr[d0] = *(const GAS bf16x8*)(qp + d0 * 16);
}
template <bool NOLOOP = false>
__device__ __forceinline__ void sb_unit4(char* lds, const bf16* P, bf16* MIX, int b, int h, int qb, int tid_in, int lane_in, int wave, Sb4Seam& Z, bool has_next, int nb, int nh, int nqb) {
    int tid = tid_in, lane = lane_in; asm volatile("" : "+v"(tid), "+v"(lane));
    const int r32 = lane & 31, hi = lane >> 5, g4 = wave >> 1, ltid = tid & 127;
    const int qw0 = qb * 256 + wave * 32;
    const size_t rowbase = (size_t)b * SEQ;
    unsigned* flags = (unsigned*)(lds + OFF_FLAG);
    if (tid < 16) flags[tid] = 0u;
    char* gl = lds + g4 * 32768;
    const bf16* Kg = P + rowbase * NPROJ + L1_K + h * HD; const bf16* Vg = P + rowbase * NPROJ + L1_V + h * HD;
    const int loff = (ltid >> 4) * NPROJ + (ltid & 15) * 8;
    int wk[4], wv[4];
#pragma unroll
    for (int j = 0; j < 4; ++j) { const int row = 8 * j + (ltid >> 4), sc = (ltid & 15) * 8; wk[j] = KSWZ(row, sc * 2); wv[j] = 8192 + v_st(row, sc); }
    const int tstart = 8 * qb + 2 * g4 + 1;
    bf16x8 (&kr)[4] = Z.kr; bf16x8 (&vr)[4] = Z.vr; bf16x8 (&qr)[8] = Z.qr;
#define SB4_LOAD(tt) do { _Pragma("unroll") for (int j = 0; j < 4; ++j) { const bf16* kp = Kg + (size_t)((tt) * 32 + 8 * j) * NPROJ; const bf16* vp = Vg + (size_t)((tt) * 32 + 8 * j) * NPROJ; \
        kr[j] = *(const GAS bf16x8*)(kp + loff); vr[j] = *(const GAS bf16x8*)(vp + loff); } } while (0)
#define SB4_WRITE(bf) do { _Pragma("unroll") for (int j = 0; j < 4; ++j) { *(bf16x8*)(gl + (bf) * 16384 + wk[j]) = kr[j]; *(bf16x8*)(gl + (bf) * 16384 + wv[j]) = vr[j]; } } while (0)
    SB4_WRITE(0);
    __syncthreads();
    const float C2 = 0.08838834764831845f * LOG2E;
    float R = 1.f; f32x16 o[4] = {}; bool done_w = false;
    for (int it = 0; it <= (NOLOOP ? -1 : 8 * qb + 8); ++it) {
        const int t = tstart - it, bf = it & 1;
        if (t > 0) SB4_LOAD(t - 1);
        if (t < 0) done_w = true;
        const int kb = t * 32;
        const bool act = !done_w && (kb < qw0 + 31);
        if (act) {
            char* kt = gl + bf * 16384;
            f32x16 p0 = f32x16{}, l0;
            { const char* kb4[4];
#pragma unroll
              for (int dd = 0; dd < 4; ++dd) kb4[dd] = kt + KSWZ(r32, (dd * 16 + hi * 8) * 2);
#pragma unroll
              for (int d0 = 0; d0 < 8; ++d0) { const bf16x8 b0 = *reinterpret_cast<const bf16x8*>(kb4[d0 & 3] + (d0 >> 2) * 128); p0 = __builtin_amdgcn_mfma_f32_32x32x16_bf16(b0, qr[d0], p0, 0, 0, 0); } }
            const int dq = qw0 + r32 - kb - 4 * hi; const bool diag = kb + 31 >= qw0;
#pragma unroll
            for (int r = 0; r < 16; ++r) { const int c = (r & 3) + 8 * (r >> 2);
                const float e = __builtin_amdgcn_exp2f(fminf(p0[r] * C2, 100.f)), om = __builtin_amdgcn_rcpf(1.f + e); const bool ok = !diag || (dq - c > 0);
                l0[r] = ok ? om : 1.f; p0[r] = ok ? e * om : 0.f; }
            float T0[4], Q0[4];
#pragma unroll
            for (int g = 0; g < 4; ++g) T0[g] = (l0[4 * g] * l0[4 * g + 1]) * (l0[4 * g + 2] * l0[4 * g + 3]);
#pragma unroll
            for (int g = 0; g < 4; ++g) Q0[g] = swap_get(T0[g], hi);
            float SO0[4]; float run = 1.f;
#pragma unroll
            for (int g = 3; g >= 0; --g) { SO0[g] = run; run *= T0[g] * Q0[g]; }
#pragma unroll
            for (int g = 0; g < 4; ++g) { const float g0 = R * SO0[g] * (hi == 0 ? Q0[g] : 1.f), a3 = g0 * l0[4 * g + 3], a32 = a3 * l0[4 * g + 2];
                p0[4 * g + 3] *= g0; p0[4 * g + 2] *= a3; p0[4 * g + 1] *= a32; p0[4 * g] *= a32 * l0[4 * g + 1]; }
            R *= run;
            bf16x8 pa0, pa1;
            ATT_PK4(p0, 0, pa0); ATT_PK4(p0, 8, pa1);
            const int vb = (int)(uintptr_t)(kt + 8192) + v_rd_base(lane);
#define SB4_TR(dst, off) asm volatile("ds_read_b64_tr_b16 %0, %1 offset:%2" : "=&v"(dst) : "v"(vb), "i"(off) : "memory")
#define SB4_PV(d0) do { s16x4 x0, y0, x1, y1; SB4_TR(x0, d0 * 512); SB4_TR(y0, d0 * 512 + 2048); SB4_TR(x1, d0 * 512 + 4096); SB4_TR(y1, d0 * 512 + 6144); \
            asm volatile("s_waitcnt lgkmcnt(0)" ::: "memory"); __builtin_amdgcn_sched_barrier(0); \
            o[d0] = __builtin_amdgcn_mfma_f32_32x32x16_bf16(pa0, (bf16x8){x0[0], x0[1], x0[2], x0[3], y0[0], y0[1], y0[2], y0[3]}, o[d0], 0, 0, 0); \
            o[d0] = __builtin_amdgcn_mfma_f32_32x32x16_bf16(pa1, (bf16x8){x1[0], x1[1], x1[2], x1[3], y1[0], y1[1], y1[2], y1[3]}, o[d0], 0, 0, 0); } while (0)
            SB4_PV(0); SB4_PV(1); SB4_PV(2); SB4_PV(3);
#undef SB4_PV
#undef SB4_TR
            done_w = __all(R < 1.2e-38f);
        }
        if (lane == 0) flags[bf * 8 + wave] = done_w ? 1u : 0u;
        if (t > 0) SB4_WRITE((it + 1) & 1);
        __syncthreads();
        unsigned alld = 1u;
#pragma unroll
        for (int w = 0; w < 8; ++w) alld &= flags[bf * 8 + w];
        if (alld) break;
    }
#undef SB4_LOAD
#undef SB4_WRITE
    if (has_next) sb4_prefetch(Z, P, nb, nh, nqb, tid, lane, wave);
    o_epilogue(o, lds, wave, lane, r32, hi, false, P + (rowbase + qw0) * NPROJ + L1_G + h * HD, NPROJ, MIX + (rowbase + qw0) * DM + h * HD, DM);
    __syncthreads();
}

__device__ __forceinline__ void sb_unit5(char* lds, const bf16* P, bf16* MIX, int b, int h, int qb, int tid_in, int lane_in, int wave, bf16x8 (&qr)[8], bool has_next, int nb, int nh, int nqb) {
    int tid = tid_in, lane = lane_in; asm volatile("" : "+v"(tid), "+v"(lane));
    const int r32 = lane & 31, hi = lane >> 5, hA = wave >> 2, wl = wave & 3;
    const int qw0 = qb * 256 + wave * 32;
    const size_t rowbase = (size_t)b * SEQ;
    unsigned* flags = (unsigned*)(lds + OFF_FLAG);
    if (tid < 16) flags[tid] = 0u;
    char* sl = lds + hA * 65536;
    const bf16* Kg = P + rowbase * NPROJ + L1_K + h * HD; const bf16* Vg = P + rowbase * NPROJ + L1_V + h * HD;
    unsigned gofK[2], gofV[2];
#pragma unroll
    for (int i = 0; i < 2; ++i) { const int q = 2 * wl + i;
        { const int row = 4 * q + (lane >> 4), colB = ((lane & 15) * 16) ^ ((row & 7) << 4); gofK[i] = (unsigned)(row * NPROJ + (colB >> 1)); }
        { const int sub = 2 * q + (lane >> 5), kk = (sub >> 2) * 8 + ((lane & 31) >> 2), c = (sub & 3) * 32 + (lane & 3) * 8, k = (kk & ~0xC) | ((kk & 4) << 1) | ((kk & 8) >> 1); gofV[i] = (unsigned)(k * NPROJ + c); } }
#define SB5_DMA(tt, slot) do { _Pragma("unroll") for (int i_ = 0; i_ < 2; ++i_) { \
        __builtin_amdgcn_global_load_lds((const unsigned*)(Kg + (size_t)(tt) * 32 * NPROJ + gofK[i_]), (__attribute__((address_space(3))) unsigned*)(sl + (slot) * 16384 + (2 * wl + i_) * 1024), 16, 0, 0); \
        __builtin_amdgcn_global_load_lds((const unsigned*)(Vg + (size_t)(tt) * 32 * NPROJ + gofV[i_]), (__attribute__((address_space(3))) unsigned*)(sl + (slot) * 16384 + 8192 + (2 * wl + i_) * 1024), 16, 0, 0); } } while (0)
    const int tstart = 8 * qb + 4 * hA + 3;
    __syncthreads();
    SB5_DMA(tstart, 0); SB5_DMA(tstart - 1, 1); SB5_DMA(tstart - 2, 2);
    asm volatile("s_waitcnt vmcnt(8)" ::: "memory"); __builtin_amdgcn_s_barrier(); asm volatile("" ::: "memory");
    const float C2 = 0.08838834764831845f * LOG2E;
    float R = 1.f; f32x16 o[4] = {}; bool done_w = false;
    for (int it = 0; it <= 8 * qb + 8; ++it) {
        const int t = tstart - it, bf = it & 1, slot = it & 3;
        if (t - 3 >= 0) SB5_DMA(t - 3, (it + 3) & 3);
        if (t < 0) done_w = true;
        const int kb = t * 32;
        const bool act = !done_w && (kb < qw0 + 31);
        if (act) {
            char* kt = sl + slot * 16384;
            f32x16 p0 = f32x16{}, l0;
            { const char* kb4[4];
#pragma unroll
              for (int dd = 0; dd < 4; ++dd) kb4[dd] = kt + KSWZ(r32, (dd * 16 + hi * 8) * 2);
#pragma unroll
              for (int d0 = 0; d0 < 8; ++d0) { const bf16x8 b0 = *reinterpret_cast<const bf16x8*>(kb4[d0 & 3] + (d0 >> 2) * 128); p0 = __builtin_amdgcn_mfma_f32_32x32x16_bf16(b0, qr[d0], p0, 0, 0, 0); } }
            const int dq = qw0 + r32 - kb - 4 * hi; const bool diag = kb + 31 >= qw0;
#pragma unroll
            for (int r = 0; r < 16; ++r) { const int c = (r & 3) + 8 * (r >> 2);
                const float e = __builtin_amdgcn_exp2f(fminf(p0[r] * C2, 100.f)), om = __builtin_amdgcn_rcpf(1.f + e); const bool ok = !diag || (dq - c > 0);
                l0[r] = ok ? om : 1.f; p0[r] = ok ? e * om : 0.f; }
            float T0[4], Q0[4];
#pragma unroll
            for (int g = 0; g < 4; ++g) T0[g] = (l0[4 * g] * l0[4 * g + 1]) * (l0[4 * g + 2] * l0[4 * g + 3]);
#pragma unroll
            for (int g = 0; g < 4; ++g) Q0[g] = swap_get(T0[g], hi);
            float SO0[4]; float run = 1.f;
#pragma unroll
            for (int g = 3; g >= 0; --g) { SO0[g] = run; run *= T0[g] * Q0[g]; }
#pragma unroll
            for (int g = 0; g < 4; ++g) { const float g0 = R * SO0[g] * (hi == 0 ? Q0[g] : 1.f), a3 = g0 * l0[4 * g + 3], a32 = a3 * l0[4 * g + 2];
                p0[4 * g + 3] *= g0; p0[4 * g + 2] *= a3; p0[4 * g + 1] *= a32; p0[4 * g] *= a32 * l0[4 * g + 1]; }
            R *= run;
            bf16x8 pa0, pa1;
            ATT_PK4(p0, 0, pa0); ATT_PK4(p0, 8, pa1);
            const int vb = (int)(uintptr_t)(kt + 8192) + v_rd_base(lane);
#define SB5_TR(dst, off) asm volatile("ds_read_b64_tr_b16 %0, %1 offset:%2" : "=&v"(dst) : "v"(vb), "i"(off) : "memory")
#define SB5_PV(d0) do { s16x4 x0, y0, x1, y1; SB5_TR(x0, d0 * 512); SB5_TR(y0, d0 * 512 + 2048); SB5_TR(x1, d0 * 512 + 4096); SB5_TR(y1, d0 * 512 + 6144); \
            asm volatile("s_waitcnt lgkmcnt(0)" ::: "memory"); __builtin_amdgcn_sched_barrier(0); \
            o[d0] = __builtin_amdgcn_mfma_f32_32x32x16_bf16(pa0, (bf16x8){x0[0], x0[1], x0[2], x0[3], y0[0], y0[1], y0[2], y0[3]}, o[d0], 0, 0, 0); \
            o[d0] = __builtin_amdgcn_mfma_f32_32x32x16_bf16(pa1, (bf16x8){x1[0], x1[1], x1[2], x1[3], y1[0], y1[1], y1[2], y1[3]}, o[d0], 0, 0, 0); } while (0)
            SB5_PV(0); SB5_PV(1); SB5_PV(2); SB5_PV(3);
#undef SB5_PV
#undef SB5_TR
            done_w = __all(R < 1.2e-38f);
        }
        if (lane == 0) flags[bf * 8 + wave] = done_w ? 1u : 0u;
        if (t - 3 >= 0) asm volatile("s_waitcnt vmcnt(8) lgkmcnt(0)" ::: "memory"); else if (t - 2 >= 0) asm volatile("s_waitcnt vmcnt(4) lgkmcnt(0)" ::: "memory"); else asm volatile("s_waitcnt vmcnt(0) lgkmcnt(0)" ::: "memory");
        __builtin_amdgcn_s_barrier(); asm volatile("" ::: "memory");
        unsigned alld = 1u;
#pragma unroll
        for (int w = 0; w < 8; ++w) alld &= flags[bf * 8 + w];
        if (alld) break;
    }
#undef SB5_DMA
    asm volatile("s_waitcnt vmcnt(0)" ::: "memory"); __syncthreads();
    if (has_next) { const int qn0 = nqb * 256 + wave * 32; const bf16* qp = P + ((size_t)nb * SEQ + qn0 + r32) * NPROJ + L1_Q + nh * HD + hi * 8;
#pragma unroll
        for (int d0 = 0; d0 < 8; ++d0) qr[d0] = *(const GAS bf16x8*)(qp + d0 * 16); }
    o_epilogue(o, lds, wave, lane, r32, hi, false, P + (rowbase + qw0) * NPROJ + L1_G + h * HD, NPROJ, MIX + (rowbase + qw0) * DM + h * HD, DM);
}
#if defined(DBG_SBDUMMY)
__device__ __forceinline__ void sb_dummy_phase(Frame& F, const bf16* P) {
    PH_IDS();
    char* lds = (char*)(F.lds + RING_OFF);
    constexpr int NBH = BATCH * SB_H, NU = NBH * 8, SETB = 65536;
    const int sr = tid >> 4, sc = (tid & 15) * 8, kws = KSWZ(sr, sc * 2), vst0 = v_st(sr, sc), vst1 = v_st(32 + sr, sc);
    for (int u = vcu; u < NU; u += G) { const int bh = u % NBH, qb = u / NBH, b = bh >> 5, h = bh & 31, t_hi = 4 * qb + 3; const size_t rowbase = (size_t)b * SEQ;
        const bf16* Kg = P + rowbase * NPROJ + L1_K + h * HD + sc; const bf16* Vg = P + rowbase * NPROJ + L1_V + h * HD + sc;
        Stage SA, SB_; stage_load(SA, Kg, Vg, t_hi * 64, sr); stage_load(SB_, Kg, Vg, (t_hi - 2) * 64, sr);
        asm volatile("s_waitcnt vmcnt(0)" ::: "memory"); stage_write(SA, lds, 0, kws, vst0, vst1); stage_write(SB_, lds + SETB, 0, kws, vst0, vst1);
        __syncthreads();
        for (int it = 0; it < 6 && it <= t_hi; ++it) { const int tA = t_hi - it, tB = tA - 2;
            if (tA > 0) stage_load(SA, Kg, Vg, (tA - 1) * 64, sr);
            if (tB > 0) stage_load(SB_, Kg, Vg, (tB - 1) * 64, sr);
#if DBG_SBDUMMY == 2
            { const unsigned long long t0_ = __builtin_amdgcn_s_memtime(); while (__builtin_amdgcn_s_memtime() - t0_ < 4000ull) __builtin_amdgcn_s_sleep(4); }
#endif
            if (tA > 0) { asm volatile("s_waitcnt vmcnt(0)" ::: "memory"); stage_write(SA, lds, (it + 1) & 1, kws, vst0, vst1); if (tB > 0) stage_write(SB_, lds + SETB, (it + 1) & 1, kws, vst0, vst1); }
            __syncthreads(); }
        __syncthreads(); }
}
#endif

#if defined(DBG_SBDUMMY4)
__device__ __forceinline__ void sb_dummy4_phase(Frame& F, const bf16* P, bf16* SCR) {
    PH_IDS();
    char* lds = (char*)(F.lds + RING_OFF);
    constexpr int NBH = BATCH * SB_H, NU = NBH * 8; for (int u = vcu; u < NU; u += G) { const int bh = u % NBH, qb = u / NBH; { Sb4Seam Z; sb4_prefetch(Z, P, bh >> 5, bh & 31, qb, tid, lane, wave); sb_unit4<true>(lds, P, SCR, bh >> 5, bh & 31, qb, tid, lane, wave, Z, false, 0, 0, 0); } }
}
#endif
__device__ __forceinline__ void sb_phase(Frame& F, const bf16* P, bf16* MIX) {
    PH_IDS();
    char* lds = (char*)(F.lds + RING_OFF);
    if (SB_DUAL == 4) { constexpr int NBH = BATCH * SB_H, NU = NBH * 8; bf16x8 qr[8];
        if (vcu < NU) { const int bh = vcu % NBH, qb = vcu / NBH; const bf16* qp = P + ((size_t)(bh >> 5) * SEQ + qb * 256 + wave * 32 + (lane & 31)) * NPROJ + L1_Q + (bh & 31) * HD + (lane >> 5) * 8;
#pragma unroll
            for (int d0 = 0; d0 < 8; ++d0) qr[d0] = *(const GAS bf16x8*)(qp + d0 * 16); }
        for (int u = vcu; u < NU; u += G) { const int bh = u % NBH, qb = u / NBH, un = u + G; const bool hn = un < NU; sb_unit5(lds, P, MIX, bh >> 5, bh & 31, qb, tid, lane, wave, qr, hn, (un % NBH) >> 5, (un % NBH) & 31, un / NBH); }
        __syncthreads(); }
    else if (SB_DUAL == 3) { constexpr int NBH = BATCH * SB_H, NU = NBH * 8; Sb4Seam Z; if (vcu < NU) sb4_prefetch(Z, P, (vcu % NBH) >> 5, (vcu % NBH) & 31, vcu / NBH, tid, lane, wave);
        for (int u = vcu; u < NU; u += G) { const int bh = u % NBH, qb = u / NBH, un = u + G; const bool hn = un < NU; sb_unit4(lds, P, MIX, bh >> 5, bh & 31, qb, tid, lane, wave, Z, hn, (un % NBH) >> 5, (un % NBH) & 31, un / NBH); } }
    else if (SB_DUAL == 2) { constexpr int NBH = BATCH * SB_H, NU = NBH * 8; for (int u = vcu; u < NU; u += G) { const int bh = u % NBH, qb = u / NBH; sb_unit3(lds, P, MIX, bh >> 5, bh & 31, qb, lane, wave); } }
    else if (SB_DUAL) { SbSeam Z; constexpr int NBH = BATCH * SB_H, NU = NBH * 8; if (vcu < NU) sb_prefetch(Z, P, (vcu % NBH) >> 5, (vcu % NBH) & 31, vcu / NBH, tid, lane, wave);
        for (int u = vcu; u < NU; u += G) { const int bh = u % NBH, qb = u / NBH, un = u + G; const bool hn = un < NU;
            sb_unit2(lds, P, MIX, bh >> 5, bh & 31, qb, tid, lane, wave, Z, hn, (un % NBH) >> 5, (un % NBH) & 31, un / NBH); } }
    else for (int u = vcu; u < BATCH * SB_H * 8; u += G) { const int qb = u & 7, bh = u >> 3; sb_unit(lds, P, MIX, bh >> 5, bh & 31, qb, tid, lane, wave); }
}

#define XKSWZ(row, colB) ((row) * 512 + ((colB) ^ (((row) & 7) << 4)))
__device__ __forceinline__ int xv_st(int k, int c) { const int kk = (k & ~0xC) | ((k & 4) << 1) | ((k & 8) >> 1); return ((kk >> 3) * 8 + (c >> 5)) * 512 + ((kk & 7) * 32 + (c & 31)) * 2; }
__device__ __forceinline__ void xattn_unit(char* lds, const bf16* QG, const bf16* KVX, bf16* XOIN, int b, int xh, int qb, int tid_in, int lane_in, int wave) {
    int tid = tid_in, lane = lane_in; asm volatile("" : "+v"(tid), "+v"(lane));
    const int r32 = lane & 31, hi = lane >> 5;
    const size_t m0 = (size_t)b * SEQ + qb * 256 + wave * 32;
    float* lil = (float*)(lds + OFF_LI) + wave * 32;
    bf16x8 qf[16];
    { const bf16* qp = QG + (m0 + r32) * XQW + xh * XHD + hi * 8;
#pragma unroll
      for (int d = 0; d < 16; ++d) qf[d] = *(const GAS bf16x8*)(qp + d * 16); }
    { const bf16* Kg = KVX + (size_t)(b * NMEM) * KVLD + xh * XHD;
#pragma unroll
      for (int hb = 0; hb < 2; ++hb) { bf16x8 kv_[8];
#pragma unroll
          for (int i = 0; i < 8; ++i) { const int id = (hb * 8 + i) * 512 + tid, row = id >> 5, ch = id & 31; kv_[i] = *(const GAS bf16x8*)(Kg + (size_t)row * KVLD + ch * 8); }
#pragma unroll
          for (int i = 0; i < 8; ++i) { const int id = (hb * 8 + i) * 512 + tid, row = id >> 5, ch = id & 31; *(bf16x8*)(lds + XKSWZ(row, ch * 16)) = kv_[i]; } } }
    __syncthreads();
    f32x16 s[8];
#pragma unroll
    for (int kt = 0; kt < 8; ++kt) s[kt] = f32x16{};
#pragma unroll
    for (int d0 = 0; d0 < 16; ++d0) {
#pragma unroll
        for (int kt = 0; kt < 8; ++kt) { const bf16x8 kf = *(const bf16x8*)(lds + XKSWZ(32 * kt + r32, (d0 * 16 + hi * 8) * 2)); s[kt] = __builtin_amdgcn_mfma_f32_32x32x16_bf16(kf, qf[d0], s[kt], 0, 0, 0); } }
    const bf16* Vg = KVX + (size_t)(b * NMEM) * KVLD + XW + xh * XHD; int tid2 = tid; asm volatile("" : "+v"(tid2));
    bf16x8 vv0[8];
#pragma unroll
    for (int i = 0; i < 8; ++i) { const int id = i * 512 + tid2, row = id >> 5, ch = id & 31; vv0[i] = *(const GAS bf16x8*)(Vg + (size_t)row * KVLD + ch * 8); }
    float mx = s[0][0];
#pragma unroll
    for (int kt = 0; kt < 8; ++kt)
#pragma unroll
        for (int r = 0; r < 16; ++r) mx = fmaxf(mx, s[kt][r]);
    mx = swap_max(mx);
    const float CX = 0.0625f * LOG2E; float ps = 0.f;
#pragma unroll
    for (int kt = 0; kt < 8; ++kt)
#pragma unroll
        for (int r = 0; r < 16; ++r) { s[kt][r] = __builtin_amdgcn_exp2f((s[kt][r] - mx) * CX); ps += s[kt][r]; }
    ps = swap_add(ps);
    bf16x8 pa[16];
#pragma unroll
    for (int kt = 0; kt < 8; ++kt) { ATT_PK4(s[kt], 0, pa[2 * kt]); ATT_PK4(s[kt], 8, pa[2 * kt + 1]); }
    __syncthreads();
    { int tid3 = tid; asm volatile("" : "+v"(tid3));
      bf16x8 vv_[8];
#pragma unroll
      for (int i = 0; i < 8; ++i) { const int id = (8 + i) * 512 + tid3, row = id >> 5, ch = id & 31; vv_[i] = *(const GAS bf16x8*)(Vg + (size_t)row * KVLD + ch * 8); }
#pragma unroll
      for (int i = 0; i < 8; ++i) { const int id = i * 512 + tid3, row = id >> 5, ch = id & 31; *(bf16x8*)(lds + xv_st(row, ch * 8)) = vv0[i]; }
#pragma unroll
      for (int i = 0; i < 8; ++i) { const int id = (8 + i) * 512 + tid3, row = id >> 5, ch = id & 31; *(bf16x8*)(lds + xv_st(row, ch * 8)) = vv_[i]; } }
    __syncthreads();
    f32x16 o[8];
#pragma unroll
    for (int d0 = 0; d0 < 8; ++d0) o[d0] = f32x16{};
    const int vb0 = (int)(uintptr_t)lds + v_rd_base(lane);
    s16x4 lo_[2], hi_[2];
#define XA_VRD(it_, buf_) do { asm volatile("ds_read_b64_tr_b16 %0, %1 offset:%2" : "=&v"(lo_[buf_]) : "v"(vb0 + ((it_) >> 3) * 8192), "i"(((it_) & 7) * 512) : "memory"); \
        asm volatile("ds_read_b64_tr_b16 %0, %1 offset:%2" : "=&v"(hi_[buf_]) : "v"(vb0 + ((it_) >> 3) * 8192), "i"(((it_) & 7) * 512 + 4096) : "memory"); } while (0)
    XA_VRD(0, 0);
#pragma unroll
    for (int it = 0; it < 128; ++it) { const int ks = it >> 3, d0 = it & 7, cb = it & 1;
        if (it + 1 < 128) { XA_VRD(it + 1, cb ^ 1); asm volatile("s_waitcnt lgkmcnt(2)" ::: "memory"); } else asm volatile("s_waitcnt lgkmcnt(0)" ::: "memory");
        __builtin_amdgcn_sched_barrier(0);
        o[d0] = __builtin_amdgcn_mfma_f32_32x32x16_bf16(pa[ks], (bf16x8){lo_[cb][0], lo_[cb][1], lo_[cb][2], lo_[cb][3], hi_[cb][0], hi_[cb][1], hi_[cb][2], hi_[cb][3]}, o[d0], 0, 0, 0);
        __builtin_amdgcn_sched_barrier(0); }
#undef XA_VRD
    __syncthreads();
    if (hi == 0) lil[r32] = 1.f / ps;
    if (FP8_XO) {
        unsigned char* o8 = (unsigned char*)XOIN + m0 * XW + xh * XHD;
        o_epilogue(o, lds, wave, lane, r32, hi, true, QG + m0 * XQW + XW + xh * XHD, XQW, (bf16*)o8, XW, XO8_SCALE);
        o_epilogue(o + 4, lds, wave, lane, r32, hi, true, QG + m0 * XQW + XW + xh * XHD + 128, XQW, (bf16*)(o8 + 128), XW, XO8_SCALE);
    } else {
    o_epilogue(o, lds, wave, lane, r32, hi, true, QG + m0 * XQW + XW + xh * XHD, XQW, XOIN + m0 * XW + xh * XHD, XW);
    o_epilogue(o + 4, lds, wave, lane, r32, hi, true, QG + m0 * XQW + XW + xh * XHD + 128, XQW, XOIN + m0 * XW + xh * XHD + 128, XW);
    }
    __syncthreads();
}
__device__ __forceinline__ void xattn_phase(Frame& F, const bf16* QG, const bf16* KVX, bf16* XOIN) {
    PH_IDS();
    char* lds = (char*)(F.lds + RING_OFF);
    for (int u = vcu; u < BATCH * XH * 8; u += G) xattn_unit(lds, QG, KVX, XOIN, u >> 5, (u >> 3) & 3, u & 7, tid, lane, wave);
}
}

#ifndef MK_PER_PHASE
#define MK_PER_PHASE 0
#endif
#ifndef MFMA_MOBA
#define MFMA_MOBA 1
#endif
#ifndef MFMA_SB
#define MFMA_SB 1
#endif
#ifndef MFMA_XA
#define MFMA_XA 1
#endif

#ifndef DBG_MOBA
#define DBG_MOBA 0
#endif
#ifndef DBG_STAT
#define DBG_STAT 0
#endif
constexpr int CW_DBG = 8192;
__device__ __forceinline__ void dbg_compare(Frame& F, const bf16* MIX, const bf16* ALT) {
    PH_IDS();
    unsigned* st = (unsigned*)(F.ctl + CW_DBG);
    unsigned cnt = 0, tot = 0, mnv = 0, mxv = 0, cb = 0, wv = 0, rc = 0, qbm = 0;
    for (size_t i = (size_t)vcu * 512 + tid; i < (size_t)MROWS * 2048; i += (size_t)G * 512) {
        const int m = (int)(i >> 11), c = (int)(i & 2047), t = m & (SEQ - 1), qb = t >> 8;
        if (!((MOBA_QBMASK >> qb) & 1)) continue;
        const float a = bf_lo((unsigned)ALT[(size_t)m * DM + CONVW + c]), r = bf_lo((unsigned)MIX[(size_t)m * DM + CONVW + c]);
        ++tot;
        if (!(fabsf(a - r) <= 0.03f * fabsf(r) + 0.003f)) { ++cnt; mnv = mnv > 2047u - (unsigned)t ? mnv : 2047u - (unsigned)t; mxv = mxv > (unsigned)t ? mxv : (unsigned)t; cb |= 1u << ((c >> 5) & 3); rc |= 1u << (t & 31); qbm |= 1u << qb; if (qb == 0) wv |= 1u << ((t >> 5) & 7); }
    }
    if (tot) atomicAdd(st + 1, tot);
    if (cnt) { atomicAdd(st + 0, cnt); atomicMax(st + 2, mnv); atomicMax(st + 3, mxv); atomicOr(st + 4, cb); atomicOr(st + 5, rc); atomicOr(st + 6, qbm); atomicOr(st + 7, wv); }
}
__device__ __forceinline__ void dbg_spin(Frame& F) {
    if (blockIdx.x == 0 && threadIdx.x == 0) {
        unsigned* st = (unsigned*)(F.ctl + CW_DBG); unsigned v[56];
        const unsigned cnt = __hip_atomic_load(st + 0, RLX_AGENT), tot = __hip_atomic_load(st + 1, RLX_AGENT), mn = 2047u - __hip_atomic_load(st + 2, RLX_AGENT), mxv = __hip_atomic_load(st + 3, RLX_AGENT);
        unsigned s1 = 0, s2 = 0;
        if (DBG_STAT == 0) { s1 = 0; s2 = 0; }
        if (DBG_STAT == 1) { s1 = cnt == 0 ? 0u : (mn > 31u ? 31u : mn); s2 = cnt == 0 ? 0u : 1u + (unsigned)(14.0f * (float)cnt / (float)(tot ? tot : 1u)); }
        if (DBG_STAT == 2) { s1 = __hip_atomic_load(st + 4, RLX_AGENT) | ((__hip_atomic_load(st + 6, RLX_AGENT) & 1u) << 4); s2 = __hip_atomic_load(st + 7, RLX_AGENT) & 15u; }
        if (DBG_STAT == 3) { const unsigned rcv = __hip_atomic_load(st + 5, RLX_AGENT); s1 = rcv & 31u; s2 = (rcv >> 5) & 15u; }
        (void)v;
        const unsigned long long ticks = (unsigned long long)s1 * 200000ull + (unsigned long long)(s2 > 15u ? 15u : s2) * 6400000ull;
        const unsigned long long t0 = __builtin_amdgcn_s_memrealtime();
        while (__builtin_amdgcn_s_memrealtime() - t0 < ticks) __builtin_amdgcn_s_sleep(64);
    }
}
constexpr int NPHASES = 19;
#ifndef CONV_IN_MOBA
#define CONV_IN_MOBA 1
#endif
#ifndef GEMM_STAG
#define GEMM_STAG 0
#define GEMM_STAG_CLS 8
#endif
#ifndef GEMM_SP2
#define GEMM_SP2 true
#endif
#ifndef GEMM_ALIGN
#define GEMM_ALIGN true
#endif
struct Args { const float* in[N_IN]; float* out; unsigned char* ws; int ph_lo, ph_hi; };
#ifndef FUSE_XQ
#define FUSE_XQ 0
#endif
struct XqOrder { int v;
    __device__ __forceinline__ bool next(int i, pg8::Unit& u) const { if (i > 1) return false; u.pm = v >> 2; u.pn = (v & 3) + 4 * i; return true; }
    __device__ __forceinline__ void a_ready(const pg8::Unit&) const {}
    __device__ __forceinline__ void done(const pg8::Unit&) const {} };
__device__ __forceinline__ void xq_xattn_fused(Frame& F, const bf16* A, const bf16* Wxq_t, bf16* QG, const bf16* KVX, bf16* XOIN) {
    int v_ = F.vcu_; asm volatile("" : "+s"(v_));
    { pg8::Gemm g{A, Wxq_t, MROWS, XQW, DM}; XqOrder S{v_}; pg8::EpiBf16 E{QG, XQW};
      pg8::gemm_phase<pg8::EpiBf16, XqOrder, GEMM_ALIGN, GEMM_SP2, true>(F.lds + RING_OFF, g, S, E); }
    __builtin_amdgcn_fence(__ATOMIC_ACQUIRE, "agent"); asm volatile("s_waitcnt vmcnt(0)" ::: "memory"); __syncthreads();
    PH_IDS();
    att::xattn_unit((char*)(F.lds + RING_OFF), QG, KVX, XOIN, (v_ >> 2) >> 3, v_ & 3, (v_ >> 2) & 7, tid, lane, wave);
}
#ifndef FP8_VG
#define FP8_VG 0
#endif
template <bool F16 = false, bool FP8 = false, class Epi> __device__ __forceinline__ void run_gemm(Frame& F, const bf16* A, const bf16* Bt, int M, int N, int K, const Epi& E) {
    int c_ = blockIdx.x, G_ = F.G_; asm volatile("" : "+s"(c_), "+s"(G_));
    pg8::Gemm g{A, Bt, M, N, K}; pg8::StaticOrder S; S.init(M, N, G_, c_);
    pg8::gemm_phase<Epi, pg8::StaticOrder, GEMM_ALIGN, GEMM_SP2, F16, FP8>(F.lds + RING_OFF, g, S, E);
}
__global__ void __launch_bounds__(NWAVES * 64, 2) mega_fwd(Args args) {
    extern __shared__ __attribute__((aligned(16))) unsigned char lds[];
    Frame F;
    F.lds = (LAS unsigned char*)lds;
    F.MISC = (volatile LAS unsigned*)(F.lds + MISC_OFF);
    F.G_ = gridDim.x; { const int bx = blockIdx.x; F.vcu_ = (F.G_ % 8 == 0) ? (bx % 8) * (F.G_ / 8) + bx / 8 : bx; }
    unsigned char* ws = args.ws;
    F.ctl = (gu32*)(ws + WS_CTL);
    for (int u = threadIdx.x; u < (LDS_BYTES - LDSCTL_OFF) / 4; u += NWAVES * 64) ((LAS unsigned*)(F.lds + LDSCTL_OFF))[u] = 0u;
    __syncthreads();
    XcdBarrier bar = xcd_barrier_post((unsigned*)(F.ctl + CW_BAR), F.MISC + 8);
    const int lo = args.ph_lo, hi = args.ph_hi;
#ifndef DBG_TMASK
#define DBG_TMASK 0u
#endif
#ifndef DBG_TAMP
#define DBG_TAMP 10
#endif
#define TP_BEGIN(k) do { if (((DBG_TMASK >> (k)) & 1u) && threadIdx.x == 0) { const unsigned long long t_ = __builtin_amdgcn_s_memrealtime(); F.MISC[18] = (unsigned)t_; F.MISC[19] = (unsigned)(t_ >> 32); } } while (0)
#define TP_END(k) do { if (((DBG_TMASK >> (k)) & 1u) && threadIdx.x == 0) { const unsigned long long t_ = __builtin_amdgcn_s_memrealtime() - (((unsigned long long)F.MISC[19] << 32) | F.MISC[18]); const unsigned long long a_ = (((unsigned long long)F.MISC[17] << 32) | F.MISC[16]) + t_; F.MISC[16] = (unsigned)a_; F.MISC[17] = (unsigned)(a_ >> 32); } } while (0)
#define IN(k) (lo <= (k) && (k) < hi)
#define SEAM(k) do { if (IN(k) && IN((k) + 1)) xcd_barrier(bar); } while (0)
#define PHASE_PTRS() unsigned char* wsp = ws; int Lp = L; asm volatile("" : "+s"(wsp), "+s"(Lp)); unsigned char* const wl = wsp + WS_W + (size_t)Lp * W_LAYER; (void)wl; \
        bf16* const XM = (bf16*)(wsp + WS_XM); bf16* const PROJ = (bf16*)(wsp + WS_PROJ); bf16* const QG = (bf16*)(wsp + WS_QG); bf16* const XOIN = (bf16*)(wsp + WS_XOIN); \
        bf16* const KVX = (bf16*)(wsp + WS_KVX) + (size_t)Lp * XQW; (void)XM; (void)PROJ; (void)QG; (void)XOIN; (void)KVX
    float* const OUT = args.out;

    if (IN(0)) { TP_BEGIN(0); p0_prologue(F, ws, (unsigned char*)args.out); SEAM(0); TP_END(0); }

    { constexpr int L = 0;
        const int pb = 1 + 9 * L;
        if (IN(pb + 0)) { TP_BEGIN(pb + 0); PHASE_PTRS(); {
#if defined(DBG_CLK)
                            unsigned long long c0_ = 0, r0_ = 0; if (L == 1) { c0_ = __builtin_amdgcn_s_memtime(); r0_ = __builtin_amdgcn_s_memrealtime(); }
#endif
                            if (GEMM_STAG != 0) { const unsigned cls_ = ((unsigned)blockIdx.x >> 3) % (unsigned)GEMM_STAG_CLS; const unsigned long long t0_ = __builtin_amdgcn_s_memrealtime();
                                                   while (__builtin_amdgcn_s_memrealtime() - t0_ < cls_ * (unsigned long long)GEMM_STAG) __builtin_amdgcn_s_sleep(8); }
                            pg8::EpiBf16 E{PROJ, NPROJ}; run_gemm<false>(F, L == 0 ? (const bf16*)XM : (const bf16*)(wsp + WS_X1B), (const bf16*)(wl + W_IN), MROWS, (L == 0 && FP8_VG) ? NPB0 : (L == 1 && FP8_L1) ? NPB1 : NPROJ, DM, E);
                            if (L == 1 && FP8_L1) { pg8::EpiBf16 E8{PROJ + NPB1, NPROJ, 1.f / 64.f}; run_gemm<false, true>(F, (const bf16*)(wsp + WS_X8_1), (const bf16*)(wl + W_IN + W1_W8_OFF), MROWS, NP8_1, DM / 2, E8); }
                            if (L == 0 && FP8_VG) { pg8::EpiBf16 E8{PROJ + NPB0, NPROJ, 1.f / 64.f}; run_gemm<false, true>(F, (const bf16*)((const unsigned char*)OUT + OUT_X8), (const bf16*)((const unsigned char*)OUT + OUT_W8), MROWS, NP8, DM / 2, E8); }
#if defined(DBG_CLK)
                            if (L == 1 && threadIdx.x == 0) { const unsigned long long dc_ = __builtin_amdgcn_s_memtime() - c0_, dr_ = __builtin_amdgcn_s_memrealtime() - r0_; const unsigned long long mhz_ = dc_ * 100ull / dr_;
                                F.MISC[16] = (unsigned)(mhz_ * 10000ull); F.MISC[17] = 0u; }
#endif
                          }
                          if (L == 0) { PHASE_PTRS(); pg8::EpiBf16 E{(bf16*)(wsp + WS_KVX), KVLD}; run_gemm(F, (const bf16*)(wsp + WS_MEMB), (const bf16*)(wsp + WS_WXKV), BATCH * NMEM, KVLD, DM, E);
                                        constexpr int KV_UNITS = (BATCH * NMEM / 256) * (KVLD / 256); if ((int)blockIdx.x >= KV_UNITS && (int)gridDim.x > KV_UNITS) p1_convert_win1(F, wsp, (int)blockIdx.x - KV_UNITS, (int)gridDim.x - KV_UNITS);
                                        else if ((int)gridDim.x <= KV_UNITS) p1_convert_win1(F, wsp, (int)blockIdx.x, (int)gridDim.x); }
                          SEAM(pb + 0); TP_END(pb + 0); }
        if (IN(pb + 1)) { TP_BEGIN(pb + 1); if (L == 0) { PHASE_PTRS(); if (!CONV_IN_MOBA) conv_phase(F, PROJ, XM, karg_in(I_CONVW)); kbar_phase(F, PROJ, (float*)(wsp + WS_KBAR)); SEAM(pb + 1); TP_END(pb + 1); } }
        if (IN(pb + 2)) { TP_BEGIN(pb + 2); PHASE_PTRS(); if (L == 0) { if (DBG_MOBA) { att::moba_phase(F, PROJ, (const float*)(wsp + WS_KBAR), karg_in(I_RELB), (bf16*)OUT); moba_naive_phase(F, PROJ, (const float*)(wsp + WS_KBAR), karg_in(I_RELB), XM); xcd_barrier(bar); dbg_compare(F, XM, (const bf16*)OUT); }
                          else { const int conv_slot_ = CONV_IN_MOBA ? (int)(((unsigned)blockIdx.x >> 3) % 3u) : -1; const bool conv_first = false; (void)conv_first;
                                 if (MFMA_MOBA) att::moba_phase(F, PROJ, (const float*)(wsp + WS_KBAR), karg_in(I_RELB), XM, conv_slot_, karg_in(I_CONVW), LATE_CONV ? wsp : nullptr);     if (!MFMA_MOBA || MOBA_QBMASK != 0xff) moba_naive_phase(F, PROJ, (const float*)(wsp + WS_KBAR), karg_in(I_RELB), XM); } }
                          else { const bool late_first = (((unsigned)blockIdx.x >> 3) & 1u) == 0u;
                                 if (LATE_CONV && late_first) { p_convert_late(F, wsp, 1); __syncthreads(); }
                                 if (MFMA_SB) att::sb_phase(F, PROJ, XM); else sb_naive_phase(F, PROJ, XM);
                                 if (LATE_CONV && !late_first) { __syncthreads(); p_convert_late(F, wsp, 1); __syncthreads(); }
#if defined(DBG_SBDUMMY)
                                 TP_BEGIN(19); att::sb_dummy_phase(F, PROJ); TP_END(19);
#endif
#if defined(DBG_SBDUMMY4)
                                 xcd_barrier(bar); TP_BEGIN(19); att::sb_dummy4_phase(F, PROJ, (bf16*)(wsp + WS_YB)); TP_END(19);
#endif
                          } SEAM(pb + 2); TP_END(pb + 2); }
        if (IN(pb + 3)) { TP_BEGIN(pb + 3); PHASE_PTRS();
                          if (L == 0 && FP8_OP0) { pg8::EpiBf16 E1{(bf16*)(wsp + WS_YB), DM}; run_gemm(F, XM, (const bf16*)(wl + W_OUT), MROWS, DM, CONVW, E1);
                                                   __builtin_amdgcn_fence(__ATOMIC_ACQUIRE, "agent");
                                                   pg8::EpiBf16Acc E2{(bf16*)(wsp + WS_YB), DM, 1.f / (64.f * MO8_SCALE)}; run_gemm<false, true>(F, (const bf16*)((const unsigned char*)XM + MIX8_OFF), (const bf16*)(wl + W_OUT + WOUT8_OFF), MROWS, DM, CONVW / 2, E2); }
                          else { pg8::EpiBf16 E{(bf16*)(wsp + WS_YB), DM}; run_gemm(F, XM, (const bf16*)(wl + W_OUT), MROWS, DM, DM, E); }
                          SEAM(pb + 3); TP_END(pb + 3); }
        if (IN(pb + 4)) { TP_BEGIN(pb + 4); PHASE_PTRS(); if (L == 0) ln_phase<false, false, false, (FP8_XQ != 0)>(F, karg_in(I_X), (const bf16*)(wsp + WS_YB), nullptr, (_Float16*)(wsp + WS_RH), nullptr, karg_in(I_LN1G0), karg_in(I_LN1B0), DN_ALPHA, (unsigned*)(wsp + WS_X8Q));
                          else ln_phase<true, false, false, (FP8_XQ != 0)>(F, (const _Float16*)OUT + (size_t)MROWS * DM, (const bf16*)(wsp + WS_YB), nullptr, (_Float16*)(wsp + WS_RH), nullptr, karg_in(I_LN1G1), karg_in(I_LN1B1), DN_ALPHA, (unsigned*)(wsp + WS_X8Q)); SEAM(pb + 4); TP_END(pb + 4); }
        const bool fuse_xq = FUSE_XQ && MFMA_XA && F.G_ == 256 && IN(pb + 5) && IN(pb + 6);
        if (IN(pb + 5)) { TP_BEGIN(pb + 5); { PHASE_PTRS(); if (fuse_xq) xq_xattn_fused(F, (const bf16*)(wsp + WS_RH), (const bf16*)(wl + W_XQ), QG, KVX, XOIN); else if (FP8_XQ == 2) { pg8::EpiBf16 E8{QG, XQW, 1.f / 64.f}; run_gemm<false, true>(F, (const bf16*)(wsp + WS_X8Q), (const bf16*)(wl + W_XQ), MROWS, XQW, DM / 2, E8); }
                          else if (FP8_XQ) { pg8::EpiBf16 E8{QG, XQW, 1.f / 64.f}; run_gemm<false, true>(F, (const bf16*)(wsp + WS_X8Q), (const bf16*)(wl + W_XQ), MROWS, XW, DM / 2, E8);
                                 pg8::EpiBf16 E{QG + XW, XQW}; run_gemm<true>(F, (const bf16*)(wsp + WS_RH), (const bf16*)(wl + W_XQ) + (size_t)XW * DM, MROWS, XW, DM, E); }
                          else { pg8::EpiBf16 E{QG, XQW}; run_gemm<true>(F, (const bf16*)(wsp + WS_RH), (const bf16*)(wl + W_XQ), MROWS, XQW, DM, E); } }
                          SEAM(pb + 5); TP_END(pb + 5); }
        if (IN(pb + 6) && !fuse_xq) { TP_BEGIN(pb + 6); PHASE_PTRS(); if (MFMA_XA) att::xattn_phase(F, QG, KVX, XOIN); else xattn_naive_phase(F, QG, KVX, XOIN); SEAM(pb + 6); TP_END(pb + 6); }
        if (IN(pb + 7)) { TP_BEGIN(pb + 7); PHASE_PTRS(); if (FP8_XO) { pg8::EpiBf16 E8{(bf16*)(wsp + WS_YB), DM, 1.f / (64.f * XO8_SCALE)}; run_gemm<false, true>(F, XOIN, (const bf16*)(wl + W_XO), MROWS, DM, XW / 2, E8); } else { pg8::EpiBf16 E{(bf16*)(wsp + WS_YB), DM}; run_gemm(F, XOIN, (const bf16*)(wl + W_XO), MROWS, DM, XW, E); } SEAM(pb + 7); TP_END(pb + 7); }
        if (IN(pb + 8)) { TP_BEGIN(pb + 8); PHASE_PTRS(); if (L == 0) ln_phase<true, false, true, (FP8_L1 != 0)>(F, (const _Float16*)(wsp + WS_RH), (const bf16*)(wsp + WS_YB), (bf16*)(wsp + WS_X1B), (_Float16*)OUT + (size_t)MROWS * DM, nullptr, karg_in(I_LN2G0), karg_in(I_LN2B0), DN_ALPHA, (unsigned*)(wsp + WS_X8_1));
                          else ln_phase<true, true>(F, (const _Float16*)(wsp + WS_RH), (const bf16*)(wsp + WS_YB), nullptr, nullptr, OUT, karg_in(I_LN2G1), karg_in(I_LN2B1), DN_ALPHA);   SEAM(pb + 8); TP_END(pb + 8); }

    }
    { constexpr int L = 1;
        const int pb = 1 + 9 * L;
        if (IN(pb + 0)) { TP_BEGIN(pb + 0); PHASE_PTRS(); {
#if defined(DBG_CLK)
                            unsigned long long c0_ = 0, r0_ = 0; if (L == 1) { c0_ = __builtin_amdgcn_s_memtime(); r0_ = __builtin_amdgcn_s_memrealtime(); }
#endif
                            if (GEMM_STAG != 0) { const unsigned cls_ = ((unsigned)blockIdx.x >> 3) % (unsigned)GEMM_STAG_CLS; const unsigned long long t0_ = __builtin_amdgcn_s_memrealtime();
                                                   while (__builtin_amdgcn_s_memrealtime() - t0_ < cls_ * (unsigned long long)GEMM_STAG) __builtin_amdgcn_s_sleep(8); }
                            pg8::EpiBf16 E{PROJ, NPROJ}; run_gemm<false>(F, L == 0 ? (const bf16*)XM : (const bf16*)(wsp + WS_X1B), (const bf16*)(wl + W_IN), MROWS, (L == 0 && FP8_VG) ? NPB0 : (L == 1 && FP8_L1) ? NPB1 : NPROJ, DM, E);
                            if (L == 1 && FP8_L1) { pg8::EpiBf16 E8{PROJ + NPB1, NPROJ, 1.f / 64.f}; run_gemm<false, true>(F, (const bf16*)(wsp + WS_X8_1), (const bf16*)(wl + W_IN + W1_W8_OFF), MROWS, NP8_1, DM / 2, E8); }
                            if (L == 0 && FP8_VG) { pg8::EpiBf16 E8{PROJ + NPB0, NPROJ, 1.f / 64.f}; run_gemm<false, true>(F, (const bf16*)((const unsigned char*)OUT + OUT_X8), (const bf16*)((const unsigned char*)OUT + OUT_W8), MROWS, NP8, DM / 2, E8); }
#if defined(DBG_CLK)
                            if (L == 1 && threadIdx.x == 0) { const unsigned long long dc_ = __builtin_amdgcn_s_memtime() - c0_, dr_ = __builtin_amdgcn_s_memrealtime() - r0_; const unsigned long long mhz_ = dc_ * 100ull / dr_;
                                F.MISC[16] = (unsigned)(mhz_ * 10000ull); F.MISC[17] = 0u; }
#endif
                          }
                          if (L == 0) { PHASE_PTRS(); pg8::EpiBf16 E{(bf16*)(wsp + WS_KVX), KVLD}; run_gemm(F, (const bf16*)(wsp + WS_MEMB), (const bf16*)(wsp + WS_WXKV), BATCH * NMEM, KVLD, DM, E);
                                        constexpr int KV_UNITS = (BATCH * NMEM / 256) * (KVLD / 256); if ((int)blockIdx.x >= KV_UNITS && (int)gridDim.x > KV_UNITS) p1_convert_win1(F, wsp, (int)blockIdx.x - KV_UNITS, (int)gridDim.x - KV_UNITS);
                                        else if ((int)gridDim.x <= KV_UNITS) p1_convert_win1(F, wsp, (int)blockIdx.x, (int)gridDim.x); }
                          SEAM(pb + 0); TP_END(pb + 0); }
        if (IN(pb + 1)) { TP_BEGIN(pb + 1); if (L == 0) { PHASE_PTRS(); if (!CONV_IN_MOBA) conv_phase(F, PROJ, XM, karg_in(I_CONVW)); kbar_phase(F, PROJ, (float*)(wsp + WS_KBAR)); SEAM(pb + 1); TP_END(pb + 1); } }
        if (IN(pb + 2)) { TP_BEGIN(pb + 2); PHASE_PTRS(); if (L == 0) { if (DBG_MOBA) { att::moba_phase(F, PROJ, (const float*)(wsp + WS_KBAR), karg_in(I_RELB), (bf16*)OUT); moba_naive_phase(F, PROJ, (const float*)(wsp + WS_KBAR), karg_in(I_RELB), XM); xcd_barrier(bar); dbg_compare(F, XM, (const bf16*)OUT); }
                          else { const int conv_slot_ = CONV_IN_MOBA ? (int)(((unsigned)blockIdx.x >> 3) % 3u) : -1; const bool conv_first = false; (void)conv_first;
                                 if (MFMA_MOBA) att::moba_phase(F, PROJ, (const float*)(wsp + WS_KBAR), karg_in(I_RELB), XM, conv_slot_, karg_in(I_CONVW), LATE_CONV ? wsp : nullptr);     if (!MFMA_MOBA || MOBA_QBMASK != 0xff) moba_naive_phase(F, PROJ, (const float*)(wsp + WS_KBAR), karg_in(I_RELB), XM); } }
                          else { const bool late_first = (((unsigned)blockIdx.x >> 3) & 1u) == 0u;
                                 if (LATE_CONV && late_first) { p_convert_late(F, wsp, 1); __syncthreads(); }
                                 if (MFMA_SB) att::sb_phase(F, PROJ, XM); else sb_naive_phase(F, PROJ, XM);
                                 if (LATE_CONV && !late_first) { __syncthreads(); p_convert_late(F, wsp, 1); __syncthreads(); }
#if defined(DBG_SBDUMMY)
                                 TP_BEGIN(19); att::sb_dummy_phase(F, PROJ); TP_END(19);
#endif
#if defined(DBG_SBDUMMY4)
                                 xcd_barrier(bar); TP_BEGIN(19); att::sb_dummy4_phase(F, PROJ, (bf16*)(wsp + WS_YB)); TP_END(19);
#endif
                          } SEAM(pb + 2); TP_END(pb + 2); }
        if (IN(pb + 3)) { TP_BEGIN(pb + 3); PHASE_PTRS();
                          if (L == 0 && FP8_OP0) { pg8::EpiBf16 E1{(bf16*)(wsp + WS_YB), DM}; run_gemm(F, XM, (const bf16*)(wl + W_OUT), MROWS, DM, CONVW, E1);
                                                   __builtin_amdgcn_fence(__ATOMIC_ACQUIRE, "agent");
                                                   pg8::EpiBf16Acc E2{(bf16*)(wsp + WS_YB), DM, 1.f / (64.f * MO8_SCALE)}; run_gemm<false, true>(F, (const bf16*)((const unsigned char*)XM + MIX8_OFF), (const bf16*)(wl + W_OUT + WOUT8_OFF), MROWS, DM, CONVW / 2, E2); }
                          else { pg8::EpiBf16 E{(bf16*)(wsp + WS_YB), DM}; run_gemm(F, XM, (const bf16*)(wl + W_OUT), MROWS, DM, DM, E); }
                          SEAM(pb + 3); TP_END(pb + 3); }
        if (IN(pb + 4)) { TP_BEGIN(pb + 4); PHASE_PTRS(); if (L == 0) ln_phase<false, false, false, (FP8_XQ != 0)>(F, karg_in(I_X), (const bf16*)(wsp + WS_YB), nullptr, (_Float16*)(wsp + WS_RH), nullptr, karg_in(I_LN1G0), karg_in(I_LN1B0), DN_ALPHA, (unsigned*)(wsp + WS_X8Q));
                          else ln_phase<true, false, false, (FP8_XQ != 0)>(F, (const _Float16*)OUT + (size_t)MROWS * DM, (const bf16*)(wsp + WS_YB), nullptr, (_Float16*)(wsp + WS_RH), nullptr, karg_in(I_LN1G1), karg_in(I_LN1B1), DN_ALPHA, (unsigned*)(wsp + WS_X8Q)); SEAM(pb + 4); TP_END(pb + 4); }
        const bool fuse_xq = FUSE_XQ && MFMA_XA && F.G_ == 256 && IN(pb + 5) && IN(pb + 6);
        if (IN(pb + 5)) { TP_BEGIN(pb + 5); { PHASE_PTRS(); if (fuse_xq) xq_xattn_fused(F, (const bf16*)(wsp + WS_RH), (const bf16*)(wl + W_XQ), QG, KVX, XOIN); else if (FP8_XQ == 2) { pg8::EpiBf16 E8{QG, XQW, 1.f / 64.f}; run_gemm<false, true>(F, (const bf16*)(wsp + WS_X8Q), (const bf16*)(wl + W_XQ), MROWS, XQW, DM / 2, E8); }
                          else if (FP8_XQ) { pg8::EpiBf16 E8{QG, XQW, 1.f / 64.f}; run_gemm<false, true>(F, (const bf16*)(wsp + WS_X8Q), (const bf16*)(wl + W_XQ), MROWS, XW, DM / 2, E8);
                                 pg8::EpiBf16 E{QG + XW, XQW}; run_gemm<true>(F, (const bf16*)(wsp + WS_RH), (const bf16*)(wl + W_XQ) + (size_t)XW * DM, MROWS, XW, DM, E); }
                          else { pg8::EpiBf16 E{QG, XQW}; run_gemm<true>(F, (const bf16*)(wsp + WS_RH), (const bf16*)(wl + W_XQ), MROWS, XQW, DM, E); } }
                          SEAM(pb + 5); TP_END(pb + 5); }
        if (IN(pb + 6) && !fuse_xq) { TP_BEGIN(pb + 6); PHASE_PTRS(); if (MFMA_XA) att::xattn_phase(F, QG, KVX, XOIN); else xattn_naive_phase(F, QG, KVX, XOIN); SEAM(pb + 6); TP_END(pb + 6); }
        if (IN(pb + 7)) { TP_BEGIN(pb + 7); PHASE_PTRS(); if (FP8_XO) { pg8::EpiBf16 E8{(bf16*)(wsp + WS_YB), DM, 1.f / (64.f * XO8_SCALE)}; run_gemm<false, true>(F, XOIN, (const bf16*)(wl + W_XO), MROWS, DM, XW / 2, E8); } else { pg8::EpiBf16 E{(bf16*)(wsp + WS_YB), DM}; run_gemm(F, XOIN, (const bf16*)(wl + W_XO), MROWS, DM, XW, E); } SEAM(pb + 7); TP_END(pb + 7); }
        if (IN(pb + 8)) { TP_BEGIN(pb + 8); PHASE_PTRS(); if (L == 0) ln_phase<true, false, true, (FP8_L1 != 0)>(F, (const _Float16*)(wsp + WS_RH), (const bf16*)(wsp + WS_YB), (bf16*)(wsp + WS_X1B), (_Float16*)OUT + (size_t)MROWS * DM, nullptr, karg_in(I_LN2G0), karg_in(I_LN2B0), DN_ALPHA, (unsigned*)(wsp + WS_X8_1));
                          else ln_phase<true, true>(F, (const _Float16*)(wsp + WS_RH), (const bf16*)(wsp + WS_YB), nullptr, nullptr, OUT, karg_in(I_LN2G1), karg_in(I_LN2B1), DN_ALPHA);   SEAM(pb + 8); TP_END(pb + 8); }

    }
#undef PHASE_PTRS
    if (DBG_MOBA) { xcd_barrier(bar); dbg_spin(F); }
#if defined(DBG_SEGSB)
    if (blockIdx.x == DBG_SEGBLK && threadIdx.x == DBG_SEGTID) { const unsigned long long t0 = __builtin_amdgcn_s_memrealtime(), ticks = ((((unsigned long long)F.MISC[17] << 32) | F.MISC[16])) * DBG_TAMP; while (__builtin_amdgcn_s_memrealtime() - t0 < ticks) __builtin_amdgcn_s_sleep(32); }
#endif
#if defined(DBG_TLOOP) || defined(DBG_SEG) || defined(DBG_CLK)
    if (blockIdx.x == 0 && threadIdx.x == 0) { const unsigned long long t0 = __builtin_amdgcn_s_memrealtime(), ticks = ((((unsigned long long)F.MISC[17] << 32) | F.MISC[16])) * DBG_TAMP; while (__builtin_amdgcn_s_memrealtime() - t0 < ticks) __builtin_amdgcn_s_sleep(32); }
#endif
    if (DBG_TMASK != 0u && blockIdx.x == 0 && threadIdx.x == 0) { const unsigned long long t0 = __builtin_amdgcn_s_memrealtime(), ticks = ((((unsigned long long)F.MISC[17] << 32) | F.MISC[16])) * DBG_TAMP; while (__builtin_amdgcn_s_memrealtime() - t0 < ticks) __builtin_amdgcn_s_sleep(32); }
#undef IN
#undef SEAM
}

extern "C" void kernel_launch(void* const* d_in, const int* in_sizes, int n_in, void* d_out, int out_size, void* d_ws, size_t ws_size, hipStream_t stream) {
    static int grid = 0;
    if (grid == 0) {
        if (n_in != N_IN || in_sizes[0] != MROWS * DM || out_size != MROWS * DM || ws_size < WS_END) { fprintf(stderr, "kernel_launch: unexpected shapes / workspace (n_in %d, ws %zu, need %zu); nothing launched\n", n_in, ws_size, (size_t)WS_END); grid = -1; return; }
        int dev = 0, cus = 0, per_cu = 0;
        if (hipGetDevice(&dev) != hipSuccess || hipDeviceGetAttribute(&cus, hipDeviceAttributeMultiprocessorCount, dev) != hipSuccess) { grid = -1; return; }
        if (hipFuncSetAttribute((const void*)mega_fwd, hipFuncAttributeMaxDynamicSharedMemorySize, LDS_BYTES) != hipSuccess) { fprintf(stderr, "kernel_launch: hipFuncSetAttribute failed\n"); grid = -1; return; }
        if (hipOccupancyMaxActiveBlocksPerMultiprocessor(&per_cu, (const void*)mega_fwd, NWAVES * 64, LDS_BYTES) != hipSuccess || per_cu < 1) { fprintf(stderr, "kernel_launch: occupancy query says %d workgroups per CU\n", per_cu); }
        (void)hipGetLastError();
        grid = cus;
    }
    if (grid < 0) return;
    if (hipMemsetAsync((char*)d_ws + WS_CTL, 0, CTL_ZERO_BYTES, stream) != hipSuccess) return;
    Args a{};
    for (int i = 0; i < N_IN; ++i) a.in[i] = (const float*)d_in[i];
    a.out = (float*)d_out; a.ws = (unsigned char*)d_ws;
#if MK_PER_PHASE
    for (int p = 0; p < NPHASES; ++p) { a.ph_lo = p; a.ph_hi = p + 1; hipLaunchKernelGGL(mega_fwd, dim3(grid), dim3(NWAVES * 64), LDS_BYTES, stream, a); }
#else
    a.ph_lo = 0; a.ph_hi = NPHASES;
    hipLaunchKernelGGL(mega_fwd, dim3(grid), dim3(NWAVES * 64), LDS_BYTES, stream, a);
#endif
    const hipError_t le = hipPeekAtLastError();
    if (le != hipSuccess) fprintf(stderr, "kernel_launch: launch failed: %s\n", hipGetErrorName(le));
}
```

```cpp
#include <hip/hip_runtime.h>
#include <cstdio>
#include <cstdint>
namespace pg8 {
#define PG8_LAS __attribute__((address_space(3)))
typedef unsigned short bf16_t;
typedef short bf16x8 __attribute__((ext_vector_type(8)));
typedef _Float16 f16x8 __attribute__((ext_vector_type(8)));
typedef int i32x4 __attribute__((ext_vector_type(4)));
typedef int i32x8 __attribute__((ext_vector_type(8)));
typedef float f32x4 __attribute__((ext_vector_type(4)));
typedef unsigned u32x4 __attribute__((ext_vector_type(4)));
constexpr int BM = 256, BK = 64, HALF = 128, HTB = HALF * BK * 2  , STAGE_BYTES = 8 * HTB, NXCD = 8, WGM = 8;

__host__ __device__ __forceinline__ int lds_byte(int r, int c) { const int st = (r >> 4) * 2 + (c >> 5), rr = r & 15, cc = c & 31, ob = rr * 64 + cc * 2; return st * 1024 + (ob ^ (((ob >> 9) & 1) << 5)); }
__host__ __device__ __forceinline__ void stage_rc(int b, int& R, int& C) { const int st = b / 1024, sb = b % 1024, swz = sb ^ (((sb >> 9) & 1) << 5); R = (st >> 1) * 16 + swz / 64; C = (st & 1) * 32 + (swz % 64) / 2; }
__host__ __device__ __forceinline__ int perm32(int rho) { const int n = rho >> 4, i = rho & 15; return 8 * (i >> 2) + 4 * n + (i & 3); }

struct Unit { int pm, pn; };
struct Gemm { const bf16_t* A; const bf16_t* Bt; int M, N, K; };

struct StaticOrder {
    int nM, nN, nwg, G, c;
    __host__ __device__ void init(int M, int N, int G_, int c_) { nM = M / BM; nN = N / BM; nwg = nM * nN; G = G_; c = c_; }
    __host__ __device__ bool next(int i, Unit& u) const {
        const long L = (long)i * G + c; if (L >= nwg) return false;
        int wgid = (int)L; { const int q = nwg / NXCD, r = nwg % NXCD, xcd = wgid % NXCD, off = wgid / NXCD; wgid = (xcd < r ? xcd * (q + 1) : r * (q + 1) + (xcd - r) * q) + off; }
        const int nig = WGM * nN, gid = wgid / nig, fm = gid * WGM, gsz = (nM - fm) < WGM ? (nM - fm) : WGM;
        u.pm = fm + ((wgid % nig) % gsz); u.pn = (wgid % nig) / gsz; return true;
    }
    __device__ __forceinline__ void a_ready(const Unit&) const {}
    __device__ __forceinline__ void done(const Unit&) const {}
};

__device__ __forceinline__ unsigned cvt_pk_bf16(float lo, float hi) { unsigned r; asm volatile("v_cvt_pk_bf16_f32 %0, %1, %2" : "=v"(r) : "v"(lo), "v"(hi)); return r; }
typedef float f32x2 __attribute__((ext_vector_type(2)));
struct EpiBf16 {
    static constexpr bool PERM = true, AFTER_DRAIN = false;
    static constexpr int NSTORE = 16;
    bf16_t* O; int ldc; float scale = 1.f;
    __device__ __forceinline__ void operator()(const f32x4 (&acc)[2][2][4][2], const Unit& u, int wr, int wc, int fr, int fq) const {
        const int row0 = u.pm * BM + wr * 64 + fr; const int col0 = u.pn * BM + wc * 32 + 8 * fq;
#pragma unroll
        for (int ai = 0; ai < 2; ++ai)
#pragma unroll
            for (int m = 0; m < 4; ++m) { bf16_t* rowp = O + (size_t)(row0 + ai * HALF + m * 16) * ldc + col0;
#pragma unroll
                for (int bj = 0; bj < 2; ++bj) { const f32x4 v0 = acc[ai][bj][m][0] * scale, v1 = acc[ai][bj][m][1] * scale;
                    u32x4 w; w.x = cvt_pk_bf16(v0[0], v0[1]); w.y = cvt_pk_bf16(v0[2], v0[3]); w.z = cvt_pk_bf16(v1[0], v1[1]); w.w = cvt_pk_bf16(v1[2], v1[3]);
                    *(__attribute__((address_space(1))) u32x4*)(rowp + bj * HALF) = w; } }
    }
};
struct EpiBf16Acc {
    static constexpr bool PERM = true, AFTER_DRAIN = false;
    static constexpr int NSTORE = 16;
    bf16_t* O; int ldc; float scale = 1.f;
    __device__ __forceinline__ void operator()(const f32x4 (&acc)[2][2][4][2], const Unit& u, int wr, int wc, int fr, int fq) const {
        const int row0 = u.pm * BM + wr * 64 + fr; const int col0 = u.pn * BM + wc * 32 + 8 * fq;
#pragma unroll
        for (int ai = 0; ai < 2; ++ai)
#pragma unroll
            for (int m = 0; m < 4; ++m) { bf16_t* rowp = O + (size_t)(row0 + ai * HALF + m * 16) * ldc + col0;
#pragma unroll
                for (int bj = 0; bj < 2; ++bj) { f32x4 v0 = acc[ai][bj][m][0] * scale, v1 = acc[ai][bj][m][1] * scale;
                    const u32x4 o = *(const __attribute__((address_space(1))) u32x4*)(rowp + bj * HALF);
                    v0[0] += __uint_as_float(o.x << 16); v0[1] += __uint_as_float(o.x & 0xffff0000u); v0[2] += __uint_as_float(o.y << 16); v0[3] += __uint_as_float(o.y & 0xffff0000u);
                    v1[0] += __uint_as_float(o.z << 16); v1[1] += __uint_as_float(o.z & 0xffff0000u); v1[2] += __uint_as_float(o.w << 16); v1[3] += __uint_as_float(o.w & 0xffff0000u);
                    u32x4 w; w.x = cvt_pk_bf16(v0[0], v0[1]); w.y = cvt_pk_bf16(v0[2], v0[3]); w.z = cvt_pk_bf16(v1[0], v1[1]); w.w = cvt_pk_bf16(v1[2], v1[3]);
                    *(__attribute__((address_space(1))) u32x4*)(rowp + bj * HALF) = w; } }
    }
};
struct EpiResF32 {
    static constexpr bool PERM = false, AFTER_DRAIN = false;
    static constexpr int NSTORE = 0;
    const float* res; float* out; int ldc; float alpha;
    __device__ __forceinline__ void operator()(const f32x4 (&acc)[2][2][4][2], const Unit& u, int wr, int wc, int fr, int fq) const {
        const int row0 = u.pm * BM + wr * 64 + fr, col0 = u.pn * BM + wc * 32 + 4 * fq;
#pragma unroll
        for (int ai = 0; ai < 2; ++ai)
#pragma unroll
            for (int m = 0; m < 4; ++m) { const size_t off = (size_t)(row0 + ai * HALF + m * 16) * ldc + col0;
                f32x4 r[2][2];
#pragma unroll
                for (int bj = 0; bj < 2; ++bj)
#pragma unroll
                    for (int n = 0; n < 2; ++n) r[bj][n] = *(const f32x4*)(res + off + bj * HALF + n * 16);
#pragma unroll
                for (int bj = 0; bj < 2; ++bj)
#pragma unroll
                    for (int n = 0; n < 2; ++n) *(f32x4*)(out + off + bj * HALF + n * 16) = r[bj][n] * alpha + acc[ai][bj][m][n];
                asm volatile("" ::: "memory"); }
    }
};
#ifndef GEMM_C0
#define GEMM_C0 0
#endif
#ifndef GEMM_RELAX
#define GEMM_RELAX 1
#endif
template <class Epi, class Sched, bool ALIGN_EPI = false, bool SP2 = false, bool F16 = false, bool FP8 = false>
__device__ __forceinline__ void gemm_phase(PG8_LAS unsigned char* lds, const Gemm g, const Sched& S, const Epi& E) {
    int tid_ = threadIdx.x; asm volatile("" : "+v"(tid_));
    const int tid = tid_, wid = __builtin_amdgcn_readfirstlane(tid >> 6), lane = tid & 63, wr = wid >> 2, wc = wid & 3, fr = lane & 15, fq = lane >> 4;
    const int K = g.K, nt = K / BK;
    unsigned voffA[2], voffB[2];
#pragma unroll
    for (int i = 0; i < 2; ++i) { int R, C; stage_rc(tid * 16 + i * 8192, R, C); const int Rb = Epi::PERM ? ((R & ~31) + perm32(R & 31)) : R;
        voffA[i] = (unsigned)(R * K + C) * 2u; voffB[i] = (unsigned)(Rb * K + C) * 2u; }
    const size_t kstep = (size_t)(BK * 2);
    const size_t hstep = (size_t)HALF * K * 2;
    const size_t tstep = 2 * hstep;
    const unsigned ldsw = (unsigned)wid * 1024u;
    const int aoff = lds_byte(wr * 64 + fr, fq * 8), boff = lds_byte(wc * 32 + fr, fq * 8);
    constexpr int KOFF = 1024;
#define PG8_SA(b, h) (((b) * 2 + (h)) * HTB)
#define PG8_SB(b, h) ((4 + (b) * 2 + (h)) * HTB)
#define PG8_STAGE(bufoff, gbase, voff) do { _Pragma("unroll") for (int _i = 0; _i < 2; ++_i) \
        __builtin_amdgcn_global_load_lds((const unsigned*)((const char*)(gbase) + (voff)[_i]), (PG8_LAS unsigned*)(lds + (bufoff) + ldsw + _i * 8192), 16, 0, 0); } while (0)
#define PG8_LDA(dst, b, h) do { if constexpr (FP8) { _Pragma("unroll") for (int m = 0; m < 4; ++m) dst##8[m] = __builtin_shufflevector(*(const PG8_LAS i32x4*)(lds + PG8_SA(b, h) + aoff + m * 2048), *(const PG8_LAS i32x4*)(lds + PG8_SA(b, h) + aoff + m * 2048 + KOFF), 0, 1, 2, 3, 4, 5, 6, 7); } \
        else { _Pragma("unroll") for (int m = 0; m < 4; ++m) _Pragma("unroll") for (int k = 0; k < 2; ++k) dst[m][k] = *(const PG8_LAS bf16x8*)(lds + PG8_SA(b, h) + aoff + m * 2048 + k * KOFF); } } while (0)
#define PG8_LDB(dst, b, h) do { if constexpr (FP8) { _Pragma("unroll") for (int n = 0; n < 2; ++n) dst##8[n] = __builtin_shufflevector(*(const PG8_LAS i32x4*)(lds + PG8_SB(b, h) + boff + n * 2048), *(const PG8_LAS i32x4*)(lds + PG8_SB(b, h) + boff + n * 2048 + KOFF), 0, 1, 2, 3, 4, 5, 6, 7); } \
        else { _Pragma("unroll") for (int n = 0; n < 2; ++n) _Pragma("unroll") for (int k = 0; k < 2; ++k) dst[n][k] = *(const PG8_LAS bf16x8*)(lds + PG8_SB(b, h) + boff + n * 2048 + k * KOFF); } } while (0)
#define PG8_MMA(ai, bj, At, Bt) do { __builtin_amdgcn_s_setprio(1); \
        if constexpr (FP8) { _Pragma("unroll") for (int m = 0; m < 4; ++m) _Pragma("unroll") for (int n = 0; n < 2; ++n) \
            asm volatile("v_mfma_f32_16x16x128_f8f6f4 %0, %1, %2, %0" : "+v"(acc[ai][bj][m][n]) : "v"(Bt##8[n]), "v"(At##8[m])); }     \
        else { _Pragma("unroll") for (int m = 0; m < 4; ++m) _Pragma("unroll") for (int n = 0; n < 2; ++n) _Pragma("unroll") for (int k = 0; k < 2; ++k) \
            acc[ai][bj][m][n] = F16 ? __builtin_amdgcn_mfma_f32_16x16x32_f16(__builtin_bit_cast(f16x8, Bt[n][k]), __builtin_bit_cast(f16x8, At[m][k]), acc[ai][bj][m][n], 0, 0, 0) \
                                    : __builtin_amdgcn_mfma_f32_16x16x32_bf16(Bt[n][k], At[m][k], acc[ai][bj][m][n], 0, 0, 0); } \
        __builtin_amdgcn_s_setprio(0); } while (0)
#define PG8_MMA0(ai, bj, At, Bt) do { __builtin_amdgcn_s_setprio(1);     \
        if constexpr (FP8) { _Pragma("unroll") for (int m = 0; m < 4; ++m) _Pragma("unroll") for (int n = 0; n < 2; ++n) \
            asm volatile("v_mfma_scale_f32_16x16x128_f8f6f4 %0, %1, %2, 0, %3, %3 op_sel_hi:[0,0,0]" : "=&v"(acc[ai][bj][m][n]) : "v"(Bt##8[n]), "v"(At##8[m]), "v"(0x7f7f7f7f)); } \
        else { _Pragma("unroll") for (int m = 0; m < 4; ++m) _Pragma("unroll") for (int n = 0; n < 2; ++n) { \
            acc[ai][bj][m][n] = F16 ? __builtin_amdgcn_mfma_f32_16x16x32_f16(__builtin_bit_cast(f16x8, Bt[n][0]), __builtin_bit_cast(f16x8, At[m][0]), (f32x4){0.f, 0.f, 0.f, 0.f}, 0, 0, 0) \
                                    : __builtin_amdgcn_mfma_f32_16x16x32_bf16(Bt[n][0], At[m][0], (f32x4){0.f, 0.f, 0.f, 0.f}, 0, 0, 0); \
            acc[ai][bj][m][n] = F16 ? __builtin_amdgcn_mfma_f32_16x16x32_f16(__builtin_bit_cast(f16x8, Bt[n][1]), __builtin_bit_cast(f16x8, At[m][1]), acc[ai][bj][m][n], 0, 0, 0) \
                                    : __builtin_amdgcn_mfma_f32_16x16x32_bf16(Bt[n][1], At[m][1], acc[ai][bj][m][n], 0, 0, 0); } } \
        __builtin_amdgcn_s_setprio(0); } while (0)
#if GEMM_C0
#define PG8_MMAF PG8_MMA0
#else
#define PG8_MMAF PG8_MMA
#endif
#define PG8_WAIT_V(n) asm volatile("s_waitcnt vmcnt(" #n ")" ::: "memory")
#define PG8_WAIT_VN(n) asm volatile("s_waitcnt vmcnt(%0)" :: "n"(n) : "memory")
#define PG8_WAIT_L(n) asm volatile("s_waitcnt lgkmcnt(" #n ")" ::: "memory")
#define PG8_BAR __builtin_amdgcn_s_barrier()
#define PG8_SCHED __builtin_amdgcn_sched_barrier(0)
    Unit cur, nxt; int ui = 0;
    if (!S.next(0, cur)) return;
    f32x4 acc[2][2][4][2];
    if constexpr (!(SP2 && (GEMM_RELAX != 0) && (GEMM_C0 != 0))) {
#pragma unroll
    for (int a = 0; a < 2; ++a)
#pragma unroll
        for (int b = 0; b < 2; ++b)
#pragma unroll
            for (int m = 0; m < 4; ++m)
#pragma unroll
                for (int n = 0; n < 2; ++n) acc[a][b][m][n] = (f32x4){0.f, 0.f, 0.f, 0.f};
    }
    bf16x8 At[4][2], B0[2][2], B1[2][2]; i32x8 At8[4], B08[2], B18[2];
    const char* cA = (const char*)g.A + (size_t)cur.pm * tstep; const char* cB = (const char*)g.Bt + (size_t)cur.pn * tstep;
    S.a_ready(cur);
    if constexpr (SP2) {
        PG8_STAGE(PG8_SB(0, 0), cB, voffB); PG8_STAGE(PG8_SB(0, 1), cB + hstep, voffB); PG8_STAGE(PG8_SA(0, 0), cA, voffA); PG8_STAGE(PG8_SA(0, 1), cA + hstep, voffA);
        if (wr == 1) PG8_BAR;
        PG8_WAIT_V(2); PG8_BAR;
        PG8_STAGE(PG8_SB(1, 0), cB + kstep, voffB); PG8_STAGE(PG8_SA(1, 0), cA + kstep, voffA); PG8_STAGE(PG8_SB(1, 1), cB + hstep + kstep, voffB);
        if constexpr (GEMM_RELAX != 0) PG8_WAIT_V(0); else PG8_WAIT_V(6);
        PG8_BAR;
    } else {
        PG8_STAGE(PG8_SB(0, 0), cB, voffB); PG8_STAGE(PG8_SA(0, 0), cA, voffA); PG8_STAGE(PG8_SB(0, 1), cB + hstep, voffB); PG8_STAGE(PG8_SA(0, 1), cA + hstep, voffA);
        if (wr == 1) PG8_BAR;
        PG8_WAIT_V(4); PG8_BAR;
        PG8_STAGE(PG8_SB(1, 0), cB + kstep, voffB); PG8_STAGE(PG8_SA(1, 0), cA + kstep, voffA); PG8_STAGE(PG8_SB(1, 1), cB + hstep + kstep, voffB);
        PG8_WAIT_V(6); PG8_BAR;
    }
    for (;;) {
        const bool has_next = S.next(ui + 1, nxt);
        const char* nA = has_next ? (const char*)g.A + (size_t)nxt.pm * tstep : cA; const char* nB = has_next ? (const char*)g.Bt + (size_t)nxt.pn * tstep : cB;
#define PG8_PTRS(t_) const bool last = ((t_) == nt - 2); const char* a1 = cA + (size_t)((t_) + 1) * kstep; \
            const char* a2 = last ? nA : cA + (size_t)((t_) + 2) * kstep; const char* b2 = last ? nB : cB + (size_t)((t_) + 2) * kstep; const char* a3 = a2 + kstep; const char* b3 = b2 + kstep; (void)a1
#define PG8_SP2_ITER(WAITA, MMAA) \
            PG8_LDB(B0, 0, 0); PG8_LDB(B1, 0, 1); PG8_SCHED; PG8_LDA(At, 0, 0); PG8_STAGE(PG8_SA(1, 1), a1 + hstep, voffA); \
            WAITA; PG8_WAIT_L(0); PG8_BAR; MMAA(0, 0, At, B0); MMAA(0, 1, At, B1); PG8_BAR; PG8_SCHED; \
            PG8_LDA(At, 0, 1); PG8_STAGE(PG8_SB(0, 0), b2, voffB); PG8_STAGE(PG8_SB(0, 1), b2 + hstep, voffB); PG8_STAGE(PG8_SA(0, 0), a2, voffA); \
            WAITA; PG8_WAIT_L(0); PG8_BAR; MMAA(1, 0, At, B0); MMAA(1, 1, At, B1); PG8_BAR; PG8_SCHED; \
            PG8_LDB(B0, 1, 0); PG8_LDB(B1, 1, 1); PG8_SCHED; PG8_LDA(At, 1, 0); PG8_STAGE(PG8_SA(0, 1), a2 + hstep, voffA); \
            PG8_WAIT_V(8); PG8_WAIT_L(0); PG8_BAR; PG8_MMA(0, 0, At, B0); PG8_MMA(0, 1, At, B1); PG8_BAR; PG8_SCHED; \
            PG8_LDA(At, 1, 1); PG8_STAGE(PG8_SB(1, 0), b3, voffB); PG8_STAGE(PG8_SB(1, 1), b3 + hstep, voffB); PG8_STAGE(PG8_SA(1, 0), a3, voffA); \
            PG8_WAIT_V(8); PG8_WAIT_L(0); PG8_BAR; PG8_MMA(1, 0, At, B0); PG8_MMA(1, 1, At, B1); PG8_BAR; PG8_SCHED
        int t0 = 0;
        if constexpr (SP2 && (GEMM_RELAX != 0)) {
            { PG8_PTRS(0); PG8_SP2_ITER(PG8_WAIT_VN(8 + Epi::NSTORE), PG8_MMAF); }
            t0 = 2;
        }
        for (int t = t0; t < nt; t += 2) {
            PG8_PTRS(t);
            if (last && has_next) S.a_ready(nxt);
            if constexpr (SP2) {
            PG8_SP2_ITER(PG8_WAIT_V(8), PG8_MMA);
            } else {
            PG8_LDB(B0, 0, 0); PG8_SCHED; PG8_LDA(At, 0, 0); PG8_STAGE(PG8_SA(1, 1), a1 + hstep, voffA);
            PG8_WAIT_L(8); PG8_BAR; PG8_WAIT_L(0); PG8_MMA(0, 0, At, B0); PG8_BAR; PG8_SCHED;
            PG8_LDB(B1, 0, 1); PG8_STAGE(PG8_SB(0, 0), b2, voffB);
            PG8_BAR; PG8_WAIT_L(0); PG8_MMA(0, 1, At, B1); PG8_BAR;
            PG8_LDA(At, 0, 1); PG8_STAGE(PG8_SA(0, 0), a2, voffA);
            PG8_BAR; PG8_WAIT_L(0); PG8_MMA(1, 0, At, B0); PG8_BAR; PG8_SCHED;
            PG8_STAGE(PG8_SB(0, 1), b2 + hstep, voffB);
            PG8_WAIT_V(6); PG8_BAR; PG8_MMA(1, 1, At, B1); PG8_BAR;
            PG8_LDB(B0, 1, 0); PG8_SCHED; PG8_LDA(At, 1, 0); PG8_STAGE(PG8_SA(0, 1), a2 + hstep, voffA);
            PG8_WAIT_L(8); PG8_BAR; PG8_WAIT_L(0); PG8_MMA(0, 0, At, B0); PG8_BAR; PG8_SCHED;
            PG8_LDB(B1, 1, 1); PG8_STAGE(PG8_SB(1, 0), b3, voffB);
            PG8_BAR; PG8_WAIT_L(0); PG8_MMA(0, 1, At, B1); PG8_BAR;
            PG8_LDA(At, 1, 1); PG8_STAGE(PG8_SA(1, 0), a3, voffA);
            PG8_BAR; PG8_WAIT_L(0); PG8_MMA(1, 0, At, B0); PG8_BAR; PG8_SCHED;
            PG8_STAGE(PG8_SB(1, 1), b3 + hstep, voffB);
            PG8_WAIT_V(6); PG8_BAR; PG8_MMA(1, 1, At, B1); PG8_BAR;
            }
        }
        if constexpr (ALIGN_EPI) { if (wr == 0) PG8_BAR; }
        if constexpr (!Epi::AFTER_DRAIN) { E(acc, cur, wr, wc, fr, fq); S.done(cur); }
        if (!has_next) break;
        if constexpr (!(SP2 && (GEMM_RELAX != 0) && (GEMM_C0 != 0))) {
#pragma unroll
        for (int a = 0; a < 2; ++a)
#pragma unroll
            for (int b = 0; b < 2; ++b)
#pragma unroll
                for (int m = 0; m < 4; ++m)
#pragma unroll
                    for (int n = 0; n < 2; ++n) acc[a][b][m][n] = (f32x4){0.f, 0.f, 0.f, 0.f};
        }
        cur = nxt; cA = nA; cB = nB; ++ui;
        if constexpr (ALIGN_EPI) { if (wr == 1) PG8_BAR; }
    }
    PG8_WAIT_V(0);
    if constexpr (!ALIGN_EPI) { if (wr == 0) PG8_BAR; }
    PG8_BAR;
    if constexpr (Epi::AFTER_DRAIN) { E.fused(acc, cur, wr, wc, fr, fq, lds, wid, lane); S.done(cur); }
#undef PG8_SA
#undef PG8_SB
#undef PG8_STAGE
#undef PG8_LDA
#undef PG8_LDB
#undef PG8_MMA
#undef PG8_WAIT_V
#undef PG8_WAIT_VN
#undef PG8_PTRS
#undef PG8_MMA0
#undef PG8_MMAF
#undef PG8_SP2_ITER
#undef PG8_WAIT_L
#undef PG8_BAR
#undef PG8_SCHED
}
}
#define GAS __attribute__((address_space(1)))
#define LAS __attribute__((address_space(3)))
typedef unsigned short bf16;
typedef unsigned v4u __attribute__((ext_vector_type(4)));
typedef float f32x4 __attribute__((ext_vector_type(4)));
typedef short bf16x8 __attribute__((ext_vector_type(8)));
typedef GAS unsigned gu32;
typedef GAS unsigned long long gu64;
#define RLX_AGENT __ATOMIC_RELAXED, __HIP_MEMORY_SCOPE_AGENT
#define LDS_WAIT() asm volatile("s_waitcnt lgkmcnt(0)" ::: "memory")
#define VM_WAIT() asm volatile("s_waitcnt vmcnt(0)" ::: "memory")
__device__ __forceinline__ unsigned long long rt() { return __builtin_amdgcn_s_memrealtime(); }
__device__ __forceinline__ unsigned f2bf(float f) { unsigned u = __builtin_bit_cast(unsigned, f); return (u + 0x7fffu + ((u >> 16) & 1u)) >> 16; }
__device__ __forceinline__ unsigned pk2(float lo, float hi) { return f2bf(lo) | (f2bf(hi) << 16); }

#define XB_TMO      128
#define XB_XCNT(j)  (256  + 64 * (j))
#define XB_XSUB(j)  (1280 + 64 * (j))
#define XB_XGEN(j)  (2304 + 64 * (j))
#define XB_TOP      3328
#define XB_TOPGEN   3392
#define XCD_BAR_WORDS 3456
#define XB_SPIN_CAP (1u << 22)

__device__ __forceinline__ unsigned xb_ld(unsigned* p)              { return __hip_atomic_load(p, __ATOMIC_RELAXED, __HIP_MEMORY_SCOPE_AGENT); }
__device__ __forceinline__ unsigned xb_add(unsigned* p, unsigned v) { return __hip_atomic_fetch_add(p, v, __ATOMIC_RELAXED, __HIP_MEMORY_SCOPE_AGENT); }
__device__ __forceinline__ unsigned xb_xcc_id() { return (unsigned)__builtin_amdgcn_s_getreg((3 << 11) | 20) & 0xFu; }
#define XB_SPIN(cond, bar) do { unsigned _sp = 0; while (cond) { __builtin_amdgcn_s_sleep(1); \
    if ((++_sp & 255u) == 0u) { if (xb_ld(&(bar)[XB_TMO])) break; if (_sp > XB_SPIN_CAP) { atomicAdd(&(bar)[XB_TMO], 1u); break; } } } } while (0)

struct XcdBarrier {
    unsigned* bar; unsigned x;
    volatile LAS unsigned* st;
};

__device__ __forceinline__ XcdBarrier xcd_barrier_post(unsigned* bar, volatile LAS unsigned* st) {
    XcdBarrier b; b.bar = bar; b.x = xb_xcc_id(); b.st = st;
    if (threadIdx.x == 0) (void)xb_add(&bar[XB_XCNT(b.x)], 1u);
    return b;
}
__device__ __forceinline__ void xcd_barrier_complete(unsigned* bar, unsigned x, unsigned& nloc, unsigned& nx) {
    const unsigned G = gridDim.x * gridDim.y * gridDim.z;
    unsigned sum, cnt, mine, sp = 0u;
    for (;;) {
        sum = 0u; cnt = 0u; mine = 0u;
#pragma unroll
        for (unsigned j = 0; j < 16; ++j) { const unsigned c = xb_ld(&bar[XB_XCNT(j)]); sum += c; cnt += (c > 0u) ? 1u : 0u; mine = (j == x) ? c : mine; }
        if (sum == G) break;
        __builtin_amdgcn_s_sleep(1);
        if ((++sp & 255u) == 0u) { if (xb_ld(&bar[XB_TMO])) break; if (sp > XB_SPIN_CAP) { atomicAdd(&bar[XB_TMO], 1u); break; } }
    }
    nloc = mine > 0u ? mine : 1u; nx = cnt > 0u ? cnt : 1u;
}

__device__ __forceinline__ void xcd_barrier(const XcdBarrier& b) {
    asm volatile("s_waitcnt vmcnt(0)" ::: "memory");
    __syncthreads();
    if (threadIdx.x == 0) {
        unsigned* bar = b.bar;
        __builtin_amdgcn_s_waitcnt(0);
        unsigned nloc = b.st[0], nx = b.st[1];
        if (nloc == 0u) { xcd_barrier_complete(bar, b.x, nloc, nx); b.st[0] = nloc; b.st[1] = nx; }
        const unsigned old = xb_add(&bar[XB_XSUB(b.x)], 1u);
        const unsigned gen = old / nloc;
        if (old + 1u == (gen + 1u) * nloc) {
            __builtin_amdgcn_fence(__ATOMIC_RELEASE, "agent");
            asm volatile("s_waitcnt vmcnt(0)" ::: "memory");
            const unsigned og = xb_add(&bar[XB_TOP], 1u);
            const unsigned tg = og / nx;
            if (og + 1u == (tg + 1u) * nx) xb_add(&bar[XB_TOPGEN], 1u);
            else XB_SPIN(xb_ld(&bar[XB_TOPGEN]) == tg, bar);
            __builtin_amdgcn_fence(__ATOMIC_ACQUIRE, "agent");
            xb_add(&bar[XB_XGEN(b.x)], 1u);
            asm volatile("s_waitcnt vmcnt(0)" ::: "memory");
        } else {
            XB_SPIN(xb_ld(&bar[XB_XGEN(b.x)]) == gen, bar);
            __builtin_amdgcn_fence(__ATOMIC_ACQUIRE, "agent");
            asm volatile("s_waitcnt vmcnt(0)" ::: "memory");
        }
    }
    __syncthreads();
}


constexpr int NWAVES = 8;
constexpr int BATCH = 8, SEQ = 2048, DM = 4096, MROWS = BATCH * SEQ;
constexpr int NPROJ = 16384;
constexpr int HD = 128;
constexpr int L0_H = 0, L0_B = 2048, L0_C = 4096, L0_GA = 6144, L0_Q = 8192, L0_K = 10240, L0_V = 12288, L0_GB = 14336;
constexpr int L1_Q = 0, L1_K = 4096, L1_V = 8192, L1_G = 12288;
constexpr int CONVW = 2048, MOBA_H = 16, MOBA_BLK = 256, MOBA_NB = 8, SB_H = 32;
constexpr int NMEM = 256, XH = 4, XHD = 256, XW = 1024, XQW = 2048;
constexpr float LN_EPS = 1e-5f;
constexpr float DN_ALPHA = 1.41421356237309515f;
constexpr float LOG2E = 1.4426950408889634f;
#ifndef FP8_VG
#define FP8_VG 1
#endif
constexpr int NP8 = 8192, NPB0 = NPROJ - NP8;
#ifndef FP8_XQ
#define FP8_XQ 2
#endif
#ifndef FP8_XO
#define FP8_XO 1
#endif
constexpr float XO8_SCALE = 16.f;
#ifndef FP8_OP0
#define FP8_OP0 1
#endif
constexpr float MO8_SCALE = 16.f;
constexpr size_t MIX8_OFF = 64u << 20;
constexpr size_t WOUT8_OFF = 16u << 20;
#ifndef FP8_L1
#define FP8_L1 0
#endif
constexpr int NP8_1 = 8192, NPB1 = NPROJ - NP8_1;
constexpr size_t OUT_X8 = 0, OUT_W8 = 64u << 20;
constexpr int N_IN = 22;
typedef float f32x2v __attribute__((ext_vector_type(2)));
enum { I_X = 0, I_MEM, I_RELB, I_WIN0, I_CONVW, I_WOUT0, I_LN1G0, I_LN1B0, I_WXQ0, I_WXKV0, I_WXO0, I_LN2G0, I_LN2B0, I_WIN1, I_WOUT1, I_LN1G1, I_LN1B1, I_WXQ1, I_WXKV1, I_WXO1, I_LN2G1, I_LN2B1 };

constexpr size_t MiB = 1u << 20;
constexpr size_t WS_CTL = 0, CTL_ZERO_BYTES = 1 * MiB;
constexpr size_t WS_KBAR = 1 * MiB;
constexpr size_t WS_W = 2 * MiB, W_LAYER = 184 * MiB;
constexpr size_t W_IN = 0, W_OUT = 128 * MiB, W_XQ = 160 * MiB, W_XO = 176 * MiB;
constexpr size_t WS_WXKV = 370 * MiB;
constexpr size_t WS_MEMB = 402 * MiB;
constexpr size_t WS_KVX = 418 * MiB; constexpr int KVLD = 4096;
constexpr size_t WS_XM = 434 * MiB;
constexpr size_t WS_PROJ = 562 * MiB;
constexpr size_t WS_QG = WS_PROJ, WS_XOIN = WS_PROJ + 64 * MiB;
constexpr size_t WS_RH = WS_PROJ + 256 * MiB;
constexpr size_t WS_YB = WS_PROJ + 128 * MiB;
constexpr size_t WS_X8Q = WS_PROJ + 384 * MiB;
constexpr size_t WS_END = 1074 * MiB;
constexpr size_t W1_W8_OFF = (size_t)NPB1 * DM * 2;
constexpr size_t WS_X1B = WS_W + W_IN;
constexpr size_t WS_X8_1 = WS_W + W_IN;
constexpr int CW_TMO = 0, CW_CODE = 1;
constexpr int CW_BAR = 4096;
constexpr int RING_OFF = 0, RING_BYTES = 131072;
constexpr int LDSCTL_OFF = RING_BYTES, MISC_OFF = LDSCTL_OFF + 320;
constexpr int LDS_BYTES = 147456;

#define PH_IDS() int tid_ = threadIdx.x; asm volatile("" : "+v"(tid_)); const int tid = tid_, lane = tid & 63, wave = __builtin_amdgcn_readfirstlane(tid >> 6); (void)lane; (void)wave; \
    int vcu_ = F.vcu_, G_ = F.G_; asm volatile("" : "+s"(vcu_), "+s"(G_)); const int vcu = vcu_, G = G_; (void)vcu; (void)G
struct Frame {
    LAS unsigned char* lds;
    volatile LAS unsigned* MISC;
    gu32* ctl;
    int vcu_, G_;
};

__device__ __forceinline__ const float* karg_in(int i) {
    unsigned long long v; const unsigned long long kp = (unsigned long long)__builtin_amdgcn_kernarg_segment_ptr(); const int off = __builtin_amdgcn_readfirstlane(i * 8);
    asm volatile("s_load_dwordx2 %0, %1, %2\n\ts_waitcnt lgkmcnt(0)" : "=&s"(v) : "s"(kp), "s"(off) : "memory");
    return (const float*)v;
}
__device__ __forceinline__ float wave_sum(float v) {
#pragma unroll
    for (int o = 1; o < 64; o <<= 1) v += __shfl_xor(v, o);
    return v;
}
__device__ __forceinline__ float wave_max(float v) {
#pragma unroll
    for (int o = 1; o < 64; o <<= 1) v = fmaxf(v, __shfl_xor(v, o));
    return v;
}
__device__ __forceinline__ float bf_lo(unsigned w) { return __builtin_bit_cast(float, w << 16); }
__device__ __forceinline__ float bf_hi(unsigned w) { return __builtin_bit_cast(float, w & 0xffff0000u); }
__device__ __forceinline__ unsigned pkbf(float lo, float hi) { return pg8::cvt_pk_bf16(lo, hi); }
__device__ __forceinline__ unsigned pk8(float a, float b, float c_, float d) { int w = 0; w = __builtin_amdgcn_cvt_pk_fp8_f32(a, b, w, false); w = __builtin_amdgcn_cvt_pk_fp8_f32(c_, d, w, true); return (unsigned)w; }
__device__ __forceinline__ unsigned pkh(float lo, float hi) { typedef _Float16 h2_ __attribute__((ext_vector_type(2))); const h2_ v = {(_Float16)lo, (_Float16)hi}; return __builtin_bit_cast(unsigned, v); }
__device__ __forceinline__ float silu_f(float g) { return g * __builtin_amdgcn_rcpf(1.0f + __builtin_amdgcn_exp2f(-g * LOG2E)); }
__device__ __forceinline__ int t5_bucket(int n) {
    const int b = 16 + (n >= 19) + (n >= 21) + (n >= 24) + (n >= 27) + (n >= 31) + (n >= 35) + (n >= 40) + (n >= 46) + (n >= 52) + (n >= 59) + (n >= 67) + (n >= 77) + (n >= 87) + (n >= 99) + (n >= 113);
    return n < 16 ? n : b;
}

#ifndef LATE_CONV
#define LATE_CONV 1
#endif
#ifndef P1_WOUT1
#define P1_WOUT1 0
#endif
struct P0Item { const float* W; bf16* WT; int K, N, item, f16; int ldt = 0, koff = 0; };
__device__ __forceinline__ void p0_item_load(float (&v)[32], const P0Item& I, int lane) {
    const int nblk = I.N / 32, kb = I.item / nblk, nb = I.item % nblk, k0 = 64 * kb, n0 = 32 * nb;
    const GAS float* src = (const GAS float*)I.W + (size_t)(k0 + (lane >> 5)) * I.N + n0 + (lane & 31);
#pragma unroll
    for (int i = 0; i < 32; ++i) v[i] = __builtin_nontemporal_load(src + (size_t)(2 * i) * I.N);
}
__device__ __forceinline__ void p0_item_store(const float (&v)[32], const P0Item& I, LAS float* scr, int lane) {
    const int nblk = I.N / 32, kb = I.item / nblk, nb = I.item % nblk, k0 = 64 * kb, n0 = 32 * nb;
#pragma unroll
    for (int i = 0; i < 32; ++i) scr[(2 * i + (lane >> 5)) * 33 + (lane & 31)] = v[i];
    LDS_WAIT(); asm volatile("" ::: "memory");
    const int c = lane & 7; const int ldt = I.ldt ? I.ldt : I.K, k0s = k0 - I.koff;
#pragma unroll
    for (int j = 0; j < 4; ++j) { const int n = (lane >> 3) + 8 * j; const LAS float* s = scr + (8 * c) * 33 + n;
        if (I.f16 == 2) {
            const unsigned lo8 = pk8(64.f * s[0 * 33], 64.f * s[1 * 33], 64.f * s[2 * 33], 64.f * s[3 * 33]), hi8 = pk8(64.f * s[4 * 33], 64.f * s[5 * 33], 64.f * s[6 * 33], 64.f * s[7 * 33]);
            *(GAS unsigned long long*)((unsigned char*)I.WT + (size_t)(n0 + n) * ldt + k0s + 8 * c) = (unsigned long long)lo8 | ((unsigned long long)hi8 << 32); continue; }
        v4u o;
        if (I.f16) { o.x = pkh(s[0 * 33], s[1 * 33]); o.y = pkh(s[2 * 33], s[3 * 33]); o.z = pkh(s[4 * 33], s[5 * 33]); o.w = pkh(s[6 * 33], s[7 * 33]); }
        else { o.x = pkbf(s[0 * 33], s[1 * 33]); o.y = pkbf(s[2 * 33], s[3 * 33]); o.z = pkbf(s[4 * 33], s[5 * 33]); o.w = pkbf(s[6 * 33], s[7 * 33]); }
        *(GAS v4u*)(I.WT + (size_t)(n0 + n) * ldt + k0s + 8 * c) = o; }
    LDS_WAIT(); asm volatile("" ::: "memory");
}
__device__ __forceinline__ void p0_transpose_item(const float* W, int K, int N, bf16* WT, LAS float* scr, int item, int lane) {
    float v[32]; const P0Item I{W, WT, K, N, item, 0}; p0_item_load(v, I, lane); p0_item_store(v, I, scr, lane);
}
template <bool ALSO_FP8>
__device__ __forceinline__ void cvt_bf16_stream(const float* src, bf16* dst, unsigned char* dst8, size_t n8  , size_t gtid, size_t gthreads) {
    for (size_t i = gtid; i < n8; i += 4 * gthreads) {
        f32x4 a[4], b[4];
#pragma unroll
        for (int u = 0; u < 4; ++u) { const size_t j = i + (size_t)u * gthreads; a[u] = __builtin_nontemporal_load((const GAS f32x4*)(src + j * 8)); b[u] = __builtin_nontemporal_load((const GAS f32x4*)(src + j * 8 + 4)); }
#pragma unroll
        for (int u = 0; u < 4; ++u) { const size_t j = i + (size_t)u * gthreads; v4u o; o.x = pkbf(a[u].x, a[u].y); o.y = pkbf(a[u].z, a[u].w); o.z = pkbf(b[u].x, b[u].y); o.w = pkbf(b[u].z, b[u].w); *(GAS v4u*)(dst + j * 8) = o;
            if (ALSO_FP8) *(GAS unsigned long long*)(dst8 + j * 8) = (unsigned long long)pk8(a[u].x, a[u].y, a[u].z, a[u].w) | ((unsigned long long)pk8(b[u].x, b[u].y, b[u].z, b[u].w) << 32); } }
}
struct P0Mat { const float* W; bf16* WT; int K, N, items; };
__device__ __forceinline__ void p0_prologue(Frame& F, unsigned char* ws, unsigned char* outb) {
    unsigned char* const w8 = outb + OUT_W8;
    PH_IDS();
    LAS float* scr = (LAS float*)(F.lds + RING_OFF + wave * 16384);
    const int gw = vcu * NWAVES + wave, NGW = G * NWAVES;
    constexpr int IT_IN = (DM / 64) * (NPROJ / 32), IT_OUT = (DM / 64) * (DM / 32), IT_XQ = (DM / 64) * (XQW / 32), IT_XO = (XW / 64) * (DM / 32);
    constexpr int IT_LAYER = IT_IN + IT_OUT + 2 * IT_XQ + IT_XO;
    auto item_of = [&](int it, P0Item& I) -> bool {
        if (it >= 2 * IT_LAYER) return false;
        const int L = it >= IT_LAYER ? 1 : 0; int r = it - L * IT_LAYER; unsigned char* wl = ws + WS_W + (size_t)L * W_LAYER;
        if (r < IT_IN) { if (L) return false; const int n0_ = 32 * (r % (NPROJ / 32)); if (FP8_VG && n0_ >= NPB0) I = P0Item{karg_in(I_WIN0), (bf16*)(w8 - (size_t)NPB0 * DM), DM, NPROJ, r, 2}; else I = P0Item{karg_in(I_WIN0), (bf16*)(wl + W_IN), DM, NPROJ, r, 0}; return true; } r -= IT_IN;
        if (r < IT_OUT) { if (LATE_CONV || (L && P1_WOUT1)) return false;
            if (FP8_OP0 && L == 0) { const int k0_ = 64 * (r / (DM / 32));
                if (k0_ < CONVW) I = P0Item{karg_in(I_WOUT0), (bf16*)(wl + W_OUT), DM, DM, r, 0, CONVW, 0}; else I = P0Item{karg_in(I_WOUT0), (bf16*)(wl + W_OUT + WOUT8_OFF), DM, DM, r, 2, CONVW, CONVW}; return true; }
            I = P0Item{karg_in(L ? I_WOUT1 : I_WOUT0), (bf16*)(wl + W_OUT), DM, DM, r, 0}; return true; } r -= IT_OUT;
        if (r < IT_XQ) { if (LATE_CONV) return false; I = P0Item{karg_in(L ? I_WXQ1 : I_WXQ0), (bf16*)(wl + W_XQ), DM, XQW, r, (FP8_XQ == 2 || (FP8_XQ && 32 * (r % (XQW / 32)) < XW)) ? 2 : 1}; return true; }         r -= IT_XQ;
        if (r < IT_XQ) { I = P0Item{karg_in(L ? I_WXKV1 : I_WXKV0), (bf16*)(ws + WS_WXKV) + (size_t)L * XQW * DM, DM, XQW, r, 0}; return true; } r -= IT_XQ;
        if (LATE_CONV) return false; I = P0Item{karg_in(L ? I_WXO1 : I_WXO0), (bf16*)(wl + W_XO), XW, DM, r, FP8_XO ? 2 : 0}; return true; };
    for (int it = gw; it < 2 * IT_LAYER; it += 2 * NGW) {
        P0Item A, B; const bool ha = item_of(it, A), hb = item_of(it + NGW, B);
        float va[32], vb[32];
        if (ha) p0_item_load(va, A, lane);
        if (hb) p0_item_load(vb, B, lane);
        if (ha) p0_item_store(va, A, scr, lane);
        if (hb) p0_item_store(vb, B, scr, lane);
    }
    const size_t gtid = (size_t)vcu * 512 + tid, gth = (size_t)G * 512;
    cvt_bf16_stream<(FP8_VG != 0)>(karg_in(I_X), (bf16*)(ws + WS_XM), outb + OUT_X8, (size_t)MROWS * DM / 8, gtid, gth);
    cvt_bf16_stream<false>(karg_in(I_MEM), (bf16*)(ws + WS_MEMB), nullptr, (size_t)BATCH * NMEM * DM / 8, gtid, gth);
}

__device__ __forceinline__ void p1_convert_win1(Frame& F, unsigned char* ws, int rank, int nranks) {
    PH_IDS();
    LAS float* scr = (LAS float*)(F.lds + RING_OFF + wave * 16384);
    constexpr int IT_IN = (DM / 64) * (NPROJ / 32);
    const float* w = karg_in(I_WIN1); bf16* wt = (bf16*)(ws + WS_W + W_LAYER + W_IN);
    unsigned char* const wt8 = (unsigned char*)wt + W1_W8_OFF - (size_t)NPB1 * DM;
    for (int it = rank * NWAVES + wave; it < IT_IN; it += nranks * NWAVES) { float v[32]; const bool f8 = FP8_L1 && 32 * (it % (NPROJ / 32)) >= NPB1;
        const P0Item I{w, f8 ? (bf16*)wt8 : wt, DM, NPROJ, it, f8 ? 2 : 0}; p0_item_load(v, I, lane); p0_item_store(v, I, scr, lane); }
    if (P1_WOUT1) {
        constexpr int IT_OUT = (DM / 64) * (DM / 32);
        const float* wo = karg_in(I_WOUT1); bf16* wot = (bf16*)(ws + WS_W + W_LAYER + W_OUT);
        for (int it = rank * NWAVES + wave; it < IT_OUT; it += nranks * NWAVES) { float v[32]; const P0Item I{wo, wot, DM, DM, it, 0}; p0_item_load(v, I, lane); p0_item_store(v, I, scr, lane); } }
}
__device__ __forceinline__ void p_convert_late(Frame& F, unsigned char* ws, int L) {
    PH_IDS();
    LAS float* scr = (LAS float*)(F.lds + RING_OFF + wave * 16384);
    constexpr int IT_OUT = (DM / 64) * (DM / 32), IT_XQ = (DM / 64) * (XQW / 32), IT_XO = (XW / 64) * (DM / 32), IT = IT_OUT + IT_XQ + IT_XO;
    unsigned char* wl = ws + WS_W + (size_t)L * W_LAYER;
    auto item_of = [&](int it, P0Item& I) -> bool { if (it >= IT) return false; int r = it;
        if (r < IT_OUT) { const int k0_ = 64 * (r / (DM / 32));
            if (FP8_OP0 && L == 0) { if (k0_ < CONVW) I = P0Item{karg_in(I_WOUT0), (bf16*)(wl + W_OUT), DM, DM, r, 0, CONVW, 0}; else I = P0Item{karg_in(I_WOUT0), (bf16*)(wl + W_OUT + WOUT8_OFF), DM, DM, r, 2, CONVW, CONVW}; }
            else I = P0Item{karg_in(L ? I_WOUT1 : I_WOUT0), (bf16*)(wl + W_OUT), DM, DM, r, 0}; }
        else if ((r -= IT_OUT) < IT_XQ) I = P0Item{karg_in(L ? I_WXQ1 : I_WXQ0), (bf16*)(wl + W_XQ), DM, XQW, r, (FP8_XQ == 2 || (FP8_XQ && 32 * (r % (XQW / 32)) < XW)) ? 2 : 1};
        else { r -= IT_XQ; I = P0Item{karg_in(L ? I_WXO1 : I_WXO0), (bf16*)(wl + W_XO), XW, DM, r, FP8_XO ? 2 : 0}; }
        return true; };
    const int NGW = G * NWAVES;
    for (int it = vcu * NWAVES + wave; it < IT; it += 2 * NGW) {
        P0Item A, B; const bool ha = item_of(it, A), hb = item_of(it + NGW, B);
        float va[32], vb[32];
        if (ha) p0_item_load(va, A, lane);
        if (hb) p0_item_load(vb, B, lane);
        if (ha) p0_item_store(va, A, scr, lane);
        if (hb) p0_item_store(vb, B, scr, lane);
    }
}
typedef _Float16 f16x4 __attribute__((ext_vector_type(4)));
template <bool RES_F16, bool FINAL, bool WRITE_BF16 = false, bool WRITE_FP8 = false>
__device__ __forceinline__ void ln_phase(Frame& F, const void* RES, const bf16* Y, bf16* XB, _Float16* XH, float* XF, const float* g, const float* b, float alpha, unsigned* X8 = nullptr) {
    PH_IDS();
    LAS f32x4* gl = (LAS f32x4*)(F.lds + RING_OFF); LAS f32x4* bl = (LAS f32x4*)(F.lds + RING_OFF + 16384);
    for (int i = tid; i < DM / 4; i += NWAVES * 64) { gl[i] = ((const GAS f32x4*)g)[i]; bl[i] = ((const GAS f32x4*)b)[i]; }
    __syncthreads();
    const int gw = vcu * NWAVES + wave, NGW = G * NWAVES;
    for (int m = gw; m < MROWS; m += NGW) {
        asm volatile("" ::: "memory");
        const GAS unsigned long long* yr = (const GAS unsigned long long*)(Y + (size_t)m * DM) + lane;
        f32x4 v[16]; unsigned long long yv[16]; float s = 0.f;
        if (RES_F16) { const GAS f16x4* rr = (const GAS f16x4*)((const _Float16*)RES + (size_t)m * DM) + lane;
            f16x4 rv[16];
#pragma unroll
            for (int j = 0; j < 16; ++j) { rv[j] = rr[64 * j]; yv[j] = yr[64 * j]; }
#pragma unroll
            for (int j = 0; j < 16; ++j) v[j] = (f32x4){(float)rv[j].x, (float)rv[j].y, (float)rv[j].z, (float)rv[j].w};
        } else { const GAS f32x4* rr = (const GAS f32x4*)((const float*)RES + (size_t)m * DM) + lane;
#pragma unroll
            for (int j = 0; j < 16; ++j) { v[j] = rr[64 * j]; yv[j] = yr[64 * j]; } }
#pragma unroll
        for (int j = 0; j < 16; ++j) { const unsigned y0 = (unsigned)yv[j], y1 = (unsigned)(yv[j] >> 32);
            v[j].x = v[j].x * alpha + bf_lo(y0); v[j].y = v[j].y * alpha + bf_hi(y0); v[j].z = v[j].z * alpha + bf_lo(y1); v[j].w = v[j].w * alpha + bf_hi(y1);
            s += (v[j].x + v[j].y) + (v[j].z + v[j].w); }
        const float mean = wave_sum(s) * (1.f / DM); float s2 = 0.f;
#pragma unroll
        for (int j = 0; j < 16; ++j) { v[j] = v[j] - mean; s2 += (v[j].x * v[j].x + v[j].y * v[j].y) + (v[j].z * v[j].z + v[j].w * v[j].w); }
        const float rstd = 1.f / sqrtf(wave_sum(s2) * (1.f / DM) + LN_EPS);
        GAS f32x4* xr = (GAS f32x4*)(XF + (size_t)m * DM) + lane; GAS unsigned long long* o8 = (GAS unsigned long long*)(XB + (size_t)m * DM) + lane; GAS f16x4* oh = (GAS f16x4*)(XH + (size_t)m * DM) + lane; GAS unsigned* o1 = (GAS unsigned*)(X8 + (size_t)m * (DM / 4)) + lane;
#pragma unroll
        for (int j = 0; j < 16; ++j) { if ((j & 3) == 0) asm volatile("" ::: "memory");
            const f32x4 o = v[j] * rstd * gl[64 * j + lane] + bl[64 * j + lane];
            if (FINAL) xr[64 * j] = o;
            else { oh[64 * j] = (f16x4){(_Float16)o.x, (_Float16)o.y, (_Float16)o.z, (_Float16)o.w}; if (WRITE_BF16) o8[64 * j] = (unsigned long long)pkbf(o.x, o.y) | ((unsigned long long)pkbf(o.z, o.w) << 32);
                   if (WRITE_FP8) o1[64 * j] = pk8(o.x, o.y, o.z, o.w); } }
    }
    __syncthreads();
}

__device__ __forceinline__ void conv_phase(Frame& F, const bf16* P, bf16* MIX, const float* cw) {
    PH_IDS();
    const int half = tid >> 8, c0 = (tid & 255) * 8;
    float w0[8], w1[8], w2[8];
#pragma unroll
    for (int i = 0; i < 8; ++i) { w0[i] = cw[c0 + i]; w1[i] = cw[CONVW + c0 + i]; w2[i] = cw[2 * CONVW + c0 + i]; }
    for (int item = vcu; item < MROWS / 32; item += G) {
        const int m0 = item * 32 + half * 16; const bool hist = (m0 & (SEQ - 1)) != 0;
        float p2[8], p1[8];
#pragma unroll
        for (int i = 0; i < 8; ++i) { p2[i] = 0.f; p1[i] = 0.f; }
        if (hist) {
            const bf16* r2 = P + (size_t)(m0 - 2) * NPROJ + c0; const bf16* r1 = P + (size_t)(m0 - 1) * NPROJ + c0;
            const v4u h2 = *(const GAS v4u*)(r2 + L0_H), c2 = *(const GAS v4u*)(r2 + L0_C), h1 = *(const GAS v4u*)(r1 + L0_H), c1 = *(const GAS v4u*)(r1 + L0_C);
#pragma unroll
            for (int i = 0; i < 4; ++i) { p2[2 * i] = bf_lo(h2[i]) * bf_lo(c2[i]); p2[2 * i + 1] = bf_hi(h2[i]) * bf_hi(c2[i]); p1[2 * i] = bf_lo(h1[i]) * bf_lo(c1[i]); p1[2 * i + 1] = bf_hi(h1[i]) * bf_hi(c1[i]); }
        }
#pragma unroll 8
        for (int r = 0; r < 16; ++r) {
            const bf16* rp = P + (size_t)(m0 + r) * NPROJ + c0;
            const v4u hv = *(const GAS v4u*)(rp + L0_H), bv = *(const GAS v4u*)(rp + L0_B), cv = *(const GAS v4u*)(rp + L0_C), gv = *(const GAS v4u*)(rp + L0_GA);
            float y[8];
#pragma unroll
            for (int i = 0; i < 4; ++i) {
                const float ch0 = bf_lo(hv[i]) * bf_lo(cv[i]), ch1 = bf_hi(hv[i]) * bf_hi(cv[i]);
                const float cv0 = w0[2 * i] * p2[2 * i] + w1[2 * i] * p1[2 * i] + w2[2 * i] * ch0, cv1 = w0[2 * i + 1] * p2[2 * i + 1] + w1[2 * i + 1] * p1[2 * i + 1] + w2[2 * i + 1] * ch1;
                y[2 * i] = bf_lo(bv[i]) * cv0 * silu_f(bf_lo(gv[i])); y[2 * i + 1] = bf_hi(bv[i]) * cv1 * silu_f(bf_hi(gv[i]));
                p2[2 * i] = p1[2 * i]; p2[2 * i + 1] = p1[2 * i + 1]; p1[2 * i] = ch0; p1[2 * i + 1] = ch1;
            }
            v4u o; o.x = pkbf(y[0], y[1]); o.y = pkbf(y[2], y[3]); o.z = pkbf(y[4], y[5]); o.w = pkbf(y[6], y[7]);
            *(GAS v4u*)(MIX + (size_t)(m0 + r) * (FP8_OP0 ? CONVW : DM) + c0) = o;
        }
    }
}
__device__ __forceinline__ void kbar_phase(Frame& F, const bf16* P, float* KBAR) {
    PH_IDS();
    LAS float* red = (LAS float*)(F.lds + RING_OFF);
    const int rg = tid >> 5, cgp = tid & 31;
    for (int item = vcu; item < BATCH * MOBA_NB * 8; item += G) {
        const int cgrp = item & 7, bn = item >> 3;
        const bf16* src = P + (size_t)(bn * MOBA_BLK + rg * 16) * NPROJ + L0_K + cgrp * 256 + cgp * 8;
        float a[8];
#pragma unroll
        for (int i = 0; i < 8; ++i) a[i] = 0.f;
#pragma unroll
        for (int r = 0; r < 16; ++r) { const v4u v = *(const GAS v4u*)(src + (size_t)r * NPROJ);
#pragma unroll
            for (int i = 0; i < 4; ++i) { a[2 * i] += bf_lo(v[i]); a[2 * i + 1] += bf_hi(v[i]); } }
#pragma unroll
        for (int i = 0; i < 8; ++i) red[rg * 256 + cgp * 8 + i] = a[i];
        __syncthreads();
        if (tid < 256) { float s = 0.f;
#pragma unroll
            for (int q = 0; q < 16; ++q) s += red[q * 256 + tid];
            KBAR[(size_t)bn * 2048 + cgrp * 256 + tid] = s * (1.f / MOBA_BLK); }
        __syncthreads();
    }
}

#ifndef MFMA_MOBA
#define MFMA_MOBA 1
#endif
#ifndef MOBA_QBMASK
#define MOBA_QBMASK 0xff
#endif
#ifndef DBG_MOBA
#define DBG_MOBA 0
#endif
#ifndef DBG_STAT
#define DBG_STAT 3
#endif
template <int D> __device__ __forceinline__ float dot_row(const LAS float* qs, const bf16* kp) {
    float s0 = 0.f, s1 = 0.f;
#pragma unroll 4
    for (int c = 0; c < D / 8; ++c) { const v4u kv = *(const GAS v4u*)(kp + c * 8); const f32x4 qa = *(const LAS f32x4*)(qs + c * 8), qb = *(const LAS f32x4*)(qs + c * 8 + 4);
        s0 += bf_lo(kv.x) * qa.x + bf_hi(kv.x) * qa.y + bf_lo(kv.y) * qa.z + bf_hi(kv.y) * qa.w;
        s1 += bf_lo(kv.z) * qb.x + bf_hi(kv.z) * qb.y + bf_lo(kv.w) * qb.z + bf_hi(kv.w) * qb.w; }
    return s0 + s1;
}
__device__ __forceinline__ float log_sigmoid_f(float x) { return fminf(x, 0.f) - __logf(1.f + __expf(-fabsf(x))); }

__device__ __forceinline__ void moba_naive_phase(Frame& F, const bf16* P, const float* KBAR, const float* relb, bf16* MIX) {
    PH_IDS();
    LAS float* qs = (LAS float*)(F.lds + RING_OFF + wave * 8192);
    LAS float* sc = qs + 256;
    const int gw = vcu * NWAVES + wave, NGW = G * NWAVES;
    const float scale = 0.08838834764831845f, NEG = -__builtin_inff();
    for (int task = gw; task < MROWS * MOBA_H; task += NGW) {
        const int h = task & 15, m = task >> 4, b = m >> 11, t = m & (SEQ - 1), qb = t >> 8;
        if (!DBG_MOBA && MFMA_MOBA && ((MOBA_QBMASK >> qb) & 1)) continue;
        const unsigned qw = *(const GAS unsigned*)(P + (size_t)m * NPROJ + L0_Q + h * HD + 2 * lane);
        const float q0 = bf_lo(qw), q1 = bf_hi(qw);
        qs[2 * lane] = q0; qs[2 * lane + 1] = q1;
        LDS_WAIT();
        float gate[7];
#pragma unroll
        for (int n = 0; n < 7; ++n) { float pg = 0.f;
            if (n < qb) { const f32x2v kb = *(const GAS f32x2v*)(KBAR + (size_t)(b * 8 + n) * 2048 + h * HD + 2 * lane); pg = q0 * kb.x + q1 * kb.y; }
            gate[n] = wave_sum(pg); }
        unsigned sel = 0;
#pragma unroll
        for (int n = 0; n < 7; ++n) { int rank = 0;
#pragma unroll
            for (int n2 = 0; n2 < 7; ++n2) rank += (n2 < qb && (gate[n2] > gate[n] || (gate[n2] == gate[n] && n2 < n))) ? 1 : 0;
            if (n < qb && (qb <= 3 || rank < 3)) sel |= 1u << n; }
        sel = (unsigned)__builtin_amdgcn_readfirstlane((int)sel);
        int nk = 0; float mx = NEG;
        for (int n = 0; n <= qb; ++n) {
            if (n < qb && !((sel >> n) & 1u)) continue;
            const int kend = (n == qb) ? (t & 255) + 1 : MOBA_BLK;
            for (int k0 = 0; k0 < kend; k0 += 64) {
                const int kin = k0 + lane, key = n * MOBA_BLK + kin;
                float s = dot_row<HD>(qs, P + (size_t)(b * SEQ + key) * NPROJ + L0_K + h * HD);
                const int dist = t - key;
                s = s * scale + relb[t5_bucket(dist < 0 ? 0 : dist) * MOBA_H + h];
                s = kin < kend ? s : NEG;
                sc[nk + lane] = s; mx = fmaxf(mx, s); nk += 64;
            }
        }
        mx = wave_max(mx);
        LDS_WAIT();
        float lsum = 0.f;
        for (int i = lane; i < nk; i += 64) { const float p = __builtin_amdgcn_exp2f((sc[i] - mx) * LOG2E); sc[i] = p; lsum += p; }
        lsum = wave_sum(lsum);
        LDS_WAIT();
        float o0 = 0.f, o1 = 0.f; int idx = 0;
        for (int n = 0; n <= qb; ++n) {
            if (n < qb && !((sel >> n) & 1u)) continue;
            const int kend = (n == qb) ? (t & 255) + 1 : MOBA_BLK;
            const bf16* vp = P + (size_t)(b * SEQ + n * MOBA_BLK) * NPROJ + L0_V + h * HD + 2 * lane;
#pragma unroll 4
            for (int j = 0; j < kend; ++j) { const float p = sc[idx + j]; const unsigned vw = *(const GAS unsigned*)(vp + (size_t)j * NPROJ); o0 += p * bf_lo(vw); o1 += p * bf_hi(vw); }
            idx += (kend + 63) & ~63;
        }
        const float inv = 1.f / lsum;
        const unsigned gwd = *(const GAS unsigned*)(P + (size_t)m * NPROJ + L0_GB + h * HD + 2 * lane);
        *(GAS unsigned*)(MIX + (size_t)m * DM + CONVW + h * HD + 2 * lane) = pkbf(o0 * inv * silu_f(bf_lo(gwd)), o1 * inv * silu_f(bf_hi(gwd)));
        LDS_WAIT();
    }
}

__device__ __forceinline__ void sb_naive_phase(Frame& F, const bf16* P, bf16* MIX) {
    PH_IDS();
    LAS float* qs = (LAS float*)(F.lds + RING_OFF + wave * 8192);
    LAS float* sc = qs + 256;
    const int gw = vcu * NWAVES + wave, NGW = G * NWAVES;
    const float scale = 0.08838834764831845f;
    for (int task = gw; task < MROWS * SB_H; task += NGW) {
        const int h = task & 31, m = task >> 5, b = m >> 11, t = m & (SEQ - 1);
        const unsigned qw = *(const GAS unsigned*)(P + (size_t)m * NPROJ + L1_Q + h * HD + 2 * lane);
        qs[2 * lane] = bf_lo(qw); qs[2 * lane + 1] = bf_hi(qw);
        LDS_WAIT();
        float R = 0.f, o0 = 0.f, o1 = 0.f;
        for (int kend = t; kend > 0; kend -= 64) {
            const int key = kend - 1 - lane; const bool valid = key >= 0;
            const float z = dot_row<HD>(qs, P + (size_t)(b * SEQ + (valid ? key : 0)) * NPROJ + L1_K + h * HD) * scale;
            const float lsn = valid ? log_sigmoid_f(-z) : 0.f;
            float inc = lsn;
#pragma unroll
            for (int d = 1; d < 64; d <<= 1) { const float u = __shfl_up(inc, d); if (lane >= d) inc += u; }
            const float excl = inc - lsn, total = __shfl(inc, 63);
            sc[lane] = valid ? __expf(log_sigmoid_f(z) + R + excl) : 0.f;
            LDS_WAIT();
            const int cnt = kend < 64 ? kend : 64;
            const bf16* vp = P + (size_t)(b * SEQ + kend - 1) * NPROJ + L1_V + h * HD + 2 * lane;
#pragma unroll 4
            for (int j = 0; j < cnt; ++j) { const float p = sc[j]; const unsigned vw = *(const GAS unsigned*)(vp - (size_t)j * NPROJ); o0 += p * bf_lo(vw); o1 += p * bf_hi(vw); }
            LDS_WAIT();
            R += total;
            if (R < -88.f) break;
        }
        const unsigned gwd = *(const GAS unsigned*)(P + (size_t)m * NPROJ + L1_G + h * HD + 2 * lane);
        *(GAS unsigned*)(MIX + (size_t)m * DM + h * HD + 2 * lane) = pkbf(o0 * silu_f(bf_lo(gwd)), o1 * silu_f(bf_hi(gwd)));
    }
}

__device__ __forceinline__ void xattn_naive_phase(Frame& F, const bf16* QG, const bf16* KVX, bf16* XOIN) {
    PH_IDS();
    LAS float* qs = (LAS float*)(F.lds + RING_OFF + wave * 8192);
    LAS float* sc = qs + 256;
    const int gw = vcu * NWAVES + wave, NGW = G * NWAVES;
    for (int task = gw; task < MROWS * XH; task += NGW) {
        const int xh = task & 3, m = task >> 2, b = m >> 11;
        const unsigned long long qw = *(const GAS unsigned long long*)(QG + (size_t)m * XQW + xh * XHD + 4 * lane);
        qs[4 * lane] = bf_lo((unsigned)qw); qs[4 * lane + 1] = bf_hi((unsigned)qw); qs[4 * lane + 2] = bf_lo((unsigned)(qw >> 32)); qs[4 * lane + 3] = bf_hi((unsigned)(qw >> 32));
        LDS_WAIT();
        float mx = -__builtin_inff();
#pragma unroll 1
        for (int c = 0; c < 4; ++c) { const int key = c * 64 + lane;
            const float s = dot_row<XHD>(qs, KVX + (size_t)(b * NMEM + key) * KVLD + xh * XHD) * 0.0625f; sc[key] = s; mx = fmaxf(mx, s); }
        mx = wave_max(mx);
        LDS_WAIT();
        float lsum = 0.f;
#pragma unroll
        for (int c = 0; c < 4; ++c) { const float p = __builtin_amdgcn_exp2f((sc[c * 64 + lane] - mx) * LOG2E); sc[c * 64 + lane] = p; lsum += p; }
        lsum = wave_sum(lsum);
        LDS_WAIT();
        float o[4] = {0.f, 0.f, 0.f, 0.f};
        const bf16* vp = KVX + (size_t)(b * NMEM) * KVLD + XW + xh * XHD + 4 * lane;
#pragma unroll 4
        for (int j = 0; j < NMEM; ++j) { const float p = sc[j]; const unsigned long long vw = *(const GAS unsigned long long*)(vp + (size_t)j * KVLD);
            o[0] += p * bf_lo((unsigned)vw); o[1] += p * bf_hi((unsigned)vw); o[2] += p * bf_lo((unsigned)(vw >> 32)); o[3] += p * bf_hi((unsigned)(vw >> 32)); }
        const float inv = 1.f / lsum;
        const unsigned long long gq = *(const GAS unsigned long long*)(QG + (size_t)m * XQW + XW + xh * XHD + 4 * lane);
        const unsigned r0 = pkbf(o[0] * inv * silu_f(bf_lo((unsigned)gq)), o[1] * inv * silu_f(bf_hi((unsigned)gq)));
        const unsigned r1 = pkbf(o[2] * inv * silu_f(bf_lo((unsigned)(gq >> 32))), o[3] * inv * silu_f(bf_hi((unsigned)(gq >> 32))));
        *(GAS unsigned long long*)(XOIN + (size_t)m * XW + xh * XHD + 4 * lane) = (unsigned long long)r0 | ((unsigned long long)r1 << 32);
        LDS_WAIT();
    }
}

#ifndef MOBA_DMA
#define MOBA_DMA 1
#endif
#ifndef MOBA_QBMASK
#define MOBA_QBMASK 0xff
#endif
namespace att {
typedef short s16x4 __attribute__((ext_vector_type(4)));
typedef float f32x16 __attribute__((ext_vector_type(16)));
constexpr int SHM_K = 16384, SHM_V = 16384;
constexpr int OFF_V = 0, OFF_K = 2 * SHM_V;
constexpr int MOFF_V = 0, MOFF_K = 3 * SHM_V;
constexpr int SMALL = LDSCTL_OFF + 1024;
constexpr int OFF_KBAR = SMALL, OFF_TB = SMALL + 4096, OFF_AL = OFF_TB + 512, OFF_LI = OFF_AL + 1024, OFF_FLAG = OFF_LI + 1024;
static_assert(OFF_FLAG + 64 <= LDS_BYTES, "small LDS tables");
#define KSWZ(row, colB) ((row) * 256 + ((colB) ^ (((row) & 7) << 4)))
__device__ __forceinline__ int v_st(int k, int c) { const int kk = (k & ~0xC) | ((k & 4) << 1) | ((k & 8) >> 1); return ((kk >> 3) * 4 + (c >> 5)) * 512 + ((kk & 7) * 32 + (c & 31)) * 2; }
__device__ __forceinline__ int v_rd_base(int lane) { return ((lane & 3) << 3) | (((lane >> 2) & 3) << 6) | (((lane >> 4) & 1) << 5) | (((lane >> 5) & 1) << 8); }
constexpr int v_rd_off(int d0, int ks, int half) { return d0 * 512 + ks * 4096 + half * 2048; }
__device__ __forceinline__ int crow(int r, int hi) { return (r & 3) + 8 * (r >> 2) + 4 * hi; }
__device__ __forceinline__ float swap_max(float x) { auto rr = __builtin_amdgcn_permlane32_swap(__float_as_uint(x), __float_as_uint(x), false, false); const unsigned u0 = rr[0], u1 = rr[1];
    return fmaxf(__uint_as_float(u0), __uint_as_float(u1)); }
__device__ __forceinline__ float swap_add(float x) { auto rr = __builtin_amdgcn_permlane32_swap(__float_as_uint(x), __float_as_uint(x), false, false); const unsigned u0 = rr[0], u1 = rr[1];
    return __uint_as_float(u0) + __uint_as_float(u1); }
__device__ __forceinline__ float swap_get(float x, int hi) { auto rr = __builtin_amdgcn_permlane32_swap(__float_as_uint(x), __float_as_uint(x), false, false); const unsigned u0 = rr[0], u1 = rr[1];
    return __uint_as_float(hi ? u0 : u1); }
#define ATT_PK4(P, B_, OUT) do { const unsigned a0 = pkbf(P[B_ + 0], P[B_ + 1]), a1 = pkbf(P[B_ + 2], P[B_ + 3]), b0 = pkbf(P[B_ + 4], P[B_ + 5]), b1 = pkbf(P[B_ + 6], P[B_ + 7]); \
        auto r0 = __builtin_amdgcn_permlane32_swap(a0, b0, false, false); auto r1 = __builtin_amdgcn_permlane32_swap(a1, b1, false, false); \
        v4u w_ = {r0[0], r1[0], r0[1], r1[1]}; OUT = __builtin_bit_cast(bf16x8, w_); } while (0)
__device__ __forceinline__ void qkt(f32x16& p0, f32x16& p1, const char* kt, int r32, int hi, const bf16x8* qr) {
    p0 = f32x16{}; p1 = f32x16{};
    const char* kb[4];
#pragma unroll
    for (int dd = 0; dd < 4; ++dd) kb[dd] = kt + KSWZ(r32, (dd * 16 + hi * 8) * 2);
#pragma unroll
    for (int d0 = 0; d0 < 8; ++d0) { const char* a = kb[d0 & 3] + (d0 >> 2) * 128;
        const bf16x8 b0 = *reinterpret_cast<const bf16x8*>(a);
        const bf16x8 b1 = *reinterpret_cast<const bf16x8*>(a + 32 * 256);
        p0 = __builtin_amdgcn_mfma_f32_32x32x16_bf16(b0, qr[d0], p0, 0, 0, 0);
        p1 = __builtin_amdgcn_mfma_f32_32x32x16_bf16(b1, qr[d0], p1, 0, 0, 0); }
}
__device__ __forceinline__ void pv_tile(f32x16* o, int vb, bf16x8 pa0, bf16x8 pa1, bf16x8 pa2, bf16x8 pa3) {
#define ATT_TRRD(dst, off) asm volatile("ds_read_b64_tr_b16 %0, %1 offset:%2" : "=&v"(dst) : "v"(vb), "i"(off) : "memory")
#define ATT_PV_D0(d0) do { s16x4 l0, l1, l2, l3, h0, h1, h2, h3; constexpr int b_ = v_rd_off(d0, 0, 0); \
        ATT_TRRD(l0, b_); ATT_TRRD(h0, b_ + 2048); ATT_TRRD(l1, b_ + 4096); ATT_TRRD(h1, b_ + 6144); ATT_TRRD(l2, b_ + 8192); ATT_TRRD(h2, b_ + 10240); ATT_TRRD(l3, b_ + 12288); ATT_TRRD(h3, b_ + 14336); \
        asm volatile("s_waitcnt lgkmcnt(0)" ::: "memory"); __builtin_amdgcn_sched_barrier(0); \
        o[d0] = __builtin_amdgcn_mfma_f32_32x32x16_bf16(pa0, (bf16x8){l0[0], l0[1], l0[2], l0[3], h0[0], h0[1], h0[2], h0[3]}, o[d0], 0, 0, 0); \
        o[d0] = __builtin_amdgcn_mfma_f32_32x32x16_bf16(pa1, (bf16x8){l1[0], l1[1], l1[2], l1[3], h1[0], h1[1], h1[2], h1[3]}, o[d0], 0, 0, 0); \
        o[d0] = __builtin_amdgcn_mfma_f32_32x32x16_bf16(pa2, (bf16x8){l2[0], l2[1], l2[2], l2[3], h2[0], h2[1], h2[2], h2[3]}, o[d0], 0, 0, 0); \
        o[d0] = __builtin_amdgcn_mfma_f32_32x32x16_bf16(pa3, (bf16x8){l3[0], l3[1], l3[2], l3[3], h3[0], h3[1], h3[2], h3[3]}, o[d0], 0, 0, 0); } while (0)
    ATT_PV_D0(0); ATT_PV_D0(1); ATT_PV_D0(2); ATT_PV_D0(3);
#undef ATT_PV_D0
#undef ATT_TRRD
}
struct Stage { bf16x8 k0, k1, v0, v1; };
__device__ __forceinline__ void stage_load(Stage& S, const bf16* Kg, const bf16* Vg, int kbase, int sr) {
    S.k0 = *(const GAS bf16x8*)(Kg + (size_t)(kbase + sr) * NPROJ); S.k1 = *(const GAS bf16x8*)(Kg + (size_t)(kbase + 32 + sr) * NPROJ);
    S.v0 = *(const GAS bf16x8*)(Vg + (size_t)(kbase + sr) * NPROJ); S.v1 = *(const GAS bf16x8*)(Vg + (size_t)(kbase + 32 + sr) * NPROJ);
}
__device__ __forceinline__ void stage_write(const Stage& S, char* lds, int bf, int kws, int vst0, int vst1) {
    *(bf16x8*)(lds + OFF_K + bf * SHM_K + kws) = S.k0; *(bf16x8*)(lds + OFF_K + bf * SHM_K + kws + 32 * 256) = S.k1;
    *(bf16x8*)(lds + OFF_V + bf * SHM_V + vst0) = S.v0; *(bf16x8*)(lds + OFF_V + bf * SHM_V + vst1) = S.v1;
}
__device__ __forceinline__ void mstage_write(const Stage& S, char* lds, int kbf, int vbf, int kws, int vst0, int vst1) {
    *(bf16x8*)(lds + MOFF_K + kbf * SHM_K + kws) = S.k0; *(bf16x8*)(lds + MOFF_K + kbf * SHM_K + kws + 32 * 256) = S.k1;
    *(bf16x8*)(lds + MOFF_V + vbf * SHM_V + vst0) = S.v0; *(bf16x8*)(lds + MOFF_V + vbf * SHM_V + vst1) = S.v1;
}
__device__ __forceinline__ void o_epilogue(const f32x16* o, char* lds, int wave, int lane, int r32, int hi, bool use_li, const bf16* grow  , int ldg, bf16* orow  , int ldo, float f8s = 0.f  ) {
    float* ost = (float*)(lds + wave * 16384);
    const float* lil = (const float*)(lds + OFF_LI) + wave * 32;
    v4u g[8];
#pragma unroll
    for (int i = 0; i < 8; ++i) { const int e = (i * 64 + lane) * 8, row = e >> 7, col = e & 127; g[i] = *(const GAS v4u*)(grow + (size_t)row * ldg + col); }
#pragma unroll
    for (int d0 = 0; d0 < 4; ++d0)
#pragma unroll
        for (int r = 0; r < 16; ++r) ost[crow(r, hi) * 128 + d0 * 32 + r32] = o[d0][r];
    asm volatile("s_waitcnt lgkmcnt(0)" ::: "memory");
#pragma unroll
    for (int i = 0; i < 8; ++i) { const int e = (i * 64 + lane) * 8, row = e >> 7, col = e & 127;
        const f32x4 a = *(const f32x4*)(ost + e), c = *(const f32x4*)(ost + e + 4); const float inv = use_li ? lil[row] : 1.f;
        v4u w; w.x = pkbf(a.x * inv * silu_f(bf_lo(g[i].x)), a.y * inv * silu_f(bf_hi(g[i].x))); w.y = pkbf(a.z * inv * silu_f(bf_lo(g[i].y)), a.w * inv * silu_f(bf_hi(g[i].y)));
        w.z = pkbf(c.x * inv * silu_f(bf_lo(g[i].z)), c.y * inv * silu_f(bf_hi(g[i].z))); w.w = pkbf(c.z * inv * silu_f(bf_lo(g[i].w)), c.w * inv * silu_f(bf_hi(g[i].w)));
        if (f8s != 0.f) { const float t_ = inv * f8s;
            const unsigned lo8 = pk8(a.x * t_ * silu_f(bf_lo(g[i].x)), a.y * t_ * silu_f(bf_hi(g[i].x)), a.z * t_ * silu_f(bf_lo(g[i].y)), a.w * t_ * silu_f(bf_hi(g[i].y)));
            const unsigned hi8 = pk8(c.x * t_ * silu_f(bf_lo(g[i].z)), c.y * t_ * silu_f(bf_hi(g[i].z)), c.z * t_ * silu_f(bf_lo(g[i].w)), c.w * t_ * silu_f(bf_hi(g[i].w)));
            *(GAS unsigned long long*)((unsigned char*)orow + (size_t)row * ldo + col) = (unsigned long long)lo8 | ((unsigned long long)hi8 << 32); continue; }
        *(GAS v4u*)(orow + (size_t)row * ldo + col) = w; }
}

__device__ __forceinline__ void moba_unit(char* lds, const bf16* P, const float* KBAR, const float* relb, bf16* MIX, int b, int h, int qb, int tid_in, int lane_in, int wave) {
    int tid = tid_in, lane = lane_in; asm volatile("" : "+v"(tid), "+v"(lane));
    const int r32 = lane & 31, hi = lane >> 5;
    const int qw0 = qb * MOBA_BLK + wave * 32;
    const size_t rowbase = (size_t)b * SEQ;
    float* kbl = (float*)(lds + OFF_KBAR); float* tbl = (float*)(lds + OFF_TB); float* all = (float*)(lds + OFF_AL) + wave * 32; float* lil = (float*)(lds + OFF_LI) + wave * 32;
    for (int i = tid; i < 1024; i += NWAVES * 64) kbl[i] = KBAR[(size_t)(b * 8 + (i >> 7)) * 2048 + h * HD + (i & 127)];
    if (tid < 128) tbl[tid] = relb[t5_bucket(tid) * MOBA_H + h] * LOG2E;
    bf16x8 qr[8];
    { const bf16* qp = P + (rowbase + qw0 + r32) * NPROJ + L0_Q + h * HD + hi * 8;
#pragma unroll
      for (int d0 = 0; d0 < 8; ++d0) qr[d0] = *(const GAS bf16x8*)(qp + d0 * 16); }
    const int sr = tid >> 4, sc = (tid & 15) * 8, kws = KSWZ(sr, sc * 2), vst0 = v_st(sr, sc), vst1 = v_st(32 + sr, sc);
    const bf16* Kg = P + rowbase * NPROJ + L0_K + h * HD + sc; const bf16* Vg = P + rowbase * NPROJ + L0_V + h * HD + sc;
    const int NT = 4 * (qb + 1);
    Stage S; stage_load(S, Kg, Vg, 0, sr);
    __syncthreads();
    unsigned selmask = 0;
    { float gate[7];
#pragma unroll
      for (int n = 0; n < 7; ++n) { float g = 0.f;
          if (n < qb) {
#pragma unroll
              for (int d0 = 0; d0 < 8; ++d0) { const f32x4 ka = *(const f32x4*)(kbl + n * 128 + d0 * 16 + hi * 8), kc = *(const f32x4*)(kbl + n * 128 + d0 * 16 + hi * 8 + 4);
                  const v4u qw = __builtin_bit_cast(v4u, qr[d0]);
                  g += bf_lo(qw.x) * ka.x + bf_hi(qw.x) * ka.y + bf_lo(qw.y) * ka.z + bf_hi(qw.y) * ka.w + bf_lo(qw.z) * kc.x + bf_hi(qw.z) * kc.y + bf_lo(qw.w) * kc.z + bf_hi(qw.w) * kc.w; }
              g = swap_add(g); }
          gate[n] = g; }
#pragma unroll
      for (int n = 0; n < 7; ++n) { int rank = 0;
#pragma unroll
          for (int n2 = 0; n2 < 7; ++n2) rank += (n2 < qb && (gate[n2] > gate[n] || (gate[n2] == gate[n] && n2 < n))) ? 1 : 0;
          if (n < qb && (qb <= 3 || rank < 3)) selmask |= 1u << n; } }
    asm volatile("s_waitcnt vmcnt(0)" ::: "memory"); mstage_write(S, lds, 0, 0, kws, vst0, vst1);
    __syncthreads();
    const float C2 = 0.08838834764831845f * LOG2E, NEG = -__builtin_inff();
    const float c31 = tbl[127];
    float m_run = -1e30f, l_run = 0.f; f32x16 o[4] = {};
    const int vb0 = (int)(uintptr_t)(lds + MOFF_V) + v_rd_base(lane);
    const bool late = wave >= 4; bool pend = false; int pend_vb = 0; bf16x8 pa0, pa1, pa2, pa3;
    int vbuf = 0;
#if defined(DBG_TLOOP_MOBA)
    unsigned long long tl0_ = 0; if (tid == 0) tl0_ = __builtin_amdgcn_s_memrealtime();
#endif
#if defined(DBG_SEG)
    unsigned long long sg_[5] = {0, 0, 0, 0, 0}; unsigned long long st_ = __builtin_amdgcn_s_memtime();
#define SEG(k) do { const unsigned long long n_ = __builtin_amdgcn_s_memtime(); sg_[k] += n_ - st_; st_ = n_; } while (0)
#else
#define SEG(k) do {} while (0)
#endif
    for (int t = 0; t < NT; ++t) {
        if (t + 1 < NT) stage_load(S, Kg, Vg, (t + 1) * 64, sr);
        const int n = t >> 2, kb = t * 64, bf = t & 1;
        SEG(4);
        if (late && pend) { pv_tile(o, pend_vb, pa0, pa1, pa2, pa3); pend = false; }
        const bool rowsel = n < qb ? ((selmask >> n) & 1u) != 0u : true;
        const bool act = n < qb ? (__ballot(rowsel) != 0ull) : (kb <= qw0 + 31);
        if (act) {
            f32x16 p0, p1;
            qkt(p0, p1, lds + MOFF_K + bf * SHM_K, r32, hi, qr);
            asm volatile("" : "+v"(p0), "+v"(p1)); SEG(0);
            const int dq = qw0 + r32 - kb - 4 * hi;
            if (qw0 - (kb + 63) < 113) {
#pragma unroll
                for (int g = 0; g < 4; ++g) {
#pragma unroll
                    for (int i = 0; i < 4; ++i) { const int r = 4 * g + i, c = i + 8 * g; const int d0_ = dq - c, d1_ = dq - c - 32;
                        const float b0 = tbl[d0_ < 0 ? 0 : (d0_ > 127 ? 127 : d0_)], b1 = tbl[d1_ < 0 ? 0 : (d1_ > 127 ? 127 : d1_)];
                        const float s0 = fmaf(p0[r], C2, b0), s1 = fmaf(p1[r], C2, b1);
                        p0[r] = (d0_ >= 0 && rowsel) ? s0 : NEG; p1[r] = (d1_ >= 0 && rowsel) ? s1 : NEG; }
                    __builtin_amdgcn_sched_barrier(0); }
            } else {
#pragma unroll
                for (int r = 0; r < 16; ++r) { p0[r] = rowsel ? fmaf(p0[r], C2, c31) : NEG; p1[r] = rowsel ? fmaf(p1[r], C2, c31) : NEG; }
            }
            float pmax = p0[0];
#pragma unroll
            for (int r = 1; r < 16; ++r) pmax = fmaxf(pmax, p0[r]);
#pragma unroll
            for (int r = 0; r < 16; ++r) pmax = fmaxf(pmax, p1[r]);
            pmax = swap_max(pmax);
            const float mn = fmaxf(m_run, pmax), alpha = __builtin_amdgcn_exp2f(m_run - mn); m_run = mn;
            float ps = 0.f;
#pragma unroll
            for (int r = 0; r < 16; ++r) { p0[r] = __builtin_amdgcn_exp2f(p0[r] - mn); p1[r] = __builtin_amdgcn_exp2f(p1[r] - mn); ps += p0[r] + p1[r]; }
            ps = swap_add(ps);
            l_run = l_run * alpha + ps;
            if (__any(alpha < 1.f)) {
                if (hi == 0) all[r32] = alpha;
                asm volatile("s_waitcnt lgkmcnt(0)" ::: "memory");
#pragma unroll
                for (int g = 0; g < 4; ++g) { const f32x4 av = *(const f32x4*)(all + 8 * g + 4 * hi);
#pragma unroll
                    for (int d0 = 0; d0 < 4; ++d0) { o[d0][4 * g + 0] *= av.x; o[d0][4 * g + 1] *= av.y; o[d0][4 * g + 2] *= av.z; o[d0][4 * g + 3] *= av.w; } }
            }
            ATT_PK4(p0, 0, pa0); ATT_PK4(p0, 8, pa1); ATT_PK4(p1, 0, pa2); ATT_PK4(p1, 8, pa3);
            asm volatile("" : "+v"(pa0), "+v"(pa1), "+v"(pa2), "+v"(pa3)); SEG(1);
            if (late) { pend = true; pend_vb = vb0 + vbuf * SHM_V; } else pv_tile(o, vb0 + vbuf * SHM_V, pa0, pa1, pa2, pa3);
        }
        asm volatile("" : "+v"(o[0]), "+v"(o[1]), "+v"(o[2]), "+v"(o[3])); SEG(2);
        const int vnext = vbuf == 2 ? 0 : vbuf + 1;
        if (t + 1 < NT) { asm volatile("s_waitcnt vmcnt(0)" ::: "memory"); mstage_write(S, lds, (t + 1) & 1, vnext, kws, vst0, vst1); }
        vbuf = vnext;
        __syncthreads();
        SEG(3);
    }
#if defined(DBG_SEG)
    if (blockIdx.x == 0 && tid == 0) { volatile unsigned* M_ = (volatile unsigned*)(lds + MISC_OFF); const unsigned long long a_ = (((unsigned long long)M_[17] << 32) | M_[16]) + sg_[DBG_SEG]; M_[16] = (unsigned)a_; M_[17] = (unsigned)(a_ >> 32); }
#endif
    if (late && pend) pv_tile(o, pend_vb, pa0, pa1, pa2, pa3);
#if defined(DBG_TLOOP_MOBA)
    if (tid == 0) { volatile unsigned* M_ = (volatile unsigned*)(lds + MISC_OFF); const unsigned long long d_ = __builtin_amdgcn_s_memrealtime() - tl0_; const unsigned long long a_ = (((unsigned long long)M_[17] << 32) | M_[16]) + d_; M_[16] = (unsigned)a_; M_[17] = (unsigned)(a_ >> 32); }
#endif
    __syncthreads();
    if (hi == 0) lil[r32] = 1.f / l_run;
    o_epilogue(o, lds, wave, lane, r32, hi, true, P + (rowbase + qw0) * NPROJ + L0_GB + h * HD, NPROJ, MIX + (rowbase + qw0) * DM + CONVW + h * HD, DM);
    __syncthreads();
}
__device__ __forceinline__ void moba_unit_dma(char* lds, const bf16* P, const float* KBAR, const float* relb, bf16* MIX, int b, int h, int qb, int tid_in, int lane_in, int wave) {
    int tid = tid_in, lane = lane_in; asm volatile("" : "+v"(tid), "+v"(lane));
    const int r32 = lane & 31, hi = lane >> 5;
    const int qw0 = qb * MOBA_BLK + wave * 32;
    const size_t rowbase = (size_t)b * SEQ;
    float* kbl = (float*)(lds + OFF_KBAR); float* tbl = (float*)(lds + OFF_TB); float* all = (float*)(lds + OFF_AL) + wave * 32; float* lil = (float*)(lds + OFF_LI) + wave * 32;
    for (int i = tid; i < 1024; i += NWAVES * 64) kbl[i] = KBAR[(size_t)(b * 8 + (i >> 7)) * 2048 + h * HD + (i & 127)];
    if (tid < 128) tbl[tid] = relb[t5_bucket(tid) * MOBA_H + h] * LOG2E;
    bf16x8 qr[8];
    { const bf16* qp = P + (rowbase + qw0 + r32) * NPROJ + L0_Q + h * HD + hi * 8;
#pragma unroll
      for (int d0 = 0; d0 < 8; ++d0) qr[d0] = *(const GAS bf16x8*)(qp + d0 * 16); }
    unsigned gofK[2], gofV[2];
#pragma unroll
    for (int i = 0; i < 2; ++i) { const int q = 2 * wave + i;
        { const int row = 4 * q + (lane >> 4), colB = ((lane & 15) * 16) ^ ((row & 7) << 4); gofK[i] = (unsigned)(row * NPROJ + (colB >> 1)); }
        { const int sub = 2 * q + (lane >> 5), kk = (sub >> 2) * 8 + ((lane & 31) >> 2), c = (sub & 3) * 32 + (lane & 3) * 8, k = (kk & ~0xC) | ((kk & 4) << 1) | ((kk & 8) >> 1); gofV[i] = (unsigned)(k * NPROJ + c); } }
    const bf16* Kg = P + rowbase * NPROJ + L0_K + h * HD; const bf16* Vg = P + rowbase * NPROJ + L0_V + h * HD;
#define MDMA(t_, buf_) do { _Pragma("unroll") for (int i_ = 0; i_ < 2; ++i_) { \
        __builtin_amdgcn_global_load_lds((const unsigned*)(Kg + (size_t)(t_) * 64 * NPROJ + gofK[i_]), (__attribute__((address_space(3))) unsigned*)(lds + MOFF_K + (buf_) * SHM_K + (2 * wave + i_) * 1024), 16, 0, 0); \
        __builtin_amdgcn_global_load_lds((const unsigned*)(Vg + (size_t)(t_) * 64 * NPROJ + gofV[i_]), (__attribute__((address_space(3))) unsigned*)(lds + MOFF_V + (buf_) * SHM_V + (2 * wave + i_) * 1024), 16, 0, 0); } } while (0)
    const int NT = 4 * (qb + 1);
    __syncthreads();
    MDMA(0, 0); MDMA(1, 1);
    unsigned selmask = 0;
    { float gate[7];
#pragma unroll
      for (int n = 0; n < 7; ++n) { float g = 0.f;
          if (n < qb) {
#pragma unroll
              for (int d0 = 0; d0 < 8; ++d0) { const f32x4 ka = *(const f32x4*)(kbl + n * 128 + d0 * 16 + hi * 8), kc = *(const f32x4*)(kbl + n * 128 + d0 * 16 + hi * 8 + 4);
                  const v4u qw = __builtin_bit_cast(v4u, qr[d0]);
                  g += bf_lo(qw.x) * ka.x + bf_hi(qw.x) * ka.y + bf_lo(qw.y) * ka.z + bf_hi(qw.y) * ka.w + bf_lo(qw.z) * kc.x + bf_hi(qw.z) * kc.y + bf_lo(qw.w) * kc.z + bf_hi(qw.w) * kc.w; }
              g = swap_add(g); }
          gate[n] = g; }
#pragma unroll
      for (int n = 0; n < 7; ++n) { int rank = 0;
#pragma unroll
          for (int n2 = 0; n2 < 7; ++n2) rank += (n2 < qb && (gate[n2] > gate[n] || (gate[n2] == gate[n] && n2 < n))) ? 1 : 0;
          if (n < qb && (qb <= 3 || rank < 3)) selmask |= 1u << n; } }
    asm volatile("s_waitcnt vmcnt(4)" ::: "memory"); __builtin_amdgcn_s_barrier(); asm volatile("" ::: "memory");
    const float C2 = 0.08838834764831845f * LOG2E, NEG = -__builtin_inff();
    const float c31 = tbl[127];
    float m_run = -1e30f, l_run = 0.f; f32x16 o[4] = {};
    const int vb0 = (int)(uintptr_t)(lds + MOFF_V) + v_rd_base(lane);
    bf16x8 pa0, pa1, pa2, pa3;
    int rb = 0;
#if defined(DBG_TLOOP_MOBA)
    unsigned long long tl0_ = 0; if (tid == 0) tl0_ = __builtin_amdgcn_s_memrealtime();
#endif
#if defined(DBG_SEG)
    unsigned long long sg_[5] = {0, 0, 0, 0, 0}; unsigned long long st_ = __builtin_amdgcn_s_memtime();
#define SEG(k) do { const unsigned long long n_ = __builtin_amdgcn_s_memtime(); sg_[k] += n_ - st_; st_ = n_; } while (0)
#else
#define SEG(k) do {} while (0)
#endif
    for (int t = 0; t < NT; ++t) {
        { const int nb2 = rb == 0 ? 2 : rb - 1; if (t + 2 < NT) MDMA(t + 2, nb2); }
        const int n = t >> 2, kb = t * 64;
        SEG(4);
        const bool rowsel = n < qb ? ((selmask >> n) & 1u) != 0u : true;
        const bool act = n < qb ? (__ballot(rowsel) != 0ull) : (kb <= qw0 + 31);
        if (act) {
            f32x16 p0, p1;
            qkt(p0, p1, lds + MOFF_K + rb * SHM_K, r32, hi, qr);
            asm volatile("" : "+v"(p0), "+v"(p1)); SEG(0);
            const int dq = qw0 + r32 - kb - 4 * hi;
            if (qw0 - (kb + 63) < 113) {
#pragma unroll
                for (int g = 0; g < 4; ++g) {
#pragma unroll
                    for (int i = 0; i < 4; ++i) { const int r = 4 * g + i, c = i + 8 * g; const int d0_ = dq - c, d1_ = dq - c - 32;
                        const float b0 = tbl[d0_ < 0 ? 0 : (d0_ > 127 ? 127 : d0_)], b1 = tbl[d1_ < 0 ? 0 : (d1_ > 127 ? 127 : d1_)];
                        const float s0 = fmaf(p0[r], C2, b0), s1 = fmaf(p1[r], C2, b1);
                        p0[r] = (d0_ >= 0 && rowsel) ? s0 : NEG; p1[r] = (d1_ >= 0 && rowsel) ? s1 : NEG; }
                    __builtin_amdgcn_sched_barrier(0); }
            } else {
#pragma unroll
                for (int r = 0; r < 16; ++r) { p0[r] = rowsel ? fmaf(p0[r], C2, c31) : NEG; p1[r] = rowsel ? fmaf(p1[r], C2, c31) : NEG; }
            }
            float pmax = p0[0];
#pragma unroll
            for (int r = 1; r < 16; ++r) pmax = fmaxf(pmax, p0[r]);
#pragma unroll
            for (int r = 0; r < 16; ++r) pmax = fmaxf(pmax, p1[r]);
            pmax = swap_max(pmax);
            const float mn = fmaxf(m_run, pmax), alpha = __builtin_amdgcn_exp2f(m_run - mn); m_run = mn;
            float ps = 0.f;
#pragma unroll
            for (int r = 0; r < 16; ++r) { p0[r] = __builtin_amdgcn_exp2f(p0[r] - mn); p1[r] = __builtin_amdgcn_exp2f(p1[r] - mn); ps += p0[r] + p1[r]; }
            ps = swap_add(ps);
            l_run = l_run * alpha + ps;
            if (__any(alpha < 1.f)) {
                if (hi == 0) all[r32] = alpha;
                asm volatile("s_waitcnt lgkmcnt(0)" ::: "memory");
#pragma unroll
                for (int g = 0; g < 4; ++g) { const f32x4 av = *(const f32x4*)(all + 8 * g + 4 * hi);
#pragma unroll
                    for (int d0 = 0; d0 < 4; ++d0) { o[d0][4 * g + 0] *= av.x; o[d0][4 * g + 1] *= av.y; o[d0][4 * g + 2] *= av.z; o[d0][4 * g + 3] *= av.w; } }
            }
            ATT_PK4(p0, 0, pa0); ATT_PK4(p0, 8, pa1); ATT_PK4(p1, 0, pa2); ATT_PK4(p1, 8, pa3);
            asm volatile("" : "+v"(pa0), "+v"(pa1), "+v"(pa2), "+v"(pa3)); SEG(1);
            pv_tile(o, vb0 + rb * SHM_V, pa0, pa1, pa2, pa3);
        }
        asm volatile("" : "+v"(o[0]), "+v"(o[1]), "+v"(o[2]), "+v"(o[3])); SEG(2);
        rb = rb == 2 ? 0 : rb + 1;
        if (t + 2 < NT) asm volatile("s_waitcnt vmcnt(4) lgkmcnt(0)" ::: "memory"); else asm volatile("s_waitcnt vmcnt(0) lgkmcnt(0)" ::: "memory");
        __builtin_amdgcn_s_barrier(); asm volatile("" ::: "memory");
        SEG(3);
    }
#if defined(DBG_SEG)
    if (blockIdx.x == 0 && tid == 0) { volatile unsigned* M_ = (volatile unsigned*)(lds + MISC_OFF); const unsigned long long a_ = (((unsigned long long)M_[17] << 32) | M_[16]) + sg_[DBG_SEG]; M_[16] = (unsigned)a_; M_[17] = (unsigned)(a_ >> 32); }
#endif
#if defined(DBG_TLOOP_MOBA)
    if (tid == 0) { volatile unsigned* M_ = (volatile unsigned*)(lds + MISC_OFF); const unsigned long long d_ = __builtin_amdgcn_s_memrealtime() - tl0_; const unsigned long long a_ = (((unsigned long long)M_[17] << 32) | M_[16]) + d_; M_[16] = (unsigned)a_; M_[17] = (unsigned)(a_ >> 32); }
#endif
    __syncthreads();
    if (hi == 0) lil[r32] = 1.f / l_run;
    if (FP8_OP0) o_epilogue(o, lds, wave, lane, r32, hi, true, P + (rowbase + qw0) * NPROJ + L0_GB + h * HD, NPROJ, (bf16*)((unsigned char*)MIX + MIX8_OFF + (rowbase + qw0) * CONVW + h * HD), CONVW, MO8_SCALE);
    else o_epilogue(o, lds, wave, lane, r32, hi, true, P + (rowbase + qw0) * NPROJ + L0_GB + h * HD, NPROJ, MIX + (rowbase + qw0) * DM + CONVW + h * HD, DM);
    __syncthreads();
}
#undef MDMA

__device__ __forceinline__ void moba_unit_dma2(char* lds, const bf16* P, const float* KBAR, const float* relb, bf16* MIX, int b, int h, int qb, int tid_in, int lane_in, int wave) {
    int tid = tid_in, lane = lane_in; asm volatile("" : "+v"(tid), "+v"(lane));
    const int r32 = lane & 31, hi = lane >> 5;
    const int qw0 = qb * MOBA_BLK + wave * 32;
    const size_t rowbase = (size_t)b * SEQ;
    constexpr int RV = 0, RK = 4 * SHM_V;
    float* kbl = (float*)(lds + OFF_KBAR); float* tbl = (float*)(lds + OFF_TB); float* all = (float*)(lds + OFF_AL) + wave * 32; float* lil = (float*)(lds + OFF_LI) + wave * 32;
    for (int i = tid; i < 1024; i += NWAVES * 64) kbl[i] = KBAR[(size_t)(b * 8 + (i >> 7)) * 2048 + h * HD + (i & 127)];
    if (tid < 128) tbl[tid] = relb[t5_bucket(tid) * MOBA_H + h] * LOG2E;
    bf16x8 qr[8];
    { const bf16* qp = P + (rowbase + qw0 + r32) * NPROJ + L0_Q + h * HD + hi * 8;
#pragma unroll
      for (int d0 = 0; d0 < 8; ++d0) qr[d0] = *(const GAS bf16x8*)(qp + d0 * 16); }
    unsigned gofK[2], gofV[2];
#pragma unroll
    for (int i = 0; i < 2; ++i) { const int q = 2 * wave + i;
        { const int row = 4 * q + (lane >> 4), colB = ((lane & 15) * 16) ^ ((row & 7) << 4); gofK[i] = (unsigned)(row * NPROJ + (colB >> 1)); }
        { const int sub = 2 * q + (lane >> 5), kk = (sub >> 2) * 8 + ((lane & 31) >> 2), c = (sub & 3) * 32 + (lane & 3) * 8, k = (kk & ~0xC) | ((kk & 4) << 1) | ((kk & 8) >> 1); gofV[i] = (unsigned)(k * NPROJ + c); } }
    const bf16* Kg = P + rowbase * NPROJ + L0_K + h * HD; const bf16* Vg = P + rowbase * NPROJ + L0_V + h * HD;
#define M2DMA(t_, slot_) do { _Pragma("unroll") for (int i_ = 0; i_ < 2; ++i_) { \
        __builtin_amdgcn_global_load_lds((const unsigned*)(Kg + (size_t)(t_) * 64 * NPROJ + gofK[i_]), (__attribute__((address_space(3))) unsigned*)(lds + RK + (slot_) * SHM_K + (2 * wave + i_) * 1024), 16, 0, 0); \
        __builtin_amdgcn_global_load_lds((const unsigned*)(Vg + (size_t)(t_) * 64 * NPROJ + gofV[i_]), (__attribute__((address_space(3))) unsigned*)(lds + RV + (slot_) * SHM_V + (2 * wave + i_) * 1024), 16, 0, 0); } } while (0)
    const int NT = 4 * (qb + 1);
    __syncthreads();
    M2DMA(0, 0); M2DMA(1, 1); M2DMA(2, 2);
    unsigned selmask = 0;
    { float gate[7];
#pragma unroll
      for (int n = 0; n < 7; ++n) { float g = 0.f;
          if (n < qb) {
#pragma unroll
              for (int d0 = 0; d0 < 8; ++d0) { const f32x4 ka = *(const f32x4*)(kbl + n * 128 + d0 * 16 + hi * 8), kc = *(const f32x4*)(kbl + n * 128 + d0 * 16 + hi * 8 + 4);
                  const v4u qw = __builtin_bit_cast(v4u, qr[d0]);
                  g += bf_lo(qw.x) * ka.x + bf_hi(qw.x) * ka.y + bf_lo(qw.y) * ka.z + bf_hi(qw.y) * ka.w + bf_lo(qw.z) * kc.x + bf_hi(qw.z) * kc.y + bf_lo(qw.w) * kc.z + bf_hi(qw.w) * kc.w; }
              g = swap_add(g); }
          gate[n] = g; }
#pragma unroll
      for (int n = 0; n < 7; ++n) { int rank = 0;
#pragma unroll
          for (int n2 = 0; n2 < 7; ++n2) rank += (n2 < qb && (gate[n2] > gate[n] || (gate[n2] == gate[n] && n2 < n))) ? 1 : 0;
          if (n < qb && (qb <= 3 || rank < 3)) selmask |= 1u << n; } }
    asm volatile("s_waitcnt vmcnt(4)" ::: "memory"); __builtin_amdgcn_s_barrier(); asm volatile("" ::: "memory");
    const float C2 = 0.08838834764831845f * LOG2E, NEG = -__builtin_inff();
    const float c31 = tbl[127];
    float m_run = -1e30f, l_run = 0.f; f32x16 o[4] = {};
    const int vb0 = (int)(uintptr_t)(lds + RV) + v_rd_base(lane);
#define M2ACT(t_) (((t_) >> 2) < qb ? (__ballot(((selmask >> ((t_) >> 2)) & 1u) != 0u) != 0ull) : ((t_) * 64 <= qw0 + 31))
    f32x16 p0, p1;
    if (M2ACT(0)) qkt(p0, p1, lds + RK, r32, hi, qr);
    for (int t = 0; t < NT; ++t) {
        if (t + 3 < NT) M2DMA(t + 3, (t + 3) & 3);
        const int n = t >> 2, kb = t * 64, slot = t & 3;
        const bool rowsel = n < qb ? ((selmask >> n) & 1u) != 0u : true;
        const bool act = M2ACT(t), actn = (t + 1 < NT) && M2ACT(t + 1);
        f32x16 q0, q1;
        if (act) {
            const int dq = qw0 + r32 - kb - 4 * hi;
            if (qw0 - (kb + 63) < 113) {
#pragma unroll
                for (int g = 0; g < 4; ++g) {
#pragma unroll
                    for (int i = 0; i < 4; ++i) { const int r = 4 * g + i, c = i + 8 * g; const int d0_ = dq - c, d1_ = dq - c - 32;
                        const float b0 = tbl[d0_ < 0 ? 0 : (d0_ > 127 ? 127 : d0_)], b1 = tbl[d1_ < 0 ? 0 : (d1_ > 127 ? 127 : d1_)];
                        const float s0 = fmaf(p0[r], C2, b0), s1 = fmaf(p1[r], C2, b1);
                        p0[r] = (d0_ >= 0 && rowsel) ? s0 : NEG; p1[r] = (d1_ >= 0 && rowsel) ? s1 : NEG; }
                    __builtin_amdgcn_sched_barrier(0); }
            } else {
#pragma unroll
                for (int r = 0; r < 16; ++r) { p0[r] = rowsel ? fmaf(p0[r], C2, c31) : NEG; p1[r] = rowsel ? fmaf(p1[r], C2, c31) : NEG; }
            }
            float pmax = p0[0];
#pragma unroll
            for (int r = 1; r < 16; ++r) pmax = fmaxf(pmax, p0[r]);
#pragma unroll
            for (int r = 0; r < 16; ++r) pmax = fmaxf(pmax, p1[r]);
            pmax = swap_max(pmax);
            const float mn = fmaxf(m_run, pmax), alpha = __builtin_amdgcn_exp2f(m_run - mn); m_run = mn;
            bf16x8 pa0, pa1, pa2, pa3; float ps = 0.f;
#define M2TAIL() do { _Pragma("unroll") for (int r = 0; r < 16; ++r) { p0[r] = __builtin_amdgcn_exp2f(p0[r] - mn); p1[r] = __builtin_amdgcn_exp2f(p1[r] - mn); ps += p0[r] + p1[r]; } \
                ATT_PK4(p0, 0, pa0); ATT_PK4(p0, 8, pa1); ATT_PK4(p1, 0, pa2); ATT_PK4(p1, 8, pa3); } while (0)
            if (actn) { qkt(q0, q1, lds + RK + ((t + 1) & 3) * SHM_K, r32, hi, qr); M2TAIL();
}
            else M2TAIL();
#undef M2TAIL
            ps = swap_add(ps);
            l_run = l_run * alpha + ps;
            if (__any(alpha < 1.f)) {
                if (hi == 0) all[r32] = alpha;
                asm volatile("s_waitcnt lgkmcnt(0)" ::: "memory");
#pragma unroll
                for (int g = 0; g < 4; ++g) { const f32x4 av = *(const f32x4*)(all + 8 * g + 4 * hi);
#pragma unroll
                    for (int d0 = 0; d0 < 4; ++d0) { o[d0][4 * g + 0] *= av.x; o[d0][4 * g + 1] *= av.y; o[d0][4 * g + 2] *= av.z; o[d0][4 * g + 3] *= av.w; } }
            }
            pv_tile(o, vb0 + slot * SHM_V, pa0, pa1, pa2, pa3);
        } else if (actn) qkt(q0, q1, lds + RK + ((t + 1) & 3) * SHM_K, r32, hi, qr);
        p0 = q0; p1 = q1;
        if (t + 3 < NT) asm volatile("s_waitcnt vmcnt(4) lgkmcnt(0)" ::: "memory"); else asm volatile("s_waitcnt vmcnt(0) lgkmcnt(0)" ::: "memory");
        __builtin_amdgcn_s_barrier(); asm volatile("" ::: "memory");
    }
#undef M2ACT
#undef M2DMA
    __syncthreads();
    if (hi == 0) lil[r32] = 1.f / l_run;
    o_epilogue(o, lds, wave, lane, r32, hi, true, P + (rowbase + qw0) * NPROJ + L0_GB + h * HD, NPROJ, MIX + (rowbase + qw0) * DM + CONVW + h * HD, DM);
    __syncthreads();
}
__device__ __forceinline__ void moba_phase(Frame& F, const bf16* P, const float* KBAR, const float* relb, bf16* MIX, int conv_slot = -1, const float* cw = nullptr, unsigned char* wsl = nullptr) {
    PH_IDS();
    char* lds = (char*)(F.lds + RING_OFF);
    int slot = 0;
    for (int item = vcu; item < BATCH * MOBA_H * 4; item += G, ++slot) {
        if (slot == conv_slot) { __syncthreads(); ::conv_phase(F, P, MIX, cw); if (wsl) ::p_convert_late(F, wsl, 0); __syncthreads(); }
        const int pr = item & 3, bh = item >> 2, b = bh >> 4, h = bh & 15;
#pragma unroll 1
        for (int k = 0; k < 2; ++k) { const int qb_ = k ? 7 - pr : pr; if ((MOBA_QBMASK >> qb_) & 1) { if (MOBA_DMA == 2) moba_unit_dma2(lds, P, KBAR, relb, MIX, b, h, qb_, tid, lane, wave); else if (MOBA_DMA) moba_unit_dma(lds, P, KBAR, relb, MIX, b, h, qb_, tid, lane, wave); else moba_unit(lds, P, KBAR, relb, MIX, b, h, qb_, tid, lane, wave); } }
    }
    if (conv_slot >= slot) { __syncthreads(); ::conv_phase(F, P, MIX, cw); if (wsl) ::p_convert_late(F, wsl, 0); __syncthreads(); }
}

#ifndef SB_DUAL
#define SB_DUAL 3
#endif
__device__ __forceinline__ void sb_unit(char* lds, const bf16* P, bf16* MIX, int b, int h, int qb, int tid_in, int lane_in, int wave) {
    int tid = tid_in, lane = lane_in; asm volatile("" : "+v"(tid), "+v"(lane));
    const int r32 = lane & 31, hi = lane >> 5;
    const int qw0 = qb * 256 + wave * 32;
    const size_t rowbase = (size_t)b * SEQ;
    unsigned* flags = (unsigned*)(lds + OFF_FLAG);
    if (tid < 16) flags[tid] = 0u;
    bf16x8 qr[8];
    { const bf16* qp = P + (rowbase + qw0 + r32) * NPROJ + L1_Q + h * HD + hi * 8;
#pragma unroll
      for (int d0 = 0; d0 < 8; ++d0) qr[d0] = *(const GAS bf16x8*)(qp + d0 * 16); }
    const int sr = tid >> 4, sc = (tid & 15) * 8, kws = KSWZ(sr, sc * 2), vst0 = v_st(sr, sc), vst1 = v_st(32 + sr, sc);
    const bf16* Kg = P + rowbase * NPROJ + L1_K + h * HD + sc; const bf16* Vg = P + rowbase * NPROJ + L1_V + h * HD + sc;
    const int t_hi = 4 * qb + 3;
    Stage S; stage_load(S, Kg, Vg, t_hi * 64, sr);
    asm volatile("s_waitcnt vmcnt(0)" ::: "memory"); stage_write(S, lds, 0, kws, vst0, vst1);
    __syncthreads();
    const float C2 = 0.08838834764831845f * LOG2E, NEG = -__builtin_inff();
    float R = 0.f; f32x16 o[4] = {}; bool done_w = false;
    const int vb0 = (int)(uintptr_t)(lds + OFF_V) + v_rd_base(lane);
    for (int it = 0; it <= t_hi; ++it) {
        const int t = t_hi - it, kb = t * 64, bf = it & 1;
        if (t > 0) stage_load(S, Kg, Vg, (t - 1) * 64, sr);
        const bool act = !done_w && (kb < qw0 + 31);
        if (act) {
            f32x16 p0, p1, l0, l1;
            qkt(p0, p1, lds + OFF_K + bf * SHM_K, r32, hi, qr);
            const int dq = qw0 + r32 - kb - 4 * hi;
            const bool diag = kb + 63 >= qw0;
#pragma unroll
            for (int r = 0; r < 16; ++r) { const int c = (r & 3) + 8 * (r >> 2);
                { const float z = p0[r] * C2, e = __builtin_amdgcn_exp2f(-fabsf(z)), sp = fmaxf(z, 0.f) + __builtin_amdgcn_logf(1.f + e); const bool ok = !diag || (dq - c > 0);
                  l0[r] = ok ? -sp : 0.f; p0[r] = ok ? z - sp : NEG; }
                { const float z = p1[r] * C2, e = __builtin_amdgcn_exp2f(-fabsf(z)), sp = fmaxf(z, 0.f) + __builtin_amdgcn_logf(1.f + e); const bool ok = !diag || (dq - c - 32 > 0);
                  l1[r] = ok ? -sp : 0.f; p1[r] = ok ? z - sp : NEG; } }
            float T0[4], T1[4], Q0[4], Q1[4];
#pragma unroll
            for (int g = 0; g < 4; ++g) { T0[g] = (l0[4 * g] + l0[4 * g + 1]) + (l0[4 * g + 2] + l0[4 * g + 3]); T1[g] = (l1[4 * g] + l1[4 * g + 1]) + (l1[4 * g + 2] + l1[4 * g + 3]); }
#pragma unroll
            for (int g = 0; g < 4; ++g) { Q0[g] = swap_get(T0[g], hi); Q1[g] = swap_get(T1[g], hi); }
            float SO0[4], SO1[4]; float run = 0.f;
#pragma unroll
            for (int g = 3; g >= 0; --g) { SO1[g] = run; run += T1[g] + Q1[g]; }
#pragma unroll
            for (int g = 3; g >= 0; --g) { SO0[g] = run; run += T0[g] + Q0[g]; }
#pragma unroll
            for (int g = 0; g < 4; ++g) {
                const float g0 = R + SO0[g] + (hi == 0 ? Q0[g] : 0.f), g1 = R + SO1[g] + (hi == 0 ? Q1[g] : 0.f);
                const float a32 = l0[4 * g + 3] + l0[4 * g + 2], c32 = l1[4 * g + 3] + l1[4 * g + 2];
                p0[4 * g + 3] = __builtin_amdgcn_exp2f(p0[4 * g + 3] + g0); p0[4 * g + 2] = __builtin_amdgcn_exp2f(p0[4 * g + 2] + (g0 + l0[4 * g + 3]));
                p0[4 * g + 1] = __builtin_amdgcn_exp2f(p0[4 * g + 1] + (g0 + a32)); p0[4 * g] = __builtin_amdgcn_exp2f(p0[4 * g] + (g0 + (a32 + l0[4 * g + 1])));
                p1[4 * g + 3] = __builtin_amdgcn_exp2f(p1[4 * g + 3] + g1); p1[4 * g + 2] = __builtin_amdgcn_exp2f(p1[4 * g + 2] + (g1 + l1[4 * g + 3]));
                p1[4 * g + 1] = __builtin_amdgcn_exp2f(p1[4 * g + 1] + (g1 + c32)); p1[4 * g] = __builtin_amdgcn_exp2f(p1[4 * g] + (g1 + (c32 + l1[4 * g + 1])));
            }
            R += run;
            bf16x8 pa0, pa1, pa2, pa3;
            ATT_PK4(p0, 0, pa0); ATT_PK4(p0, 8, pa1); ATT_PK4(p1, 0, pa2); ATT_PK4(p1, 8, pa3);
            pv_tile(o, vb0 + bf * SHM_V, pa0, pa1, pa2, pa3);
            done_w = __all(R < -130.f);
        }
        if (lane == 0) flags[bf * 8 + wave] = done_w ? 1u : 0u;
        if (t > 0) { asm volatile("s_waitcnt vmcnt(0)" ::: "memory"); stage_write(S, lds, (it + 1) & 1, kws, vst0, vst1); }
        __syncthreads();
        unsigned alld = 1u;
#pragma unroll
        for (int w = 0; w < 8; ++w) alld &= flags[bf * 8 + w];
        if (alld) break;
    }
    o_epilogue(o, lds, wave, lane, r32, hi, false, P + (rowbase + qw0) * NPROJ + L1_G + h * HD, NPROJ, MIX + (rowbase + qw0) * DM + h * HD, DM);
    __syncthreads();
}
struct SbSeam { bf16x8 qr[8]; Stage SA, SB_; };
__device__ __forceinline__ void sb_prefetch(SbSeam& Z, const bf16* P, int b, int h, int qb, int tid, int lane, int wave) {
    const int r32 = lane & 31, hi = lane >> 5, qw0 = qb * 256 + wave * 32, sr = tid >> 4, sc = (tid & 15) * 8, t_hi = 4 * qb + 3; const size_t rowbase = (size_t)b * SEQ;
    const bf16* Kg = P + rowbase * NPROJ + L1_K + h * HD + sc; const bf16* Vg = P + rowbase * NPROJ + L1_V + h * HD + sc;
    stage_load(Z.SA, Kg, Vg, t_hi * 64, sr); stage_load(Z.SB_, Kg, Vg, (t_hi - 2) * 64, sr);
    const bf16* qp = P + (rowbase + qw0 + r32) * NPROJ + L1_Q + h * HD + hi * 8;
#pragma unroll
    for (int d0 = 0; d0 < 8; ++d0) Z.qr[d0] = *(const GAS bf16x8*)(qp + d0 * 16);
}
__device__ __forceinline__ void sb_unit2(char* lds, const bf16* P, bf16* MIX, int b, int h, int qb, int tid_in, int lane_in, int wave, SbSeam& Z, bool has_next, int nb, int nh, int nqb) {
    int tid = tid_in, lane = lane_in; asm volatile("" : "+v"(tid), "+v"(lane));
    const int r32 = lane & 31, hi = lane >> 5;
    const int qw0 = qb * 256 + wave * 32;
    const size_t rowbase = (size_t)b * SEQ;
    unsigned* flags = (unsigned*)(lds + OFF_FLAG);
    if (tid < 16) flags[tid] = 0u;
    bf16x8 (&qr)[8] = Z.qr; Stage& SA = Z.SA; Stage& SB_ = Z.SB_;
    const int sr = tid >> 4, sc = (tid & 15) * 8, kws = KSWZ(sr, sc * 2), vst0 = v_st(sr, sc), vst1 = v_st(32 + sr, sc);
    const bf16* Kg = P + rowbase * NPROJ + L1_K + h * HD + sc; const bf16* Vg = P + rowbase * NPROJ + L1_V + h * HD + sc;
    const int t_hi = 4 * qb + 3, half = wave >> 2, SETB = 65536;
    char* ldsw = lds + (half ? 0 : SETB);
    asm volatile("s_waitcnt vmcnt(0)" ::: "memory"); stage_write(SA, lds, 0, kws, vst0, vst1); stage_write(SB_, lds + SETB, 0, kws, vst0, vst1);
    __syncthreads();
    const float C2 = 0.08838834764831845f * LOG2E, NEG = -__builtin_inff();
    float R = 1.f; f32x16 o[4] = {}; bool done_w = false;
    const int vb0 = (int)(uintptr_t)(ldsw + OFF_V) + v_rd_base(lane);
#if defined(DBG_TLOOP)
    unsigned long long tl0_ = 0; if (tid == 0) tl0_ = __builtin_amdgcn_s_memrealtime();
#endif
#if defined(DBG_SEGSB)
    unsigned long long sg_[5] = {0, 0, 0, 0, 0}; unsigned long long st_ = __builtin_amdgcn_s_memtime();
#define SEGS(k) do { const unsigned long long n_ = __builtin_amdgcn_s_memtime(); sg_[k] += n_ - st_; st_ = n_; } while (0)
#else
#define SEGS(k) do {} while (0)
#endif
    for (int it = 0; it <= t_hi; ++it) {
        const int tA = t_hi - it, tB = tA - 2, t = half ? tA : tB, kb = t * 64, bf = it & 1;
        if (tA > 0) stage_load(SA, Kg, Vg, (tA - 1) * 64, sr);
        if (tB > 0) stage_load(SB_, Kg, Vg, (tB - 1) * 64, sr);
        if (t < 0) done_w = true;
        const bool act = !done_w && (kb < qw0 + 31);
        SEGS(4);
        if (act) {
            f32x16 p0, p1, l0, l1;
            qkt(p0, p1, ldsw + OFF_K + bf * SHM_K, r32, hi, qr);
            asm volatile("" : "+v"(p0), "+v"(p1)); SEGS(0);
            const int dq = qw0 + r32 - kb - 4 * hi;
            const bool diag = kb + 63 >= qw0;
#pragma unroll
            for (int r = 0; r < 16; ++r) { const int c = (r & 3) + 8 * (r >> 2);
                { const float e = __builtin_amdgcn_exp2f(fminf(p0[r] * C2, 100.f)), om = __builtin_amdgcn_rcpf(1.f + e); const bool ok = !diag || (dq - c > 0);
                  l0[r] = ok ? om : 1.f; p0[r] = ok ? e * om : 0.f; }
                { const float e = __builtin_amdgcn_exp2f(fminf(p1[r] * C2, 100.f)), om = __builtin_amdgcn_rcpf(1.f + e); const bool ok = !diag || (dq - c - 32 > 0);
                  l1[r] = ok ? om : 1.f; p1[r] = ok ? e * om : 0.f; } }
            float T0[4], T1[4], Q0[4], Q1[4];
#pragma unroll
            for (int g = 0; g < 4; ++g) { T0[g] = (l0[4 * g] * l0[4 * g + 1]) * (l0[4 * g + 2] * l0[4 * g + 3]); T1[g] = (l1[4 * g] * l1[4 * g + 1]) * (l1[4 * g + 2] * l1[4 * g + 3]); }
#pragma unroll
            for (int g = 0; g < 4; ++g) { Q0[g] = swap_get(T0[g], hi); Q1[g] = swap_get(T1[g], hi); }
            float SO0[4], SO1[4]; float run = 1.f;
#pragma unroll
            for (int g = 3; g >= 0; --g) { SO1[g] = run; run *= T1[g] * Q1[g]; }
#pragma unroll
            for (int g = 3; g >= 0; --g) { SO0[g] = run; run *= T0[g] * Q0[g]; }
#pragma unroll
            for (int g = 0; g < 4; ++g) {
                const float g0 = R * SO0[g] * (hi == 0 ? Q0[g] : 1.f), g1 = R * SO1[g] * (hi == 0 ? Q1[g] : 1.f);
                const float a3 = g0 * l0[4 * g + 3], a32 = a3 * l0[4 * g + 2], c3 = g1 * l1[4 * g + 3], c32 = c3 * l1[4 * g + 2];
                p0[4 * g + 3] *= g0; p0[4 * g + 2] *= a3; p0[4 * g + 1] *= a32; p0[4 * g] *= a32 * l0[4 * g + 1];
                p1[4 * g + 3] *= g1; p1[4 * g + 2] *= c3; p1[4 * g + 1] *= c32; p1[4 * g] *= c32 * l1[4 * g + 1];
            }
            R *= run;
            bf16x8 pa0, pa1, pa2, pa3;
            ATT_PK4(p0, 0, pa0); ATT_PK4(p0, 8, pa1); ATT_PK4(p1, 0, pa2); ATT_PK4(p1, 8, pa3);
            asm volatile("" : "+v"(pa0), "+v"(pa1), "+v"(pa2), "+v"(pa3)); SEGS(1);
            pv_tile(o, vb0 + bf * SHM_V, pa0, pa1, pa2, pa3);
            asm volatile("" : "+v"(o[0]), "+v"(o[1]), "+v"(o[2]), "+v"(o[3])); SEGS(2);
            done_w = __all(R < 1.2e-38f);
        }
        if (lane == 0) flags[bf * 8 + wave] = done_w ? 1u : 0u;
        if (tA > 0) { asm volatile("s_waitcnt vmcnt(0)" ::: "memory"); stage_write(SA, lds, (it + 1) & 1, kws, vst0, vst1); if (tB > 0) stage_write(SB_, lds + SETB, (it + 1) & 1, kws, vst0, vst1); }
        __syncthreads();
        SEGS(3);
        unsigned alld = 1u;
#pragma unroll
        for (int w = 0; w < 8; ++w) alld &= flags[bf * 8 + w];
        if (alld) break;
    }
#if defined(DBG_SEGSB)
    if (blockIdx.x == DBG_SEGBLK && tid == DBG_SEGTID) { volatile unsigned* M_ = (volatile unsigned*)(lds + MISC_OFF); const unsigned long long a_ = (((unsigned long long)M_[17] << 32) | M_[16]) + sg_[DBG_SEGSB]; M_[16] = (unsigned)a_; M_[17] = (unsigned)(a_ >> 32); }
#endif
#if defined(DBG_TLOOP)
    if (tid == 0) { volatile unsigned* M_ = (volatile unsigned*)(lds + MISC_OFF); const unsigned long long d_ = __builtin_amdgcn_s_memrealtime() - tl0_; const unsigned long long a_ = (((unsigned long long)M_[17] << 32) | M_[16]) + d_; M_[16] = (unsigned)a_; M_[17] = (unsigned)(a_ >> 32); }
#endif
    if (has_next) sb_prefetch(Z, P, nb, nh, nqb, tid, lane, wave);
    o_epilogue(o, lds, wave, lane, r32, hi, false, P + (rowbase + qw0) * NPROJ + L1_G + h * HD, NPROJ, MIX + (rowbase + qw0) * DM + h * HD, DM);
    __syncthreads();
}


__device__ __forceinline__ void sb_tile_load(bf16x8 (&kr)[8], bf16x8 (&vr)[8], const bf16* Kg, const bf16* Vg, int k0, int lane) {
    const int loff = (lane >> 4) * NPROJ + (lane & 15) * 8;
#pragma unroll
    for (int j = 0; j < 8; ++j) { const bf16* kp = Kg + (size_t)(k0 + 4 * j) * NPROJ; const bf16* vp = Vg + (size_t)(k0 + 4 * j) * NPROJ;
        kr[j] = *(const GAS bf16x8*)(kp + loff); vr[j] = *(const GAS bf16x8*)(vp + loff); }
}
__device__ __forceinline__ void sb_unit3(char* lds, const bf16* P, bf16* MIX, int b, int h, int qb, int lane_in, int wave) {
    int lane = lane_in; asm volatile("" : "+v"(lane));
    const int r32 = lane & 31, hi = lane >> 5;
    const int qw0 = qb * 256 + wave * 32;
    const size_t rowbase = (size_t)b * SEQ;
    char* wl = lds + wave * 16384;
    const bf16* Kg = P + rowbase * NPROJ + L1_K + h * HD; const bf16* Vg = P + rowbase * NPROJ + L1_V + h * HD;
    const int tw = qw0 >> 5;
    bf16x8 kr[8], vr[8]; sb_tile_load(kr, vr, Kg, Vg, tw * 32, lane);
    bf16x8 qr[8];
    { const bf16* qp = P + (rowbase + qw0 + r32) * NPROJ + L1_Q + h * HD + hi * 8;
#pragma unroll
      for (int d0 = 0; d0 < 8; ++d0) qr[d0] = *(const GAS bf16x8*)(qp + d0 * 16); }
    const float C2 = 0.08838834764831845f * LOG2E;
    float R = 1.f; f32x16 o[4] = {};
    const int vb = (int)(uintptr_t)(wl + 8192) + v_rd_base(lane);
    for (int t = tw; t >= 0; --t) {
#pragma unroll
        for (int j = 0; j < 8; ++j) { const int pc = j * 64 + lane, row = pc >> 4, sc = (pc & 15) * 8;
            *(bf16x8*)(wl + KSWZ(row, sc * 2)) = kr[j]; *(bf16x8*)(wl + 8192 + v_st(row, sc)) = vr[j]; }
        if (t > 0) sb_tile_load(kr, vr, Kg, Vg, (t - 1) * 32, lane);
        asm volatile("s_waitcnt lgkmcnt(0)" ::: "memory");
        f32x16 p0 = f32x16{}, l0;
        { const char* kb4[4];
#pragma unroll
          for (int dd = 0; dd < 4; ++dd) kb4[dd] = wl + KSWZ(r32, (dd * 16 + hi * 8) * 2);
#pragma unroll
          for (int d0 = 0; d0 < 8; ++d0) { const bf16x8 b0 = *reinterpret_cast<const bf16x8*>(kb4[d0 & 3] + (d0 >> 2) * 128); p0 = __builtin_amdgcn_mfma_f32_32x32x16_bf16(b0, qr[d0], p0, 0, 0, 0); } }
        const int dq = qw0 + r32 - t * 32 - 4 * hi; const bool diag = t == tw;
#pragma unroll
        for (int r = 0; r < 16; ++r) { const int c = (r & 3) + 8 * (r >> 2);
            const float e = __builtin_amdgcn_exp2f(fminf(p0[r] * C2, 100.f)), om = __builtin_amdgcn_rcpf(1.f + e); const bool ok = !diag || (dq - c > 0);
            l0[r] = ok ? om : 1.f; p0[r] = ok ? e * om : 0.f; }
        float T0[4], Q0[4];
#pragma unroll
        for (int g = 0; g < 4; ++g) T0[g] = (l0[4 * g] * l0[4 * g + 1]) * (l0[4 * g + 2] * l0[4 * g + 3]);
#pragma unroll
        for (int g = 0; g < 4; ++g) Q0[g] = swap_get(T0[g], hi);
        float SO0[4]; float run = 1.f;
#pragma unroll
        for (int g = 3; g >= 0; --g) { SO0[g] = run; run *= T0[g] * Q0[g]; }
#pragma unroll
        for (int g = 0; g < 4; ++g) { const float g0 = R * SO0[g] * (hi == 0 ? Q0[g] : 1.f), a3 = g0 * l0[4 * g + 3], a32 = a3 * l0[4 * g + 2];
            p0[4 * g + 3] *= g0; p0[4 * g + 2] *= a3; p0[4 * g + 1] *= a32; p0[4 * g] *= a32 * l0[4 * g + 1]; }
        R *= run;
        bf16x8 pa0, pa1;
        ATT_PK4(p0, 0, pa0); ATT_PK4(p0, 8, pa1);
#define SB3_TR(dst, off) asm volatile("ds_read_b64_tr_b16 %0, %1 offset:%2" : "=&v"(dst) : "v"(vb), "i"(off) : "memory")
#define SB3_PV(d0) do { s16x4 x0, y0, x1, y1; SB3_TR(x0, d0 * 512); SB3_TR(y0, d0 * 512 + 2048); SB3_TR(x1, d0 * 512 + 4096); SB3_TR(y1, d0 * 512 + 6144); \
        asm volatile("s_waitcnt lgkmcnt(0)" ::: "memory"); __builtin_amdgcn_sched_barrier(0); \
        o[d0] = __builtin_amdgcn_mfma_f32_32x32x16_bf16(pa0, (bf16x8){x0[0], x0[1], x0[2], x0[3], y0[0], y0[1], y0[2], y0[3]}, o[d0], 0, 0, 0); \
        o[d0] = __builtin_amdgcn_mfma_f32_32x32x16_bf16(pa1, (bf16x8){x1[0], x1[1], x1[2], x1[3], y1[0], y1[1], y1[2], y1[3]}, o[d0], 0, 0, 0); } while (0)
        SB3_PV(0); SB3_PV(1); SB3_PV(2); SB3_PV(3);
#undef SB3_PV
#undef SB3_TR
        if (__all(R < 1.2e-38f)) break;
    }
    o_epilogue(o, lds, wave, lane, r32, hi, false, P + (rowbase + qw0) * NPROJ + L1_G + h * HD, NPROJ, MIX + (rowbase + qw0) * DM + h * HD, DM);
    asm volatile("s_waitcnt lgkmcnt(0)" ::: "memory");
}

struct Sb4Seam { bf16x8 qr[8]; bf16x8 kr[4], vr[4]; };
__device__ __forceinline__ void sb4_prefetch(Sb4Seam& Z, const bf16* P, int b, int h, int qb, int tid, int lane, int wave) {
    const int r32 = lane & 31, hi = lane >> 5, g4 = wave >> 1, ltid = tid & 127, qw0 = qb * 256 + wave * 32, tstart = 8 * qb + 2 * g4 + 1; const size_t rowbase = (size_t)b * SEQ;
    const bf16* Kg = P + rowbase * NPROJ + L1_K + h * HD; const bf16* Vg = P + rowbase * NPROJ + L1_V + h * HD; const int loff = (ltid >> 4) * NPROJ + (ltid & 15) * 8;
#pragma unroll
    for (int j = 0; j < 4; ++j) { const bf16* kp = Kg + (size_t)(tstart * 32 + 8 * j) * NPROJ; const bf16* vp = Vg + (size_t)(tstart * 32 + 8 * j) * NPROJ; Z.kr[j] = *(const GAS bf16x8*)(kp + loff); Z.vr[j] = *(const GAS bf16x8*)(vp + loff); }
    const bf16* qp = P + (rowbase + qw0 + r32) * NPROJ + L1_Q + h * HD + hi * 8;
#pragma unroll
    for (int d0 = 0; d0 < 8; ++d0) Z.qr[d0] = *(const GAS bf16x8*)(qp + d0 * 16);
}
template <bool NOLOOP = false>
__device__ __forceinline__ void sb_unit4(char* lds, const bf16* P, bf16* MIX, int b, int h, int qb, int tid_in, int lane_in, int wave, Sb4Seam& Z, bool has_next, int nb, int nh, int nqb) {
    int tid = tid_in, lane = lane_in; asm volatile("" : "+v"(tid), "+v"(lane));
    const int r32 = lane & 31, hi = lane >> 5, g4 = wave >> 1, ltid = tid & 127;
    const int qw0 = qb * 256 + wave * 32;
    const size_t rowbase = (size_t)b * SEQ;
    unsigned* flags = (unsigned*)(lds + OFF_FLAG);
    if (tid < 16) flags[tid] = 0u;
    char* gl = lds + g4 * 32768;
    const bf16* Kg = P + rowbase * NPROJ + L1_K + h * HD; const bf16* Vg = P + rowbase * NPROJ + L1_V + h * HD;
    const int loff = (ltid >> 4) * NPROJ + (ltid & 15) * 8;
    int wk[4], wv[4];
#pragma unroll
    for (int j = 0; j < 4; ++j) { const int row = 8 * j + (ltid >> 4), sc = (ltid & 15) * 8; wk[j] = KSWZ(row, sc * 2); wv[j] = 8192 + v_st(row, sc); }
    const int tstart = 8 * qb + 2 * g4 + 1;
    bf16x8 (&kr)[4] = Z.kr; bf16x8 (&vr)[4] = Z.vr; bf16x8 (&qr)[8] = Z.qr;
#define SB4_LOAD(tt) do { _Pragma("unroll") for (int j = 0; j < 4; ++j) { const bf16* kp = Kg + (size_t)((tt) * 32 + 8 * j) * NPROJ; const bf16* vp = Vg + (size_t)((tt) * 32 + 8 * j) * NPROJ; \
        kr[j] = *(const GAS bf16x8*)(kp + loff); vr[j] = *(const GAS bf16x8*)(vp + loff); } } while (0)
#define SB4_WRITE(bf) do { _Pragma("unroll") for (int j = 0; j < 4; ++j) { *(bf16x8*)(gl + (bf) * 16384 + wk[j]) = kr[j]; *(bf16x8*)(gl + (bf) * 16384 + wv[j]) = vr[j]; } } while (0)
    SB4_WRITE(0);
    __syncthreads();
    const float C2 = 0.08838834764831845f * LOG2E;
    float R = 1.f; f32x16 o[4] = {}; bool done_w = false;
    for (int it = 0; it <= (NOLOOP ? -1 : 8 * qb + 8); ++it) {
        const int t = tstart - it, bf = it & 1;
        if (t > 0) SB4_LOAD(t - 1);
        if (t < 0) done_w = true;
        const int kb = t * 32;
        const bool act = !done_w && (kb < qw0 + 31);
        if (act) {
            char* kt = gl + bf * 16384;
            f32x16 p0 = f32x16{}, l0;
            { const char* kb4[4];
#pragma unroll
              for (int dd = 0; dd < 4; ++dd) kb4[dd] = kt + KSWZ(r32, (dd * 16 + hi * 8) * 2);
#pragma unroll
              for (int d0 = 0; d0 < 8; ++d0) { const bf16x8 b0 = *reinterpret_cast<const bf16x8*>(kb4[d0 & 3] + (d0 >> 2) * 128); p0 = __builtin_amdgcn_mfma_f32_32x32x16_bf16(b0, qr[d0], p0, 0, 0, 0); } }
            const int dq = qw0 + r32 - kb - 4 * hi; const bool diag = kb + 31 >= qw0;
#pragma unroll
            for (int r = 0; r < 16; ++r) { const int c = (r & 3) + 8 * (r >> 2);
                const float e = __builtin_amdgcn_exp2f(fminf(p0[r] * C2, 100.f)), om = __builtin_amdgcn_rcpf(1.f + e); const bool ok = !diag || (dq - c > 0);
                l0[r] = ok ? om : 1.f; p0[r] = ok ? e * om : 0.f; }
            float T0[4], Q0[4];
#pragma unroll
            for (int g = 0; g < 4; ++g) T0[g] = (l0[4 * g] * l0[4 * g + 1]) * (l0[4 * g + 2] * l0[4 * g + 3]);
#pragma unroll
            for (int g = 0; g < 4; ++g) Q0[g] = swap_get(T0[g], hi);
            float SO0[4]; float run = 1.f;
#pragma unroll
            for (int g = 3; g >= 0; --g) { SO0[g] = run; run *= T0[g] * Q0[g]; }
#pragma unroll
            for (int g = 0; g < 4; ++g) { const float g0 = R * SO0[g] * (hi == 0 ? Q0[g] : 1.f), a3 = g0 * l0[4 * g + 3], a32 = a3 * l0[4 * g + 2];
                p0[4 * g + 3] *= g0; p0[4 * g + 2] *= a3; p0[4 * g + 1] *= a32; p0[4 * g] *= a32 * l0[4 * g + 1]; }
            R *= run;
            bf16x8 pa0, pa1;
            ATT_PK4(p0, 0, pa0); ATT_PK4(p0, 8, pa1);
            const int vb = (int)(uintptr_t)(kt + 8192) + v_rd_base(lane);
#define SB4_TR(dst, off) asm volatile("ds_read_b64_tr_b16 %0, %1 offset:%2" : "=&v"(dst) : "v"(vb), "i"(off) : "memory")
#define SB4_PV(d0) do { s16x4 x0, y0, x1, y1; SB4_TR(x0, d0 * 512); SB4_TR(y0, d0 * 512 + 2048); SB4_TR(x1, d0 * 512 + 4096); SB4_TR(y1, d0 * 512 + 6144); \
            asm volatile("s_waitcnt lgkmcnt(0)" ::: "memory"); __builtin_amdgcn_sched_barrier(0); \
            o[d0] = __builtin_amdgcn_mfma_f32_32x32x16_bf16(pa0, (bf16x8){x0[0], x0[1], x0[2], x0[3], y0[0], y0[1], y0[2], y0[3]}, o[d0], 0, 0, 0); \
            o[d0] = __builtin_amdgcn_mfma_f32_32x32x16_bf16(pa1, (bf16x8){x1[0], x1[1], x1[2], x1[3], y1[0], y1[1], y1[2], y1[3]}, o[d0], 0, 0, 0); } while (0)
            SB4_PV(0); SB4_PV(1); SB4_PV(2); SB4_PV(3);
#undef SB4_PV
#undef SB4_TR
            done_w = __all(R < 1.2e-38f);
        }
        if (lane == 0) flags[bf * 8 + wave] = done_w ? 1u : 0u;
        if (t > 0) SB4_WRITE((it + 1) & 1);
        __syncthreads();
        unsigned alld = 1u;
#pragma unroll
        for (int w = 0; w < 8; ++w) alld &= flags[bf * 8 + w];
        if (alld) break;
    }
#undef SB4_LOAD
#undef SB4_WRITE
    if (has_next) sb4_prefetch(Z, P, nb, nh, nqb, tid, lane, wave);
    o_epilogue(o, lds, wave, lane, r32, hi, false, P + (rowbase + qw0) * NPROJ + L1_G + h * HD, NPROJ, MIX + (rowbase + qw0) * DM + h * HD, DM);
    __syncthreads();
}

__device__ __forceinline__ void sb_unit5(char* lds, const bf16* P, bf16* MIX, int b, int h, int qb, int tid_in, int lane_in, int wave, bf16x8 (&qr)[8], bool has_next, int nb, int nh, int nqb) {
    int tid = tid_in, lane = lane_in; asm volatile("" : "+v"(tid), "+v"(lane));
    const int r32 = lane & 31, hi = lane >> 5, hA = wave >> 2, wl = wave & 3;
    const int qw0 = qb * 256 + wave * 32;
    const size_t rowbase = (size_t)b * SEQ;
    unsigned* flags = (unsigned*)(lds + OFF_FLAG);
    if (tid < 16) flags[tid] = 0u;
    char* sl = lds + hA * 65536;
    const bf16* Kg = P + rowbase * NPROJ + L1_K + h * HD; const bf16* Vg = P + rowbase * NPROJ + L1_V + h * HD;
    unsigned gofK[2], gofV[2];
#pragma unroll
    for (int i = 0; i < 2; ++i) { const int q = 2 * wl + i;
        { const int row = 4 * q + (lane >> 4), colB = ((lane & 15) * 16) ^ ((row & 7) << 4); gofK[i] = (unsigned)(row * NPROJ + (colB >> 1)); }
        { const int sub = 2 * q + (lane >> 5), kk = (sub >> 2) * 8 + ((lane & 31) >> 2), c = (sub & 3) * 32 + (lane & 3) * 8, k = (kk & ~0xC) | ((kk & 4) << 1) | ((kk & 8) >> 1); gofV[i] = (unsigned)(k * NPROJ + c); } }
#define SB5_DMA(tt, slot) do { _Pragma("unroll") for (int i_ = 0; i_ < 2; ++i_) { \
        __builtin_amdgcn_global_load_lds((const unsigned*)(Kg + (size_t)(tt) * 32 * NPROJ + gofK[i_]), (__attribute__((address_space(3))) unsigned*)(sl + (slot) * 16384 + (2 * wl + i_) * 1024), 16, 0, 0); \
        __builtin_amdgcn_global_load_lds((const unsigned*)(Vg + (size_t)(tt) * 32 * NPROJ + gofV[i_]), (__attribute__((address_space(3))) unsigned*)(sl + (slot) * 16384 + 8192 + (2 * wl + i_) * 1024), 16, 0, 0); } } while (0)
    const int tstart = 8 * qb + 4 * hA + 3;
    __syncthreads();
    SB5_DMA(tstart, 0); SB5_DMA(tstart - 1, 1); SB5_DMA(tstart - 2, 2);
    asm volatile("s_waitcnt vmcnt(8)" ::: "memory"); __builtin_amdgcn_s_barrier(); asm volatile("" ::: "memory");
    const float C2 = 0.08838834764831845f * LOG2E;
    float R = 1.f; f32x16 o[4] = {}; bool done_w = false;
    for (int it = 0; it <= 8 * qb + 8; ++it) {
        const int t = tstart - it, bf = it & 1, slot = it & 3;
        if (t - 3 >= 0) SB5_DMA(t - 3, (it + 3) & 3);
        if (t < 0) done_w = true;
        const int kb = t * 32;
        const bool act = !done_w && (kb < qw0 + 31);
        if (act) {
            char* kt = sl + slot * 16384;
            f32x16 p0 = f32x16{}, l0;
            { const char* kb4[4];
#pragma unroll
              for (int dd = 0; dd < 4; ++dd) kb4[dd] = kt + KSWZ(r32, (dd * 16 + hi * 8) * 2);
#pragma unroll
              for (int d0 = 0; d0 < 8; ++d0) { const bf16x8 b0 = *reinterpret_cast<const bf16x8*>(kb4[d0 & 3] + (d0 >> 2) * 128); p0 = __builtin_amdgcn_mfma_f32_32x32x16_bf16(b0, qr[d0], p0, 0, 0, 0); } }
            const int dq = qw0 + r32 - kb - 4 * hi; const bool diag = kb + 31 >= qw0;
#pragma unroll
            for (int r = 0; r < 16; ++r) { const int c = (r & 3) + 8 * (r >> 2);
                const float e = __builtin_amdgcn_exp2f(fminf(p0[r] * C2, 100.f)), om = __builtin_amdgcn_rcpf(1.f + e); const bool ok = !diag || (dq - c > 0);
                l0[r] = ok ? om : 1.f; p0[r] = ok ? e * om : 0.f; }
            float T0[4], Q0[4];
#pragma unroll
            for (int g = 0; g < 4; ++g) T0[g] = (l0[4 * g] * l0[4 * g + 1]) * (l0[4 * g + 2] * l0[4 * g + 3]);
#pragma unroll
            for (int g = 0; g < 4; ++g) Q0[g] = swap_get(T0[g], hi);
            float SO0[4]; float run = 1.f;
#pragma unroll
            for (int g = 3; g >= 0; --g) { SO0[g] = run; run *= T0[g] * Q0[g]; }
#pragma unroll
            for (int g = 0; g < 4; ++g) { const float g0 = R * SO0[g] * (hi == 0 ? Q0[g] : 1.f), a3 = g0 * l0[4 * g + 3], a32 = a3 * l0[4 * g + 2];
                p0[4 * g + 3] *= g0; p0[4 * g + 2] *= a3; p0[4 * g + 1] *= a32; p0[4 * g] *= a32 * l0[4 * g + 1]; }
            R *= run;
            bf16x8 pa0, pa1;
            ATT_PK4(p0, 0, pa0); ATT_PK4(p0, 8, pa1);
            const int vb = (int)(uintptr_t)(kt + 8192) + v_rd_base(lane);
#define SB5_TR(dst, off) asm volatile("ds_read_b64_tr_b16 %0, %1 offset:%2" : "=&v"(dst) : "v"(vb), "i"(off) : "memory")
#define SB5_PV(d0) do { s16x4 x0, y0, x1, y1; SB5_TR(x0, d0 * 512); SB5_TR(y0, d0 * 512 + 2048); SB5_TR(x1, d0 * 512 + 4096); SB5_TR(y1, d0 * 512 + 6144); \
            asm volatile("s_waitcnt lgkmcnt(0)" ::: "memory"); __builtin_amdgcn_sched_barrier(0); \
            o[d0] = __builtin_amdgcn_mfma_f32_32x32x16_bf16(pa0, (bf16x8){x0[0], x0[1], x0[2], x0[3], y0[0], y0[1], y0[2], y0[3]}, o[d0], 0, 0, 0); \
            o[d0] = __builtin_amdgcn_mfma_f32_32x32x16_bf16(pa1, (bf16x8){x1[0], x1[1], x1[2], x1[3], y1[0], y1[1], y1[2], y1[3]}, o[d0], 0, 0, 0); } while (0)
            SB5_PV(0); SB5_PV(1); SB5_PV(2); SB5_PV(3);
#undef SB5_PV
#undef SB5_TR
            done_w = __all(R < 1.2e-38f);
        }
        if (lane == 0) flags[bf * 8 + wave] = done_w ? 1u : 0u;
        if (t - 3 >= 0) asm volatile("s_waitcnt vmcnt(8) lgkmcnt(0)" ::: "memory"); else if (t - 2 >= 0) asm volatile("s_waitcnt vmcnt(4) lgkmcnt(0)" ::: "memory"); else asm volatile("s_waitcnt vmcnt(0) lgkmcnt(0)" ::: "memory");
        __builtin_amdgcn_s_barrier(); asm volatile("" ::: "memory");
        unsigned alld = 1u;
#pragma unroll
        for (int w = 0; w < 8; ++w) alld &= flags[bf * 8 + w];
        if (alld) break;
    }
#undef SB5_DMA
    asm volatile("s_waitcnt vmcnt(0)" ::: "memory"); __syncthreads();
    if (has_next) { const int qn0 = nqb * 256 + wave * 32; const bf16* qp = P + ((size_t)nb * SEQ + qn0 + r32) * NPROJ + L1_Q + nh * HD + hi * 8;
#pragma unroll
        for (int d0 = 0; d0 < 8; ++d0) qr[d0] = *(const GAS bf16x8*)(qp + d0 * 16); }
    o_epilogue(o, lds, wave, lane, r32, hi, false, P + (rowbase + qw0) * NPROJ + L1_G + h * HD, NPROJ, MIX + (rowbase + qw0) * DM + h * HD, DM);
}
#if defined(DBG_SBDUMMY)
__device__ __forceinline__ void sb_dummy_phase(Frame& F, const bf16* P) {
    PH_IDS();
    char* lds = (char*)(F.lds + RING_OFF);
    constexpr int NBH = BATCH * SB_H, NU = NBH * 8, SETB = 65536;
    const int sr = tid >> 4, sc = (tid & 15) * 8, kws = KSWZ(sr, sc * 2), vst0 = v_st(sr, sc), vst1 = v_st(32 + sr, sc);
    for (int u = vcu; u < NU; u += G) { const int bh = u % NBH, qb = u / NBH, b = bh >> 5, h = bh & 31, t_hi = 4 * qb + 3; const size_t rowbase = (size_t)b * SEQ;
        const bf16* Kg = P + rowbase * NPROJ + L1_K + h * HD + sc; const bf16* Vg = P + rowbase * NPROJ + L1_V + h * HD + sc;
        Stage SA, SB_; stage_load(SA, Kg, Vg, t_hi * 64, sr); stage_load(SB_, Kg, Vg, (t_hi - 2) * 64, sr);
        asm volatile("s_waitcnt vmcnt(0)" ::: "memory"); stage_write(SA, lds, 0, kws, vst0, vst1); stage_write(SB_, lds + SETB, 0, kws, vst0, vst1);
        __syncthreads();
        for (int it = 0; it < 6 && it <= t_hi; ++it) { const int tA = t_hi - it, tB = tA - 2;
            if (tA > 0) stage_load(SA, Kg, Vg, (tA - 1) * 64, sr);
            if (tB > 0) stage_load(SB_, Kg, Vg, (tB - 1) * 64, sr);
#if DBG_SBDUMMY == 2
            { const unsigned long long t0_ = __builtin_amdgcn_s_memtime(); while (__builtin_amdgcn_s_memtime() - t0_ < 4000ull) __builtin_amdgcn_s_sleep(4); }
#endif
            if (tA > 0) { asm volatile("s_waitcnt vmcnt(0)" ::: "memory"); stage_write(SA, lds, (it + 1) & 1, kws, vst0, vst1); if (tB > 0) stage_write(SB_, lds + SETB, (it + 1) & 1, kws, vst0, vst1); }
            __syncthreads(); }
        __syncthreads(); }
}
#endif

#if defined(DBG_SBDUMMY4)
__device__ __forceinline__ void sb_dummy4_phase(Frame& F, const bf16* P, bf16* SCR) {
    PH_IDS();
    char* lds = (char*)(F.lds + RING_OFF);
    constexpr int NBH = BATCH * SB_H, NU = NBH * 8; for (int u = vcu; u < NU; u += G) { const int bh = u % NBH, qb = u / NBH; { Sb4Seam Z; sb4_prefetch(Z, P, bh >> 5, bh & 31, qb, tid, lane, wave); sb_unit4<true>(lds, P, SCR, bh >> 5, bh & 31, qb, tid, lane, wave, Z, false, 0, 0, 0); } }
}
#endif
__device__ __forceinline__ void sb_phase(Frame& F, const bf16* P, bf16* MIX) {
    PH_IDS();
    char* lds = (char*)(F.lds + RING_OFF);
    if (SB_DUAL == 4) { constexpr int NBH = BATCH * SB_H, NU = NBH * 8; bf16x8 qr[8];
        if (vcu < NU) { const int bh = vcu % NBH, qb = vcu / NBH; const bf16* qp = P + ((size_t)(bh >> 5) * SEQ + qb * 256 + wave * 32 + (lane & 31)) * NPROJ + L1_Q + (bh & 31) * HD + (lane >> 5) * 8;
#pragma unroll
            for (int d0 = 0; d0 < 8; ++d0) qr[d0] = *(const GAS bf16x8*)(qp + d0 * 16); }
        for (int u = vcu; u < NU; u += G) { const int bh = u % NBH, qb = u / NBH, un = u + G; const bool hn = un < NU; sb_unit5(lds, P, MIX, bh >> 5, bh & 31, qb, tid, lane, wave, qr, hn, (un % NBH) >> 5, (un % NBH) & 31, un / NBH); }
        __syncthreads(); }
    else if (SB_DUAL == 3) { constexpr int NBH = BATCH * SB_H, NU = NBH * 8; Sb4Seam Z; if (vcu < NU) sb4_prefetch(Z, P, (vcu % NBH) >> 5, (vcu % NBH) & 31, vcu / NBH, tid, lane, wave);
        for (int u = vcu; u < NU; u += G) { const int bh = u % NBH, qb = u / NBH, un = u + G; const bool hn = un < NU; sb_unit4(lds, P, MIX, bh >> 5, bh & 31, qb, tid, lane, wave, Z, hn, (un % NBH) >> 5, (un % NBH) & 31, un / NBH); } }
    else if (SB_DUAL == 2) { constexpr int NBH = BATCH * SB_H, NU = NBH * 8; for (int u = vcu; u < NU; u += G) { const int bh = u % NBH, qb = u / NBH; sb_unit3(lds, P, MIX, bh >> 5, bh & 31, qb, lane, wave); } }
    else if (SB_DUAL) { SbSeam Z; constexpr int NBH = BATCH * SB_H, NU = NBH * 8; if (vcu < NU) sb_prefetch(Z, P, (vcu % NBH) >> 5, (vcu % NBH) & 31, vcu / NBH, tid, lane, wave);
        for (int u = vcu; u < NU; u += G) { const int bh = u % NBH, qb = u / NBH, un = u + G; const bool hn = un < NU;
            sb_unit2(lds, P, MIX, bh >> 5, bh & 31, qb, tid, lane, wave, Z, hn, (un % NBH) >> 5, (un % NBH) & 31, un / NBH); } }
    else for (int u = vcu; u < BATCH * SB_H * 8; u += G) { const int qb = u & 7, bh = u >> 3; sb_unit(lds, P, MIX, bh >> 5, bh & 31, qb, tid, lane, wave); }
}

#define XKSWZ(row, colB) ((row) * 512 + ((colB) ^ (((row) & 7) << 4)))
__device__ __forceinline__ int xv_st(int k, int c) { const int kk = (k & ~0xC) | ((k & 4) << 1) | ((k & 8) >> 1); return ((kk >> 3) * 8 + (c >> 5)) * 512 + ((kk & 7) * 32 + (c & 31)) * 2; }
__device__ __forceinline__ void xattn_unit(char* lds, const bf16* QG, const bf16* KVX, bf16* XOIN, int b, int xh, int qb, int tid_in, int lane_in, int wave) {
    int tid = tid_in, lane = lane_in; asm volatile("" : "+v"(tid), "+v"(lane));
    const int r32 = lane & 31, hi = lane >> 5;
    const size_t m0 = (size_t)b * SEQ + qb * 256 + wave * 32;
    float* lil = (float*)(lds + OFF_LI) + wave * 32;
    bf16x8 qf[16];
    { const bf16* qp = QG + (m0 + r32) * XQW + xh * XHD + hi * 8;
#pragma unroll
      for (int d = 0; d < 16; ++d) qf[d] = *(const GAS bf16x8*)(qp + d * 16); }
    { const bf16* Kg = KVX + (size_t)(b * NMEM) * KVLD + xh * XHD;
#pragma unroll
      for (int hb = 0; hb < 2; ++hb) { bf16x8 kv_[8];
#pragma unroll
          for (int i = 0; i < 8; ++i) { const int id = (hb * 8 + i) * 512 + tid, row = id >> 5, ch = id & 31; kv_[i] = *(const GAS bf16x8*)(Kg + (size_t)row * KVLD + ch * 8); }
#pragma unroll
          for (int i = 0; i < 8; ++i) { const int id = (hb * 8 + i) * 512 + tid, row = id >> 5, ch = id & 31; *(bf16x8*)(lds + XKSWZ(row, ch * 16)) = kv_[i]; } } }
    __syncthreads();
    f32x16 s[8];
#pragma unroll
    for (int kt = 0; kt < 8; ++kt) s[kt] = f32x16{};
#pragma unroll
    for (int d0 = 0; d0 < 16; ++d0) {
#pragma unroll
        for (int kt = 0; kt < 8; ++kt) { const bf16x8 kf = *(const bf16x8*)(lds + XKSWZ(32 * kt + r32, (d0 * 16 + hi * 8) * 2)); s[kt] = __builtin_amdgcn_mfma_f32_32x32x16_bf16(kf, qf[d0], s[kt], 0, 0, 0); } }
    const bf16* Vg = KVX + (size_t)(b * NMEM) * KVLD + XW + xh * XHD; int tid2 = tid; asm volatile("" : "+v"(tid2));
    bf16x8 vv0[8];
#pragma unroll
    for (int i = 0; i < 8; ++i) { const int id = i * 512 + tid2, row = id >> 5, ch = id & 31; vv0[i] = *(const GAS bf16x8*)(Vg + (size_t)row * KVLD + ch * 8); }
    float mx = s[0][0];
#pragma unroll
    for (int kt = 0; kt < 8; ++kt)
#pragma unroll
        for (int r = 0; r < 16; ++r) mx = fmaxf(mx, s[kt][r]);
    mx = swap_max(mx);
    const float CX = 0.0625f * LOG2E; float ps = 0.f;
#pragma unroll
    for (int kt = 0; kt < 8; ++kt)
#pragma unroll
        for (int r = 0; r < 16; ++r) { s[kt][r] = __builtin_amdgcn_exp2f((s[kt][r] - mx) * CX); ps += s[kt][r]; }
    ps = swap_add(ps);
    bf16x8 pa[16];
#pragma unroll
    for (int kt = 0; kt < 8; ++kt) { ATT_PK4(s[kt], 0, pa[2 * kt]); ATT_PK4(s[kt], 8, pa[2 * kt + 1]); }
    __syncthreads();
    { int tid3 = tid; asm volatile("" : "+v"(tid3));
      bf16x8 vv_[8];
#pragma unroll
      for (int i = 0; i < 8; ++i) { const int id = (8 + i) * 512 + tid3, row = id >> 5, ch = id & 31; vv_[i] = *(const GAS bf16x8*)(Vg + (size_t)row * KVLD + ch * 8); }
#pragma unroll
      for (int i = 0; i < 8; ++i) { const int id = i * 512 + tid3, row = id >> 5, ch = id & 31; *(bf16x8*)(lds + xv_st(row, ch * 8)) = vv0[i]; }
#pragma unroll
      for (int i = 0; i < 8; ++i) { const int id = (8 + i) * 512 + tid3, row = id >> 5, ch = id & 31; *(bf16x8*)(lds + xv_st(row, ch * 8)) = vv_[i]; } }
    __syncthreads();
    f32x16 o[8];
#pragma unroll
    for (int d0 = 0; d0 < 8; ++d0) o[d0] = f32x16{};
    const int vb0 = (int)(uintptr_t)lds + v_rd_base(lane);
    s16x4 lo_[2], hi_[2];
#define XA_VRD(it_, buf_) do { asm volatile("ds_read_b64_tr_b16 %0, %1 offset:%2" : "=&v"(lo_[buf_]) : "v"(vb0 + ((it_) >> 3) * 8192), "i"(((it_) & 7) * 512) : "memory"); \
        asm volatile("ds_read_b64_tr_b16 %0, %1 offset:%2" : "=&v"(hi_[buf_]) : "v"(vb0 + ((it_) >> 3) * 8192), "i"(((it_) & 7) * 512 + 4096) : "memory"); } while (0)
    XA_VRD(0, 0);
#pragma unroll
    for (int it = 0; it < 128; ++it) { const int ks = it >> 3, d0 = it & 7, cb = it & 1;
        if (it + 1 < 128) { XA_VRD(it + 1, cb ^ 1); asm volatile("s_waitcnt lgkmcnt(2)" ::: "memory"); } else asm volatile("s_waitcnt lgkmcnt(0)" ::: "memory");
        __builtin_amdgcn_sched_barrier(0);
        o[d0] = __builtin_amdgcn_mfma_f32_32x32x16_bf16(pa[ks], (bf16x8){lo_[cb][0], lo_[cb][1], lo_[cb][2], lo_[cb][3], hi_[cb][0], hi_[cb][1], hi_[cb][2], hi_[cb][3]}, o[d0], 0, 0, 0);
        __builtin_amdgcn_sched_barrier(0); }
#undef XA_VRD
    __syncthreads();
    if (hi == 0) lil[r32] = 1.f / ps;
    if (FP8_XO) {
        unsigned char* o8 = (unsigned char*)XOIN + m0 * XW + xh * XHD;
        o_epilogue(o, lds, wave, lane, r32, hi, true, QG + m0 * XQW + XW + xh * XHD, XQW, (bf16*)o8, XW, XO8_SCALE);
        o_epilogue(o + 4, lds, wave, lane, r32, hi, true, QG + m0 * XQW + XW + xh * XHD + 128, XQW, (bf16*)(o8 + 128), XW, XO8_SCALE);
    } else {
    o_epilogue(o, lds, wave, lane, r32, hi, true, QG + m0 * XQW + XW + xh * XHD, XQW, XOIN + m0 * XW + xh * XHD, XW);
    o_epilogue(o + 4, lds, wave, lane, r32, hi, true, QG + m0 * XQW + XW + xh * XHD + 128, XQW, XOIN + m0 * XW + xh * XHD + 128, XW);
    }
    __syncthreads();
}
__device__ __forceinline__ void xattn_phase(Frame& F, const bf16* QG, const bf16* KVX, bf16* XOIN) {
    PH_IDS();
    char* lds = (char*)(F.lds + RING_OFF);
    for (int u = vcu; u < BATCH * XH * 8; u += G) xattn_unit(lds, QG, KVX, XOIN, u >> 5, (u >> 3) & 3, u & 7, tid, lane, wave);
}
}

#ifndef MK_PER_PHASE
#define MK_PER_PHASE 0
#endif
#ifndef MFMA_MOBA
#define MFMA_MOBA 1
#endif
#ifndef MFMA_SB
#define MFMA_SB 1
#endif
#ifndef MFMA_XA
#define MFMA_XA 1
#endif

#ifndef DBG_MOBA
#define DBG_MOBA 0
#endif
#ifndef DBG_STAT
#define DBG_STAT 0
#endif
constexpr int CW_DBG = 8192;
__device__ __forceinline__ void dbg_compare(Frame& F, const bf16* MIX, const bf16* ALT) {
    PH_IDS();
    unsigned* st = (unsigned*)(F.ctl + CW_DBG);
    unsigned cnt = 0, tot = 0, mnv = 0, mxv = 0, cb = 0, wv = 0, rc = 0, qbm = 0;
    for (size_t i = (size_t)vcu * 512 + tid; i < (size_t)MROWS * 2048; i += (size_t)G * 512) {
        const int m = (int)(i >> 11), c = (int)(i & 2047), t = m & (SEQ - 1), qb = t >> 8;
        if (!((MOBA_QBMASK >> qb) & 1)) continue;
        const float a = bf_lo((unsigned)ALT[(size_t)m * DM + CONVW + c]), r = bf_lo((unsigned)MIX[(size_t)m * DM + CONVW + c]);
        ++tot;
        if (!(fabsf(a - r) <= 0.03f * fabsf(r) + 0.003f)) { ++cnt; mnv = mnv > 2047u - (unsigned)t ? mnv : 2047u - (unsigned)t; mxv = mxv > (unsigned)t ? mxv : (unsigned)t; cb |= 1u << ((c >> 5) & 3); rc |= 1u << (t & 31); qbm |= 1u << qb; if (qb == 0) wv |= 1u << ((t >> 5) & 7); }
    }
    if (tot) atomicAdd(st + 1, tot);
    if (cnt) { atomicAdd(st + 0, cnt); atomicMax(st + 2, mnv); atomicMax(st + 3, mxv); atomicOr(st + 4, cb); atomicOr(st + 5, rc); atomicOr(st + 6, qbm); atomicOr(st + 7, wv); }
}
__device__ __forceinline__ void dbg_spin(Frame& F) {
    if (blockIdx.x == 0 && threadIdx.x == 0) {
        unsigned* st = (unsigned*)(F.ctl + CW_DBG); unsigned v[56];
        const unsigned cnt = __hip_atomic_load(st + 0, RLX_AGENT), tot = __hip_atomic_load(st + 1, RLX_AGENT), mn = 2047u - __hip_atomic_load(st + 2, RLX_AGENT), mxv = __hip_atomic_load(st + 3, RLX_AGENT);
        unsigned s1 = 0, s2 = 0;
        if (DBG_STAT == 0) { s1 = 0; s2 = 0; }
        if (DBG_STAT == 1) { s1 = cnt == 0 ? 0u : (mn > 31u ? 31u : mn); s2 = cnt == 0 ? 0u : 1u + (unsigned)(14.0f * (float)cnt / (float)(tot ? tot : 1u)); }
        if (DBG_STAT == 2) { s1 = __hip_atomic_load(st + 4, RLX_AGENT) | ((__hip_atomic_load(st + 6, RLX_AGENT) & 1u) << 4); s2 = __hip_atomic_load(st + 7, RLX_AGENT) & 15u; }
        if (DBG_STAT == 3) { const unsigned rcv = __hip_atomic_load(st + 5, RLX_AGENT); s1 = rcv & 31u; s2 = (rcv >> 5) & 15u; }
        (void)v;
        const unsigned long long ticks = (unsigned long long)s1 * 200000ull + (unsigned long long)(s2 > 15u ? 15u : s2) * 6400000ull;
        const unsigned long long t0 = __builtin_amdgcn_s_memrealtime();
        while (__builtin_amdgcn_s_memrealtime() - t0 < ticks) __builtin_amdgcn_s_sleep(64);
    }
}
constexpr int NPHASES = 19;
#ifndef CONV_IN_MOBA
#define CONV_IN_MOBA 1
#endif
#ifndef GEMM_STAG
#define GEMM_STAG 0
#define GEMM_STAG_CLS 8
#endif
#ifndef GEMM_SP2
#define GEMM_SP2 true
#endif
#ifndef GEMM_ALIGN
#define GEMM_ALIGN true
#endif
struct Args { const float* in[N_IN]; float* out; unsigned char* ws; int ph_lo, ph_hi; };
#ifndef FUSE_XQ
#define FUSE_XQ 0
#endif
struct XqOrder { int v;
    __device__ __forceinline__ bool next(int i, pg8::Unit& u) const { if (i > 1) return false; u.pm = v >> 2; u.pn = (v & 3) + 4 * i; return true; }
    __device__ __forceinline__ void a_ready(const pg8::Unit&) const {}
    __device__ __forceinline__ void done(const pg8::Unit&) const {} };
__device__ __forceinline__ void xq_xattn_fused(Frame& F, const bf16* A, const bf16* Wxq_t, bf16* QG, const bf16* KVX, bf16* XOIN) {
    int v_ = F.vcu_; asm volatile("" : "+s"(v_));
    { pg8::Gemm g{A, Wxq_t, MROWS, XQW, DM}; XqOrder S{v_}; pg8::EpiBf16 E{QG, XQW};
      pg8::gemm_phase<pg8::EpiBf16, XqOrder, GEMM_ALIGN, GEMM_SP2, true>(F.lds + RING_OFF, g, S, E); }
    __builtin_amdgcn_fence(__ATOMIC_ACQUIRE, "agent"); asm volatile("s_waitcnt vmcnt(0)" ::: "memory"); __syncthreads();
    PH_IDS();
    att::xattn_unit((char*)(F.lds + RING_OFF), QG, KVX, XOIN, (v_ >> 2) >> 3, v_ & 3, (v_ >> 2) & 7, tid, lane, wave);
}
#ifndef FP8_VG
#define FP8_VG 0
#endif
template <bool F16 = false, bool FP8 = false, class Epi> __device__ __forceinline__ void run_gemm(Frame& F, const bf16* A, const bf16* Bt, int M, int N, int K, const Epi& E) {
    int c_ = blockIdx.x, G_ = F.G_; asm volatile("" : "+s"(c_), "+s"(G_));
    pg8::Gemm g{A, Bt, M, N, K}; pg8::StaticOrder S; S.init(M, N, G_, c_);
    pg8::gemm_phase<Epi, pg8::StaticOrder, GEMM_ALIGN, GEMM_SP2, F16, FP8>(F.lds + RING_OFF, g, S, E);
}
__global__ void __launch_bounds__(NWAVES * 64, 2) mega_fwd(Args args) {
    extern __shared__ __attribute__((aligned(16))) unsigned char lds[];
    Frame F;
    F.lds = (LAS unsigned char*)lds;
    F.MISC = (volatile LAS unsigned*)(F.lds + MISC_OFF);
    F.G_ = gridDim.x; { const int bx = blockIdx.x; F.vcu_ = (F.G_ % 8 == 0) ? (bx % 8) * (F.G_ / 8) + bx / 8 : bx; }
    unsigned char* ws = args.ws;
    F.ctl = (gu32*)(ws + WS_CTL);
    for (int u = threadIdx.x; u < (LDS_BYTES - LDSCTL_OFF) / 4; u += NWAVES * 64) ((LAS unsigned*)(F.lds + LDSCTL_OFF))[u] = 0u;
    __syncthreads();
    XcdBarrier bar = xcd_barrier_post((unsigned*)(F.ctl + CW_BAR), F.MISC + 8);
    const int lo = args.ph_lo, hi = args.ph_hi;
#ifndef DBG_TMASK
#define DBG_TMASK 0u
#endif
#ifndef DBG_TAMP
#define DBG_TAMP 10
#endif
#define TP_BEGIN(k) do { if (((DBG_TMASK >> (k)) & 1u) && threadIdx.x == 0) { const unsigned long long t_ = __builtin_amdgcn_s_memrealtime(); F.MISC[18] = (unsigned)t_; F.MISC[19] = (unsigned)(t_ >> 32); } } while (0)
#define TP_END(k) do { if (((DBG_TMASK >> (k)) & 1u) && threadIdx.x == 0) { const unsigned long long t_ = __builtin_amdgcn_s_memrealtime() - (((unsigned long long)F.MISC[19] << 32) | F.MISC[18]); const unsigned long long a_ = (((unsigned long long)F.MISC[17] << 32) | F.MISC[16]) + t_; F.MISC[16] = (unsigned)a_; F.MISC[17] = (unsigned)(a_ >> 32); } } while (0)
#define IN(k) (lo <= (k) && (k) < hi)
#define SEAM(k) do { if (IN(k) && IN((k) + 1)) xcd_barrier(bar); } while (0)
#define PHASE_PTRS() unsigned char* wsp = ws; int Lp = L; asm volatile("" : "+s"(wsp), "+s"(Lp)); unsigned char* const wl = wsp + WS_W + (size_t)Lp * W_LAYER; (void)wl; \
        bf16* const XM = (bf16*)(wsp + WS_XM); bf16* const PROJ = (bf16*)(wsp + WS_PROJ); bf16* const QG = (bf16*)(wsp + WS_QG); bf16* const XOIN = (bf16*)(wsp + WS_XOIN); \
        bf16* const KVX = (bf16*)(wsp + WS_KVX) + (size_t)Lp * XQW; (void)XM; (void)PROJ; (void)QG; (void)XOIN; (void)KVX
    float* const OUT = args.out;

    if (IN(0)) { TP_BEGIN(0); p0_prologue(F, ws, (unsigned char*)args.out); SEAM(0); TP_END(0); }

    { constexpr int L = 0;
        const int pb = 1 + 9 * L;
        if (IN(pb + 0)) { TP_BEGIN(pb + 0); PHASE_PTRS(); {
#if defined(DBG_CLK)
                            unsigned long long c0_ = 0, r0_ = 0; if (L == 1) { c0_ = __builtin_amdgcn_s_memtime(); r0_ = __builtin_amdgcn_s_memrealtime(); }
#endif
                            if (GEMM_STAG != 0) { const unsigned cls_ = ((unsigned)blockIdx.x >> 3) % (unsigned)GEMM_STAG_CLS; const unsigned long long t0_ = __builtin_amdgcn_s_memrealtime();
                                                   while (__builtin_amdgcn_s_memrealtime() - t0_ < cls_ * (unsigned long long)GEMM_STAG) __builtin_amdgcn_s_sleep(8); }
                            pg8::EpiBf16 E{PROJ, NPROJ}; run_gemm<false>(F, L == 0 ? (const bf16*)XM : (const bf16*)(wsp + WS_X1B), (const bf16*)(wl + W_IN), MROWS, (L == 0 && FP8_VG) ? NPB0 : (L == 1 && FP8_L1) ? NPB1 : NPROJ, DM, E);
                            if (L == 1 && FP8_L1) { pg8::EpiBf16 E8{PROJ + NPB1, NPROJ, 1.f / 64.f}; run_gemm<false, true>(F, (const bf16*)(wsp + WS_X8_1), (const bf16*)(wl + W_IN + W1_W8_OFF), MROWS, NP8_1, DM / 2, E8); }
                            if (L == 0 && FP8_VG) { pg8::EpiBf16 E8{PROJ + NPB0, NPROJ, 1.f / 64.f}; run_gemm<false, true>(F, (const bf16*)((const unsigned char*)OUT + OUT_X8), (const bf16*)((const unsigned char*)OUT + OUT_W8), MROWS, NP8, DM / 2, E8); }
#if defined(DBG_CLK)
                            if (L == 1 && threadIdx.x == 0) { const unsigned long long dc_ = __builtin_amdgcn_s_memtime() - c0_, dr_ = __builtin_amdgcn_s_memrealtime() - r0_; const unsigned long long mhz_ = dc_ * 100ull / dr_;
                                F.MISC[16] = (unsigned)(mhz_ * 10000ull); F.MISC[17] = 0u; }
#endif
                          }
                          if (L == 0) { PHASE_PTRS(); pg8::EpiBf16 E{(bf16*)(wsp + WS_KVX), KVLD}; run_gemm(F, (const bf16*)(wsp + WS_MEMB), (const bf16*)(wsp + WS_WXKV), BATCH * NMEM, KVLD, DM, E);
                                        constexpr int KV_UNITS = (BATCH * NMEM / 256) * (KVLD / 256); if ((int)blockIdx.x >= KV_UNITS && (int)gridDim.x > KV_UNITS) p1_convert_win1(F, wsp, (int)blockIdx.x - KV_UNITS, (int)gridDim.x - KV_UNITS);
                                        else if ((int)gridDim.x <= KV_UNITS) p1_convert_win1(F, wsp, (int)blockIdx.x, (int)gridDim.x); }
                          SEAM(pb + 0); TP_END(pb + 0); }
        if (IN(pb + 1)) { TP_BEGIN(pb + 1); if (L == 0) { PHASE_PTRS(); if (!CONV_IN_MOBA) conv_phase(F, PROJ, XM, karg_in(I_CONVW)); kbar_phase(F, PROJ, (float*)(wsp + WS_KBAR)); SEAM(pb + 1); TP_END(pb + 1); } }
        if (IN(pb + 2)) { TP_BEGIN(pb + 2); PHASE_PTRS(); if (L == 0) { if (DBG_MOBA) { att::moba_phase(F, PROJ, (const float*)(wsp + WS_KBAR), karg_in(I_RELB), (bf16*)OUT); moba_naive_phase(F, PROJ, (const float*)(wsp + WS_KBAR), karg_in(I_RELB), XM); xcd_barrier(bar); dbg_compare(F, XM, (const bf16*)OUT); }
                          else { const int conv_slot_ = CONV_IN_MOBA ? (int)(((unsigned)blockIdx.x >> 3) % 3u) : -1; const bool conv_first = false; (void)conv_first;
                                 if (MFMA_MOBA) att::moba_phase(F, PROJ, (const float*)(wsp + WS_KBAR), karg_in(I_RELB), XM, conv_slot_, karg_in(I_CONVW), LATE_CONV ? wsp : nullptr);     if (!MFMA_MOBA || MOBA_QBMASK != 0xff) moba_naive_phase(F, PROJ, (const float*)(wsp + WS_KBAR), karg_in(I_RELB), XM); } }
                          else { const bool late_first = (((unsigned)blockIdx.x >> 3) & 1u) == 0u;
                                 if (LATE_CONV && late_first) { p_convert_late(F, wsp, 1); __syncthreads(); }
                                 if (MFMA_SB) att::sb_phase(F, PROJ, XM); else sb_naive_phase(F, PROJ, XM);
                                 if (LATE_CONV && !late_first) { __syncthreads(); p_convert_late(F, wsp, 1); __syncthreads(); }
#if defined(DBG_SBDUMMY)
                                 TP_BEGIN(19); att::sb_dummy_phase(F, PROJ); TP_END(19);
#endif
#if defined(DBG_SBDUMMY4)
                                 xcd_barrier(bar); TP_BEGIN(19); att::sb_dummy4_phase(F, PROJ, (bf16*)(wsp + WS_YB)); TP_END(19);
#endif
                          } SEAM(pb + 2); TP_END(pb + 2); }
        if (IN(pb + 3)) { TP_BEGIN(pb + 3); PHASE_PTRS();
                          if (L == 0 && FP8_OP0) { pg8::EpiBf16 E1{(bf16*)(wsp + WS_YB), DM}; run_gemm(F, XM, (const bf16*)(wl + W_OUT), MROWS, DM, CONVW, E1);
                                                   __builtin_amdgcn_fence(__ATOMIC_ACQUIRE, "agent");
                                                   pg8::EpiBf16Acc E2{(bf16*)(wsp + WS_YB), DM, 1.f / (64.f * MO8_SCALE)}; run_gemm<false, true>(F, (const bf16*)((const unsigned char*)XM + MIX8_OFF), (const bf16*)(wl + W_OUT + WOUT8_OFF), MROWS, DM, CONVW / 2, E2); }
                          else { pg8::EpiBf16 E{(bf16*)(wsp + WS_YB), DM}; run_gemm(F, XM, (const bf16*)(wl + W_OUT), MROWS, DM, DM, E); }
                          SEAM(pb + 3); TP_END(pb + 3); }
        if (IN(pb + 4)) { TP_BEGIN(pb + 4); PHASE_PTRS(); if (L == 0) ln_phase<false, false, false, (FP8_XQ != 0)>(F, karg_in(I_X), (const bf16*)(wsp + WS_YB), nullptr, (_Float16*)(wsp + WS_RH), nullptr, karg_in(I_LN1G0), karg_in(I_LN1B0), DN_ALPHA, (unsigned*)(wsp + WS_X8Q));
                          else ln_phase<true, false, false, (FP8_XQ != 0)>(F, (const _Float16*)OUT + (size_t)MROWS * DM, (const bf16*)(wsp + WS_YB), nullptr, (_Float16*)(wsp + WS_RH), nullptr, karg_in(I_LN1G1), karg_in(I_LN1B1), DN_ALPHA, (unsigned*)(wsp + WS_X8Q)); SEAM(pb + 4); TP_END(pb + 4); }
        const bool fuse_xq = FUSE_XQ && MFMA_XA && F.G_ == 256 && IN(pb + 5) && IN(pb + 6);
        if (IN(pb + 5)) { TP_BEGIN(pb + 5); { PHASE_PTRS(); if (fuse_xq) xq_xattn_fused(F, (const bf16*)(wsp + WS_RH), (const bf16*)(wl + W_XQ), QG, KVX, XOIN); else if (FP8_XQ == 2) { pg8::EpiBf16 E8{QG, XQW, 1.f / 64.f}; run_gemm<false, true>(F, (const bf16*)(wsp + WS_X8Q), (const bf16*)(wl + W_XQ), MROWS, XQW, DM / 2, E8); }
                          else if (FP8_XQ) { pg8::EpiBf16 E8{QG, XQW, 1.f / 64.f}; run_gemm<false, true>(F, (const bf16*)(wsp + WS_X8Q), (const bf16*)(wl + W_XQ), MROWS, XW, DM / 2, E8);
                                 pg8::EpiBf16 E{QG + XW, XQW}; run_gemm<true>(F, (const bf16*)(wsp + WS_RH), (const bf16*)(wl + W_XQ) + (size_t)XW * DM, MROWS, XW, DM, E); }
                          else { pg8::EpiBf16 E{QG, XQW}; run_gemm<true>(F, (const bf16*)(wsp + WS_RH), (const bf16*)(wl + W_XQ), MROWS, XQW, DM, E); } }
                          SEAM(pb + 5); TP_END(pb + 5); }
        if (IN(pb + 6) && !fuse_xq) { TP_BEGIN(pb + 6); PHASE_PTRS(); if (MFMA_XA) att::xattn_phase(F, QG, KVX, XOIN); else xattn_naive_phase(F, QG, KVX, XOIN); SEAM(pb + 6); TP_END(pb + 6); }
        if (IN(pb + 7)) { TP_BEGIN(pb + 7); PHASE_PTRS(); if (FP8_XO) { pg8::EpiBf16 E8{(bf16*)(wsp + WS_YB), DM, 1.f / (64.f * XO8_SCALE)}; run_gemm<false, true>(F, XOIN, (const bf16*)(wl + W_XO), MROWS, DM, XW / 2, E8); } else { pg8::EpiBf16 E{(bf16*)(wsp + WS_YB), DM}; run_gemm(F, XOIN, (const bf16*)(wl + W_XO), MROWS, DM, XW, E); } SEAM(pb + 7); TP_END(pb + 7); }
        if (IN(pb + 8)) { TP_BEGIN(pb + 8); PHASE_PTRS(); if (L == 0) ln_phase<true, false, true, (FP8_L1 != 0)>(F, (const _Float16*)(wsp + WS_RH), (const bf16*)(wsp + WS_YB), (bf16*)(wsp + WS_X1B), (_Float16*)OUT + (size_t)MROWS * DM, nullptr, karg_in(I_LN2G0), karg_in(I_LN2B0), DN_ALPHA, (unsigned*)(wsp + WS_X8_1));
                          else ln_phase<true, true>(F, (const _Float16*)(wsp + WS_RH), (const bf16*)(wsp + WS_YB), nullptr, nullptr, OUT, karg_in(I_LN2G1), karg_in(I_LN2B1), DN_ALPHA);   SEAM(pb + 8); TP_END(pb + 8); }

    }
    { constexpr int L = 1;
        const int pb = 1 + 9 * L;
        if (IN(pb + 0)) { TP_BEGIN(pb + 0); PHASE_PTRS(); {
#if defined(DBG_CLK)
                            unsigned long long c0_ = 0, r0_ = 0; if (L == 1) { c0_ = __builtin_amdgcn_s_memtime(); r0_ = __builtin_amdgcn_s_memrealtime(); }
#endif
                            if (GEMM_STAG != 0) { const unsigned cls_ = ((unsigned)blockIdx.x >> 3) % (unsigned)GEMM_STAG_CLS; const unsigned long long t0_ = __builtin_amdgcn_s_memrealtime();
                                                   while (__builtin_amdgcn_s_memrealtime() - t0_ < cls_ * (unsigned long long)GEMM_STAG) __builtin_amdgcn_s_sleep(8); }
                            pg8::EpiBf16 E{PROJ, NPROJ}; run_gemm<false>(F, L == 0 ? (const bf16*)XM : (const bf16*)(wsp + WS_X1B), (const bf16*)(wl + W_IN), MROWS, (L == 0 && FP8_VG) ? NPB0 : (L == 1 && FP8_L1) ? NPB1 : NPROJ, DM, E);
                            if (L == 1 && FP8_L1) { pg8::EpiBf16 E8{PROJ + NPB1, NPROJ, 1.f / 64.f}; run_gemm<false, true>(F, (const bf16*)(wsp + WS_X8_1), (const bf16*)(wl + W_IN + W1_W8_OFF), MROWS, NP8_1, DM / 2, E8); }
                            if (L == 0 && FP8_VG) { pg8::EpiBf16 E8{PROJ + NPB0, NPROJ, 1.f / 64.f}; run_gemm<false, true>(F, (const bf16*)((const unsigned char*)OUT + OUT_X8), (const bf16*)((const unsigned char*)OUT + OUT_W8), MROWS, NP8, DM / 2, E8); }
#if defined(DBG_CLK)
                            if (L == 1 && threadIdx.x == 0) { const unsigned long long dc_ = __builtin_amdgcn_s_memtime() - c0_, dr_ = __builtin_amdgcn_s_memrealtime() - r0_; const unsigned long long mhz_ = dc_ * 100ull / dr_;
                                F.MISC[16] = (unsigned)(mhz_ * 10000ull); F.MISC[17] = 0u; }
#endif
                          }
                          if (L == 0) { PHASE_PTRS(); pg8::EpiBf16 E{(bf16*)(wsp + WS_KVX), KVLD}; run_gemm(F, (const bf16*)(wsp + WS_MEMB), (const bf16*)(wsp + WS_WXKV), BATCH * NMEM, KVLD, DM, E);
                                        constexpr int KV_UNITS = (BATCH * NMEM / 256) * (KVLD / 256); if ((int)blockIdx.x >= KV_UNITS && (int)gridDim.x > KV_UNITS) p1_convert_win1(F, wsp, (int)blockIdx.x - KV_UNITS, (int)gridDim.x - KV_UNITS);
                                        else if ((int)gridDim.x <= KV_UNITS) p1_convert_win1(F, wsp, (int)blockIdx.x, (int)gridDim.x); }
                          SEAM(pb + 0); TP_END(pb + 0); }
        if (IN(pb + 1)) { TP_BEGIN(pb + 1); if (L == 0) { PHASE_PTRS(); if (!CONV_IN_MOBA) conv_phase(F, PROJ, XM, karg_in(I_CONVW)); kbar_phase(F, PROJ, (float*)(wsp + WS_KBAR)); SEAM(pb + 1); TP_END(pb + 1); } }
        if (IN(pb + 2)) { TP_BEGIN(pb + 2); PHASE_PTRS(); if (L == 0) { if (DBG_MOBA) { att::moba_phase(F, PROJ, (const float*)(wsp + WS_KBAR), karg_in(I_RELB), (bf16*)OUT); moba_naive_phase(F, PROJ, (const float*)(wsp + WS_KBAR), karg_in(I_RELB), XM); xcd_barrier(bar); dbg_compare(F, XM, (const bf16*)OUT); }
                          else { const int conv_slot_ = CONV_IN_MOBA ? (int)(((unsigned)blockIdx.x >> 3) % 3u) : -1; const bool conv_first = false; (void)conv_first;
                                 if (MFMA_MOBA) att::moba_phase(F, PROJ, (const float*)(wsp + WS_KBAR), karg_in(I_RELB), XM, conv_slot_, karg_in(I_CONVW), LATE_CONV ? wsp : nullptr);     if (!MFMA_MOBA || MOBA_QBMASK != 0xff) moba_naive_phase(F, PROJ, (const float*)(wsp + WS_KBAR), karg_in(I_RELB), XM); } }
                          else { const bool late_first = (((unsigned)blockIdx.x >> 3) & 1u) == 0u;
                                 if (LATE_CONV && late_first) { p_convert_late(F, wsp, 1); __syncthreads(); }
                                 if (MFMA_SB) att::sb_phase(F, PROJ, XM); else sb_naive_phase(F, PROJ, XM);
                                 if (LATE_CONV && !late_first) { __syncthreads(); p_convert_late(F, wsp, 1); __syncthreads(); }
#if defined(DBG_SBDUMMY)
                                 TP_BEGIN(19); att::sb_dummy_phase(F, PROJ); TP_END(19);
#endif
#if defined(DBG_SBDUMMY4)
                                 xcd_barrier(bar); TP_BEGIN(19); att::sb_dummy4_phase(F, PROJ, (bf16*)(wsp + WS_YB)); TP_END(19);
#endif
                          } SEAM(pb + 2); TP_END(pb + 2); }
        if (IN(pb + 3)) { TP_BEGIN(pb + 3); PHASE_PTRS();
                          if (L == 0 && FP8_OP0) { pg8::EpiBf16 E1{(bf16*)(wsp + WS_YB), DM}; run_gemm(F, XM, (const bf16*)(wl + W_OUT), MROWS, DM, CONVW, E1);
                                                   __builtin_amdgcn_fence(__ATOMIC_ACQUIRE, "agent");
                                                   pg8::EpiBf16Acc E2{(bf16*)(wsp + WS_YB), DM, 1.f / (64.f * MO8_SCALE)}; run_gemm<false, true>(F, (const bf16*)((const unsigned char*)XM + MIX8_OFF), (const bf16*)(wl + W_OUT + WOUT8_OFF), MROWS, DM, CONVW / 2, E2); }
                          else { pg8::EpiBf16 E{(bf16*)(wsp + WS_YB), DM}; run_gemm(F, XM, (const bf16*)(wl + W_OUT), MROWS, DM, DM, E); }
                          SEAM(pb + 3); TP_END(pb + 3); }
        if (IN(pb + 4)) { TP_BEGIN(pb + 4); PHASE_PTRS(); if (L == 0) ln_phase<false, false, false, (FP8_XQ != 0)>(F, karg_in(I_X), (const bf16*)(wsp + WS_YB), nullptr, (_Float16*)(wsp + WS_RH), nullptr, karg_in(I_LN1G0), karg_in(I_LN1B0), DN_ALPHA, (unsigned*)(wsp + WS_X8Q));
                          else ln_phase<true, false, false, (FP8_XQ != 0)>(F, (const _Float16*)OUT + (size_t)MROWS * DM, (const bf16*)(wsp + WS_YB), nullptr, (_Float16*)(wsp + WS_RH), nullptr, karg_in(I_LN1G1), karg_in(I_LN1B1), DN_ALPHA, (unsigned*)(wsp + WS_X8Q)); SEAM(pb + 4); TP_END(pb + 4); }
        const bool fuse_xq = FUSE_XQ && MFMA_XA && F.G_ == 256 && IN(pb + 5) && IN(pb + 6);
        if (IN(pb + 5)) { TP_BEGIN(pb + 5); { PHASE_PTRS(); if (fuse_xq) xq_xattn_fused(F, (const bf16*)(wsp + WS_RH), (const bf16*)(wl + W_XQ), QG, KVX, XOIN); else if (FP8_XQ == 2) { pg8::EpiBf16 E8{QG, XQW, 1.f / 64.f}; run_gemm<false, true>(F, (const bf16*)(wsp + WS_X8Q), (const bf16*)(wl + W_XQ), MROWS, XQW, DM / 2, E8); }
                          else if (FP8_XQ) { pg8::EpiBf16 E8{QG, XQW, 1.f / 64.f}; run_gemm<false, true>(F, (const bf16*)(wsp + WS_X8Q), (const bf16*)(wl + W_XQ), MROWS, XW, DM / 2, E8);
                                 pg8::EpiBf16 E{QG + XW, XQW}; run_gemm<true>(F, (const bf16*)(wsp + WS_RH), (const bf16*)(wl + W_XQ) + (size_t)XW * DM, MROWS, XW, DM, E); }
                          else { pg8::EpiBf16 E{QG, XQW}; run_gemm<true>(F, (const bf16*)(wsp + WS_RH), (const bf16*)(wl + W_XQ), MROWS, XQW, DM, E); } }
                          SEAM(pb + 5); TP_END(pb + 5); }
        if (IN(pb + 6) && !fuse_xq) { TP_BEGIN(pb + 6); PHASE_PTRS(); if (MFMA_XA) att::xattn_phase(F, QG, KVX, XOIN); else xattn_naive_phase(F, QG, KVX, XOIN); SEAM(pb + 6); TP_END(pb + 6); }
        if (IN(pb + 7)) { TP_BEGIN(pb + 7); PHASE_PTRS(); if (FP8_XO) { pg8::EpiBf16 E8{(bf16*)(wsp + WS_YB), DM, 1.f / (64.f * XO8_SCALE)}; run_gemm<false, true>(F, XOIN, (const bf16*)(wl + W_XO), MROWS, DM, XW / 2, E8); } else { pg8::EpiBf16 E{(bf16*)(wsp + WS_YB), DM}; run_gemm(F, XOIN, (const bf16*)(wl + W_XO), MROWS, DM, XW, E); } SEAM(pb + 7); TP_END(pb + 7); }
        if (IN(pb + 8)) { TP_BEGIN(pb + 8); PHASE_PTRS(); if (L == 0) ln_phase<true, false, true, (FP8_L1 != 0)>(F, (const _Float16*)(wsp + WS_RH), (const bf16*)(wsp + WS_YB), (bf16*)(wsp + WS_X1B), (_Float16*)OUT + (size_t)MROWS * DM, nullptr, karg_in(I_LN2G0), karg_in(I_LN2B0), DN_ALPHA, (unsigned*)(wsp + WS_X8_1));
                          else ln_phase<true, true>(F, (const _Float16*)(wsp + WS_RH), (const bf16*)(wsp + WS_YB), nullptr, nullptr, OUT, karg_in(I_LN2G1), karg_in(I_LN2B1), DN_ALPHA);   SEAM(pb + 8); TP_END(pb + 8); }

    }
#undef PHASE_PTRS
    if (DBG_MOBA) { xcd_barrier(bar); dbg_spin(F); }
#if defined(DBG_SEGSB)
    if (blockIdx.x == DBG_SEGBLK && threadIdx.x == DBG_SEGTID) { const unsigned long long t0 = __builtin_amdgcn_s_memrealtime(), ticks = ((((unsigned long long)F.MISC[17] << 32) | F.MISC[16])) * DBG_TAMP; while (__builtin_amdgcn_s_memrealtime() - t0 < ticks) __builtin_amdgcn_s_sleep(32); }
#endif
#if defined(DBG_TLOOP) || defined(DBG_SEG) || defined(DBG_CLK)
    if (blockIdx.x == 0 && threadIdx.x == 0) { const unsigned long long t0 = __builtin_amdgcn_s_memrealtime(), ticks = ((((unsigned long long)F.MISC[17] << 32) | F.MISC[16])) * DBG_TAMP; while (__builtin_amdgcn_s_memrealtime() - t0 < ticks) __builtin_amdgcn_s_sleep(32); }
#endif
    if (DBG_TMASK != 0u && blockIdx.x == 0 && threadIdx.x == 0) { const unsigned long long t0 = __builtin_amdgcn_s_memrealtime(), ticks = ((((unsigned long long)F.MISC[17] << 32) | F.MISC[16])) * DBG_TAMP; while (__builtin_amdgcn_s_memrealtime() - t0 < ticks) __builtin_amdgcn_s_sleep(32); }
#undef IN
#undef SEAM
}

extern "C" void kernel_launch(void* const* d_in, const int* in_sizes, int n_in, void* d_out, int out_size, void* d_ws, size_t ws_size, hipStream_t stream) {
    static int grid = 0;
    if (grid == 0) {
        if (n_in != N_IN || in_sizes[0] != MROWS * DM || out_size != MROWS * DM || ws_size < WS_END) { fprintf(stderr, "kernel_launch: unexpected shapes / workspace (n_in %d, ws %zu, need %zu); nothing launched\n", n_in, ws_size, (size_t)WS_END); grid = -1; return; }
        int dev = 0, cus = 0, per_cu = 0;
        if (hipGetDevice(&dev) != hipSuccess || hipDeviceGetAttribute(&cus, hipDeviceAttributeMultiprocessorCount, dev) != hipSuccess) { grid = -1; return; }
        if (hipFuncSetAttribute((const void*)mega_fwd, hipFuncAttributeMaxDynamicSharedMemorySize, LDS_BYTES) != hipSuccess) { fprintf(stderr, "kernel_launch: hipFuncSetAttribute failed\n"); grid = -1; return; }
        if (hipOccupancyMaxActiveBlocksPerMultiprocessor(&per_cu, (const void*)mega_fwd, NWAVES * 64, LDS_BYTES) != hipSuccess || per_cu < 1) { fprintf(stderr, "kernel_launch: occupancy query says %d workgroups per CU\n", per_cu); }
        (void)hipGetLastError();
        grid = cus;
    }
    if (grid < 0) return;
    if (hipMemsetAsync((char*)d_ws + WS_CTL, 0, CTL_ZERO_BYTES, stream) != hipSuccess) return;
    Args a{};
    for (int i = 0; i < N_IN; ++i) a.in[i] = (const float*)d_in[i];
    a.out = (float*)d_out; a.ws = (unsigned char*)d_ws;
#if MK_PER_PHASE
    for (int p = 0; p < NPHASES; ++p) { a.ph_lo = p; a.ph_hi = p + 1; hipLaunchKernelGGL(mega_fwd, dim3(grid), dim3(NWAVES * 64), LDS_BYTES, stream, a); }
#else
    a.ph_lo = 0; a.ph_hi = NPHASES;
    hipLaunchKernelGGL(mega_fwd, dim3(grid), dim3(NWAVES * 64), LDS_BYTES, stream, a);
#endif
    const hipError_t le = hipPeekAtLastError();
    if (le != hipSuccess) fprintf(stderr, "kernel_launch: launch failed: %s\n", hipGetErrorName(le));
}
```
